# Optimizing an MI355X kernel written in HIP

```python
import jax, jax.numpy as jnp
from jax import lax
import numpy as np

D_MODEL = 2048
BATCH = 4
SEQ = 4096
DEPTH = 2

N_MEM = 256
N_MIXERS = 2
N_A = (DEPTH + 1) // 2
N_B = DEPTH // 2
E_BRANCH = 2 * D_MODEL
E_CA = E_BRANCH // 4
E_MIX = E_BRANCH - E_CA
CA_HEADS = 4
CA_HEAD_DIM = E_CA // CA_HEADS
POOL_WINDOWS = (2, 4, 8, 16)
N_POOL_GROUPS = len(POOL_WINDOWS)
POOL_GROUP = E_MIX // N_POOL_GROUPS
HG_HEAD_DIM = 128
HG_HEADS = E_MIX // HG_HEAD_DIM
HG_CHUNK = 64
EPS = 1e-6

kernel_name = "interleaved_pool_hgrn2_memory_hybrid"


def rmsnorm(x, g):
    xf = x.astype(jnp.float32)
    y = xf * lax.rsqrt(jnp.mean(xf * xf, axis=-1, keepdims=True) + EPS)
    return (y * g.astype(jnp.float32)).astype(x.dtype)


def pool_mixer(u, w_grp, scale):
    B, S, _ = u.shape
    wmax = max(POOL_WINDOWS)
    uf = u.astype(jnp.float32)
    c = jnp.cumsum(uf, axis=1)
    c_pad = jnp.pad(c, ((0, 0), (wmax, 0), (0, 0)))
    pos = jnp.arange(S, dtype=jnp.float32)[:, None]
    pooled = []
    for j, w in enumerate(POOL_WINDOWS):
        lo, hi = j * POOL_GROUP, (j + 1) * POOL_GROUP
        win_sum = c[:, :, lo:hi] - c_pad[:, wmax - w: wmax - w + S, lo:hi]
        count = jnp.minimum(pos + 1.0, float(w))
        pooled.append(win_sum / count - uf[:, :, lo:hi])
    pooled = jnp.stack(pooled, axis=2).astype(u.dtype)
    y = jnp.einsum('bsgc,gcd->bsgd', pooled, w_grp)
    return y.reshape(B, S, E_MIX) * scale


def hgrn2_mixer(q_in, f_in, i_in, lb, norm_g):
    B, S, _ = q_in.shape
    N = S // HG_CHUNK
    f32 = jnp.float32

    def heads(t):
        return t.reshape(B, N, HG_CHUNK, HG_HEADS, HG_HEAD_DIM).transpose(0, 3, 1, 2, 4)

    q = heads(jax.nn.silu(q_in.astype(f32))) * (HG_HEAD_DIM ** -0.5)
    f = lb + (1.0 - lb) * jax.nn.sigmoid(f_in.astype(f32))
    k = heads(1.0 - f)
    b = jnp.cumsum(heads(jnp.log(f)), axis=3)
    v = heads(i_in.astype(f32))
    b_last = b[:, :, :, -1:, :]

    q_dec = q * jnp.exp(b)
    k_inv = k * jnp.exp(-b)
    k_to_end = k * jnp.exp(b_last - b)

    causal = jnp.tril(jnp.ones((HG_CHUNK, HG_CHUNK), dtype=bool))
    attn = jnp.einsum('bhnck,bhnsk->bhncs', q_dec, k_inv)
    attn = jnp.where(causal, attn, 0.0)
    o_intra = jnp.einsum('bhncs,bhnsv->bhncv', attn, v)

    def step(state, xs):
        qd, kte, vv, dec = xs
        o = jnp.einsum('bhck,bhkv->bhcv', qd, state)
        state = dec[..., None] * state + jnp.einsum('bhck,bhcv->bhkv', kte, vv)
        return state, o

    mv = lambda t: jnp.moveaxis(t, 2, 0)
    s0 = jnp.zeros((B, HG_HEADS, HG_HEAD_DIM, HG_HEAD_DIM), f32)
    _, o_inter = lax.scan(step, s0, (mv(q_dec), mv(k_to_end), mv(v), mv(jnp.exp(b_last[:, :, :, 0, :]))))
    o = o_intra + jnp.moveaxis(o_inter, 0, 2)
    o = o * lax.rsqrt(jnp.mean(o * o, axis=-1, keepdims=True) + EPS)
    o = o.transpose(0, 2, 3, 1, 4).reshape(B, S, E_MIX) * norm_g.astype(f32)
    return o.astype(q_in.dtype)


def memory_attention(q_in, mem_n, w_kv):
    B, S, _ = q_in.shape
    M = mem_n.shape[1]
    kv = jnp.einsum('bmd,de->bme', mem_n, w_kv)
    k, v = jnp.split(kv, 2, axis=-1)
    q = q_in.reshape(B, S, CA_HEADS, CA_HEAD_DIM)
    k = k.reshape(B, M, CA_HEADS, CA_HEAD_DIM)
    v = v.reshape(B, M, CA_HEADS, CA_HEAD_DIM)
    s = jnp.einsum('bshd,bmhd->bhsm', q, k).astype(jnp.float32) * (CA_HEAD_DIM ** -0.5)
    p = jax.nn.softmax(s, axis=-1).astype(v.dtype)
    o = jnp.einsum('bhsm,bmhd->bshd', p, v)
    return o.reshape(B, S, E_CA)


def setup_inputs(seed: int = 0) -> dict:
    key = jax.random.key(seed)
    ks = jax.random.split(key, 14)
    f32 = jnp.float32
    nrm = lambda k, shape, s: jax.random.normal(k, shape, f32) * s
    d_in_pool = E_MIX + E_CA + E_BRANCH
    d_in_hg = 3 * E_MIX + E_CA + E_BRANCH
    return {
        "x": nrm(ks[0], (BATCH, SEQ, D_MODEL), 1.0),
        "mem": nrm(ks[1], (BATCH, N_MEM, D_MODEL), 1.0),
        "norm_g": 1.0 + nrm(ks[2], (DEPTH, D_MODEL), 0.02),
        "mem_norm_g": 1.0 + nrm(ks[3], (D_MODEL,), 0.02),
        "w_kv": nrm(ks[4], (DEPTH, D_MODEL, 2 * E_CA), D_MODEL ** -0.5),
        "w_out": nrm(ks[5], (DEPTH, E_BRANCH, D_MODEL), E_BRANCH ** -0.5),
        "pool_w_in": nrm(ks[6], (N_A, D_MODEL, d_in_pool), D_MODEL ** -0.5),
        "pool_w_grp": nrm(ks[7], (N_A, N_POOL_GROUPS, POOL_GROUP, POOL_GROUP), POOL_GROUP ** -0.5),
        "pool_scale": 1.0 + nrm(ks[8], (N_A, E_MIX), 0.1),
        "hgrn_w_in": nrm(ks[9], (N_B, D_MODEL, d_in_hg), D_MODEL ** -0.5),
        "hgrn_lb": nrm(ks[10], (DEPTH, E_MIX), 0.1),
        "hgrn_norm_g": 1.0 + nrm(ks[11], (N_B, E_MIX), 0.02),
        "final_g": 1.0 + nrm(ks[12], (D_MODEL,), 0.02),
    }


def reference(x, mem, norm_g, mem_norm_g, w_kv, w_out, pool_w_in, pool_w_grp, pool_scale,
              hgrn_w_in, hgrn_lb, hgrn_norm_g, final_g):
    mem_n = rmsnorm(mem, mem_norm_g)
    sm = jax.nn.softmax(hgrn_lb.astype(jnp.float32), axis=0)
    lb_all = jnp.cumsum(sm, axis=0) - sm[0:1]
    for i in range(DEPTH):
        h = rmsnorm(x, norm_g[i])
        j = i // N_MIXERS
        if i % N_MIXERS == 0:
            proj = jnp.einsum('bsd,de->bse', h, pool_w_in[j])
            u, q_ca, gate = jnp.split(proj, [E_MIX, E_MIX + E_CA], axis=-1)
            mix = pool_mixer(u, pool_w_grp[j], pool_scale[j])
        else:
            proj = jnp.einsum('bsd,de->bse', h, hgrn_w_in[j])
            q_hg, f_hg, i_hg, q_ca, gate = jnp.split(
                proj, [E_MIX, 2 * E_MIX, 3 * E_MIX, 3 * E_MIX + E_CA], axis=-1)
            mix = hgrn2_mixer(q_hg, f_hg, i_hg, lb_all[i], hgrn_norm_g[j])
        ca = memory_attention(q_ca, mem_n, w_kv[i])
        branch = jnp.concatenate([mix, ca], axis=-1) * jax.nn.silu(gate)
        x = x + jnp.einsum('bse,ed->bsd', branch, w_out[i])
    return rmsnorm(x, final_g)
```

```cpp
#include <hip/hip_runtime.h>
#include <cstdio>
#include <cstdint>

#ifndef MK_N_LAUNCHES
#define MK_N_LAUNCHES 1
#endif

#define LAS __attribute__((address_space(3)))
typedef unsigned short bf16_t;
typedef short bf16x8 __attribute__((ext_vector_type(8)));
typedef float f32x4 __attribute__((ext_vector_type(4)));
typedef float f32x2 __attribute__((ext_vector_type(2)));
typedef unsigned u32x4 __attribute__((ext_vector_type(4)));
typedef unsigned u32x2 __attribute__((ext_vector_type(2)));

constexpr int BATCH = 4, SEQ = 4096, DM = 2048, T = BATCH * SEQ;
constexpr int NMEM = 256, MROWS = BATCH * NMEM;
constexpr int E_MIX = 3072, E_CA = 1024, E_BR = 4096;
constexpr int N0 = 8192, N1 = 14336, N0A = 4096, N1A = 10240;
constexpr int PGRP = 768;
constexpr int HG_H = 24, HG_D = 128;
constexpr float EPS = 1e-6f;

constexpr size_t MiB = 1u << 20;
constexpr size_t WS_CTL = 0, CTL_ZERO_BYTES = 1 * MiB;
constexpr size_t WS_WIN1 = 1 * MiB;
constexpr size_t WS_WOUT1 = 57 * MiB;
constexpr size_t WS_KMAT = 73 * MiB;
constexpr size_t WS_VT = 77 * MiB;
constexpr size_t WS_H = 81 * MiB;
constexpr size_t WS_BIG = 145 * MiB;
constexpr size_t WS_WIN0 = WS_BIG;
constexpr size_t WS_WOUT0 = WS_BIG + 32 * MiB;
constexpr size_t WS_WKV = WS_BIG + 48 * MiB;
constexpr size_t WS_WGRP = WS_BIG + 64 * MiB;
constexpr size_t WS_MEMN = WS_BIG + 69 * MiB;
constexpr size_t WS_U = WS_BIG + 73 * MiB;
constexpr size_t WS_POOL = WS_BIG + 201 * MiB;
constexpr size_t WS_P1 = WS_BIG;
constexpr size_t WS_END = WS_BIG + 320 * MiB;
static_assert(WS_POOL + (size_t)T * E_MIX * 2 <= WS_END, "ws map");

namespace pg8 {
constexpr int BM = 256, BK = 64, HALF = 128, HTB = HALF * BK * 2, STAGE_BYTES = 8 * HTB, NXCD = 8, WGM = 8;
__host__ __device__ __forceinline__ int lds_byte(int r, int c) { const int st = (r >> 4) * 2 + (c >> 5), rr = r & 15, cc = c & 31, ob = rr * 64 + cc * 2; return st * 1024 + (ob ^ (((ob >> 9) & 1) << 5)); }
__host__ __device__ __forceinline__ void stage_rc(int b, int& R, int& C) { const int st = b / 1024, sb = b % 1024, swz = sb ^ (((sb >> 9) & 1) << 5); R = (st >> 1) * 16 + swz / 64; C = (st & 1) * 32 + (swz % 64) / 2; }
__host__ __device__ __forceinline__ int perm32(int rho) { const int n = rho >> 4, i = rho & 15; return 8 * (i >> 2) + 4 * n + (i & 3); }

struct Unit { int pm, pn; };
struct Job {
    const bf16_t* A; const bf16_t* Bt; int lda, ldb, K, M, N, G, c, grp_tiles, grp_stride;
    int kind; bf16_t* O; int ldc; const float* colscale; const float* base; float* out;
};
struct StaticOrder {
    int nM, nN, nwg, G, c;
    __device__ void init(int M, int N, int G_, int c_) { nM = M / BM; nN = N / BM; nwg = nM * nN; G = G_; c = c_; }
    __device__ bool next(int i, Unit& u) const {
        const long L = (long)i * G + c; if (L >= nwg) return false;
        int wgid = (int)L; { const int q = nwg / NXCD, r = nwg % NXCD, xcd = wgid % NXCD, off = wgid / NXCD; wgid = (xcd < r ? xcd * (q + 1) : r * (q + 1) + (xcd - r) * q) + off; }
        const int nig = WGM * nN, gid = wgid / nig, fm = gid * WGM, gsz = (nM - fm) < WGM ? (nM - fm) : WGM;
        u.pm = fm + ((wgid % nig) % gsz); u.pn = (wgid % nig) / gsz; return true;
    }
};
__device__ __forceinline__ unsigned cvt_pk_bf16(float lo, float hi) { unsigned r; asm volatile("v_cvt_pk_bf16_f32 %0, %1, %2" : "=v"(r) : "v"(lo), "v"(hi)); return r; }
__device__ __forceinline__ float bflo(unsigned w) { return __uint_as_float(w << 16); }
__device__ __forceinline__ float bfhi(unsigned w) { return __uint_as_float(w & 0xffff0000u); }
__device__ __forceinline__ float silu_f(float v) { return v * __builtin_amdgcn_rcpf(1.0f + __builtin_amdgcn_exp2f(-1.4426950408889634f * v)); }

__device__ __forceinline__ void epilogue(const Job& J, const f32x4 (&acc)[2][2][4][2], const Unit& u, int wr, int wc, int fr, int fq) {
    if (J.kind == 3) {
        const int row0 = u.pm * BM + wr * 64 + fr, col0 = u.pn * BM + wc * 32 + 4 * fq;
#pragma unroll
        for (int ai = 0; ai < 2; ++ai)
#pragma unroll
            for (int m = 0; m < 4; ++m) { const size_t off = (size_t)(row0 + ai * HALF + m * 16) * J.ldc + col0;
#pragma unroll
                for (int bj = 0; bj < 2; ++bj)
#pragma unroll
                    for (int n = 0; n < 2; ++n) { const f32x4 bs = *(const f32x4*)(J.base + off + bj * HALF + n * 16); *(f32x4*)(J.out + off + bj * HALF + n * 16) = bs + acc[ai][bj][m][n]; } }
        return;
    }
    const int row0 = u.pm * BM + wr * 64 + fr, col0 = u.pn * BM + wc * 32 + 8 * fq;
    f32x4 sc[2][2];
#pragma unroll
    for (int bj = 0; bj < 2; ++bj)
#pragma unroll
        for (int n = 0; n < 2; ++n) sc[bj][n] = (J.kind == 1) ? *(const f32x4*)(J.colscale + col0 + bj * HALF + 4 * n) : (f32x4){1.f, 1.f, 1.f, 1.f};
#pragma unroll
    for (int ai = 0; ai < 2; ++ai)
#pragma unroll
        for (int m = 0; m < 4; ++m) { bf16_t* rowp = J.O + (size_t)(row0 + ai * HALF + m * 16) * J.ldc + col0;
#pragma unroll
            for (int bj = 0; bj < 2; ++bj) { f32x4 v0 = acc[ai][bj][m][0], v1 = acc[ai][bj][m][1];
                if (J.kind == 1) { v0 = v0 * sc[bj][0]; v1 = v1 * sc[bj][1]; }
                if (J.kind == 2) { const u32x4 p = *(const u32x4*)(rowp + bj * HALF);
                    v0 = (f32x4){bflo(p.x) * silu_f(v0[0]), bfhi(p.x) * silu_f(v0[1]), bflo(p.y) * silu_f(v0[2]), bfhi(p.y) * silu_f(v0[3])};
                    v1 = (f32x4){bflo(p.z) * silu_f(v1[0]), bfhi(p.z) * silu_f(v1[1]), bflo(p.w) * silu_f(v1[2]), bfhi(p.w) * silu_f(v1[3])}; }
                u32x4 w; w.x = cvt_pk_bf16(v0[0], v0[1]); w.y = cvt_pk_bf16(v0[2], v0[3]); w.z = cvt_pk_bf16(v1[0], v1[1]); w.w = cvt_pk_bf16(v1[2], v1[3]);
                *(u32x4*)(rowp + bj * HALF) = w; } }
}

__device__ __forceinline__ void gemm_phase(LAS unsigned char* lds, const Job& J, const int tid) {
    constexpr bool ALIGN_EPI = true;
    const int wid = __builtin_amdgcn_readfirstlane(tid >> 6), lane = tid & 63, wr = wid >> 2, wc = wid & 3, fr = lane & 15, fq = lane >> 4;
    const int K = J.K, nt = K / BK;
    const bool perm = (J.kind != 3);
    StaticOrder S; S.init(J.M, J.N, J.G, J.c);
    unsigned voffA[2], voffB[2];
#pragma unroll
    for (int i = 0; i < 2; ++i) { int R, C; stage_rc(tid * 16 + i * 8192, R, C); const int Rb = perm ? ((R & ~31) + perm32(R & 31)) : R;
        voffA[i] = (unsigned)(R * J.lda + C) * 2u; voffB[i] = (unsigned)(Rb * J.ldb + C) * 2u; }
    const size_t kstep = (size_t)(BK * 2);
    const size_t hstepA = (size_t)HALF * J.lda * 2, hstepB = (size_t)HALF * J.ldb * 2;
    const size_t tstepA = 2 * hstepA, tstepB = 2 * hstepB;
    const unsigned ldsw = (unsigned)wid * 1024u;
    const int aoff = lds_byte(wr * 64 + fr, fq * 8), boff = lds_byte(wc * 32 + fr, fq * 8);
#define PG8_SA(b, h) (((b) * 2 + (h)) * HTB)
#define PG8_SB(b, h) ((4 + (b) * 2 + (h)) * HTB)
#define PG8_STAGE(bufoff, gbase, voff) do { _Pragma("unroll") for (int _i = 0; _i < 2; ++_i) \
        __builtin_amdgcn_global_load_lds((const unsigned*)((const char*)(gbase) + (voff)[_i]), (LAS unsigned*)(lds + (bufoff) + ldsw + _i * 8192), 16, 0, 0); } while (0)
#define PG8_LDA(dst, b, h) do { _Pragma("unroll") for (int m = 0; m < 4; ++m) _Pragma("unroll") for (int k = 0; k < 2; ++k) dst[m][k] = *(const LAS bf16x8*)(lds + PG8_SA(b, h) + aoff + m * 2048 + k * 1024); } while (0)
#define PG8_LDB(dst, b, h) do { _Pragma("unroll") for (int n = 0; n < 2; ++n) _Pragma("unroll") for (int k = 0; k < 2; ++k) dst[n][k] = *(const LAS bf16x8*)(lds + PG8_SB(b, h) + boff + n * 2048 + k * 1024); } while (0)
#define PG8_MMA(ai, bj, At, Bt) do { __builtin_amdgcn_s_setprio(1); _Pragma("unroll") for (int m = 0; m < 4; ++m) _Pragma("unroll") for (int n = 0; n < 2; ++n) _Pragma("unroll") for (int k = 0; k < 2; ++k) \
        acc[ai][bj][m][n] = __builtin_amdgcn_mfma_f32_16x16x32_bf16(Bt[n][k], At[m][k], acc[ai][bj][m][n], 0, 0, 0); __builtin_amdgcn_s_setprio(0); } while (0)
#define PG8_WAIT_V(n) asm volatile("s_waitcnt vmcnt(" #n ")" ::: "memory")
#define PG8_WAIT_L(n) asm volatile("s_waitcnt lgkmcnt(" #n ")" ::: "memory")
#define PG8_BAR __builtin_amdgcn_s_barrier()
#define PG8_SCHED __builtin_amdgcn_sched_barrier(0)
#define PG8_APTR(u) ((const char*)J.A + (size_t)(u).pm * tstepA + (size_t)((u).pn / J.grp_tiles) * (size_t)J.grp_stride * 2)
#define PG8_BPTR(u) ((const char*)J.Bt + (size_t)(u).pn * tstepB)
    Unit cur, nxt; int ui = 0;
    if (!S.next(0, cur)) return;
    f32x4 acc[2][2][4][2];
#pragma unroll
    for (int a = 0; a < 2; ++a)
#pragma unroll
        for (int b = 0; b < 2; ++b)
#pragma unroll
            for (int m = 0; m < 4; ++m)
#pragma unroll
                for (int n = 0; n < 2; ++n) acc[a][b][m][n] = (f32x4){0.f, 0.f, 0.f, 0.f};
    bf16x8 At[4][2], B0[2][2], B1[2][2];
    const char* cA = PG8_APTR(cur); const char* cB = PG8_BPTR(cur);
    PG8_STAGE(PG8_SB(0, 0), cB, voffB); PG8_STAGE(PG8_SB(0, 1), cB + hstepB, voffB); PG8_STAGE(PG8_SA(0, 0), cA, voffA); PG8_STAGE(PG8_SA(0, 1), cA + hstepA, voffA);
    if (wr == 1) PG8_BAR;
    PG8_WAIT_V(2); PG8_BAR;
    PG8_STAGE(PG8_SB(1, 0), cB + kstep, voffB); PG8_STAGE(PG8_SA(1, 0), cA + kstep, voffA); PG8_STAGE(PG8_SB(1, 1), cB + hstepB + kstep, voffB);
    PG8_WAIT_V(6); PG8_BAR;
    for (;;) {
        const bool has_next = S.next(ui + 1, nxt);
        const char* nA = has_next ? PG8_APTR(nxt) : cA; const char* nB = has_next ? PG8_BPTR(nxt) : cB;
        for (int t = 0; t < nt; t += 2) {
            const bool last = (t == nt - 2);
            const char* a1 = cA + (size_t)(t + 1) * kstep;
            const char* a2 = last ? nA : cA + (size_t)(t + 2) * kstep; const char* b2 = last ? nB : cB + (size_t)(t + 2) * kstep;
            const char* a3 = a2 + kstep; const char* b3 = b2 + kstep;
            PG8_LDB(B0, 0, 0); PG8_LDB(B1, 0, 1); PG8_SCHED; PG8_LDA(At, 0, 0); PG8_STAGE(PG8_SA(1, 1), a1 + hstepA, voffA);
            PG8_WAIT_V(8); PG8_WAIT_L(0); PG8_BAR; PG8_MMA(0, 0, At, B0); PG8_MMA(0, 1, At, B1); PG8_BAR; PG8_SCHED;
            PG8_LDA(At, 0, 1); PG8_STAGE(PG8_SB(0, 0), b2, voffB); PG8_STAGE(PG8_SB(0, 1), b2 + hstepB, voffB); PG8_STAGE(PG8_SA(0, 0), a2, voffA);
            PG8_WAIT_V(8); PG8_WAIT_L(0); PG8_BAR; PG8_MMA(1, 0, At, B0); PG8_MMA(1, 1, At, B1); PG8_BAR; PG8_SCHED;
            PG8_LDB(B0, 1, 0); PG8_LDB(B1, 1, 1); PG8_SCHED; PG8_LDA(At, 1, 0); PG8_STAGE(PG8_SA(0, 1), a2 + hstepA, voffA);
            PG8_WAIT_V(8); PG8_WAIT_L(0); PG8_BAR; PG8_MMA(0, 0, At, B0); PG8_MMA(0, 1, At, B1); PG8_BAR; PG8_SCHED;
            PG8_LDA(At, 1, 1); PG8_STAGE(PG8_SB(1, 0), b3, voffB); PG8_STAGE(PG8_SB(1, 1), b3 + hstepB, voffB); PG8_STAGE(PG8_SA(1, 0), a3, voffA);
            PG8_WAIT_V(8); PG8_WAIT_L(0); PG8_BAR; PG8_MMA(1, 0, At, B0); PG8_MMA(1, 1, At, B1); PG8_BAR; PG8_SCHED;
        }
        if constexpr (ALIGN_EPI) { if (wr == 0) PG8_BAR; }
        epilogue(J, acc, cur, wr, wc, fr, fq);
        if (!has_next) break;
#pragma unroll
        for (int a = 0; a < 2; ++a)
#pragma unroll
            for (int b = 0; b < 2; ++b)
#pragma unroll
                for (int m = 0; m < 4; ++m)
#pragma unroll
                    for (int n = 0; n < 2; ++n) acc[a][b][m][n] = (f32x4){0.f, 0.f, 0.f, 0.f};
        cur = nxt; cA = nA; cB = nB; ++ui;
        if constexpr (ALIGN_EPI) { if (wr == 1) PG8_BAR; }
    }
    PG8_WAIT_V(0);
    if constexpr (!ALIGN_EPI) { if (wr == 0) PG8_BAR; }
    PG8_BAR;
#undef PG8_SA
#undef PG8_SB
#undef PG8_STAGE
#undef PG8_LDA
#undef PG8_LDB
#undef PG8_MMA
#undef PG8_WAIT_V
#undef PG8_WAIT_L
#undef PG8_BAR
#undef PG8_SCHED
#undef PG8_APTR
#undef PG8_BPTR
}
}

constexpr int RING_OFF = 0, RING_BYTES = 131072;
constexpr int LDSCTL_OFF = RING_BYTES, MISC_OFF = LDSCTL_OFF + 320;
constexpr int LDS_BYTES = 147456;
constexpr int NWAVES = 8;

constexpr int CW_BAR = 4096;

#define RLX_AGENT __ATOMIC_RELAXED, __HIP_MEMORY_SCOPE_AGENT
#define LDS_WAIT() asm volatile("s_waitcnt lgkmcnt(0)" ::: "memory")
#define VM_WAIT() asm volatile("s_waitcnt vmcnt(0)" ::: "memory")
__device__ __forceinline__ unsigned f2bf(float f) { unsigned u = __builtin_bit_cast(unsigned, f); return (u + 0x7fffu + ((u >> 16) & 1u)) >> 16; }
__device__ __forceinline__ unsigned pk2(float lo, float hi) { return f2bf(lo) | (f2bf(hi) << 16); }
__device__ __forceinline__ float bf2f(bf16_t b) { return __uint_as_float((unsigned)b << 16); }

#define XB_TMO      128
#define XB_XCNT(j)  (256  + 64 * (j))
#define XB_XSUB(j)  (1280 + 64 * (j))
#define XB_XGEN(j)  (2304 + 64 * (j))
#define XB_TOP      3328
#define XB_TOPGEN   3392
#define XCD_BAR_WORDS 3456
#define XB_SPIN_CAP (1u << 20)

__device__ __forceinline__ unsigned xb_ld(unsigned* p)              { return __hip_atomic_load(p, __ATOMIC_RELAXED, __HIP_MEMORY_SCOPE_AGENT); }
__device__ __forceinline__ unsigned xb_add(unsigned* p, unsigned v) { return __hip_atomic_fetch_add(p, v, __ATOMIC_RELAXED, __HIP_MEMORY_SCOPE_AGENT); }
__device__ __forceinline__ unsigned xb_xcc_id() { return (unsigned)__builtin_amdgcn_s_getreg((3 << 11) | 20) & 0xFu; }
#define XB_SPIN(cond, bar) do { unsigned _sp = 0; while (cond) { __builtin_amdgcn_s_sleep(1); \
    if ((++_sp & 255u) == 0u) { if (xb_ld(&(bar)[XB_TMO])) break; if (_sp > XB_SPIN_CAP) { atomicAdd(&(bar)[XB_TMO], 1u); break; } } } } while (0)

struct XcdBarrier { unsigned* bar; unsigned x; volatile LAS unsigned* st; };

__device__ __forceinline__ XcdBarrier xcd_barrier_post(unsigned* bar, volatile LAS unsigned* st) {
    XcdBarrier b; b.bar = bar; b.x = xb_xcc_id(); b.st = st;
    if (threadIdx.x == 0) (void)xb_add(&bar[XB_XCNT(b.x)], 1u);
    return b;
}
__device__ __forceinline__ void xcd_barrier_complete(unsigned* bar, unsigned x, unsigned& nloc, unsigned& nx) {
    const unsigned G = gridDim.x * gridDim.y * gridDim.z;
    unsigned sum, cnt, mine, sp = 0u;
    for (;;) {
        sum = 0u; cnt = 0u; mine = 0u;
#pragma unroll
        for (unsigned j = 0; j < 16; ++j) { const unsigned c = xb_ld(&bar[XB_XCNT(j)]); sum += c; cnt += (c > 0u) ? 1u : 0u; mine = (j == x) ? c : mine; }
        if (sum == G) break;
        __builtin_amdgcn_s_sleep(1);
        if ((++sp & 255u) == 0u) { if (xb_ld(&bar[XB_TMO])) break; if (sp > XB_SPIN_CAP) { atomicAdd(&bar[XB_TMO], 1u); break; } }
    }
    nloc = mine > 0u ? mine : 1u; nx = cnt > 0u ? cnt : 1u;
}
__device__ __forceinline__ void xcd_barrier(const XcdBarrier& b) {
    asm volatile("s_waitcnt vmcnt(0)" ::: "memory");
    __syncthreads();
    if (threadIdx.x == 0) {
        unsigned* bar = b.bar;
        __builtin_amdgcn_s_waitcnt(0);
        unsigned nloc = b.st[0], nx = b.st[1];
        if (nloc == 0u) { xcd_barrier_complete(bar, b.x, nloc, nx); b.st[0] = nloc; b.st[1] = nx; }
        const unsigned old = xb_add(&bar[XB_XSUB(b.x)], 1u);
        const unsigned gen = old / nloc;
        if (old + 1u == (gen + 1u) * nloc) {
            __builtin_amdgcn_fence(__ATOMIC_RELEASE, "agent");
            asm volatile("s_waitcnt vmcnt(0)" ::: "memory");
            const unsigned og = xb_add(&bar[XB_TOP], 1u);
            const unsigned tg = og / nx;
            if (og + 1u == (tg + 1u) * nx) xb_add(&bar[XB_TOPGEN], 1u);
            else XB_SPIN(xb_ld(&bar[XB_TOPGEN]) == tg, bar);
            __builtin_amdgcn_fence(__ATOMIC_ACQUIRE, "agent");
            xb_add(&bar[XB_XGEN(b.x)], 1u);
            asm volatile("s_waitcnt vmcnt(0)" ::: "memory");
        } else {
            XB_SPIN(xb_ld(&bar[XB_XGEN(b.x)]) == gen, bar);
            __builtin_amdgcn_fence(__ATOMIC_ACQUIRE, "agent");
            asm volatile("s_waitcnt vmcnt(0)" ::: "memory");
        }
    }
    __syncthreads();
}

struct Args {
    const float* x; const float* mem; const float* norm_g; const float* mem_norm_g; const float* w_kv; const float* w_out;
    const float* pool_w_in; const float* pool_w_grp; const float* pool_scale; const float* hgrn_w_in; const float* hgrn_lb;
    const float* hgrn_norm_g; const float* final_g; float* out; unsigned char* ws; int ph_lo, ph_hi;
};

__device__ __forceinline__ float wave_sum(float v) {
#pragma unroll
    for (int o = 1; o < 64; o <<= 1) v += __shfl_xor(v, o);
    return v;
}
__device__ __forceinline__ float wave_max(float v) {
#pragma unroll
    for (int o = 1; o < 64; o <<= 1) v = fmaxf(v, __shfl_xor(v, o));
    return v;
}

__device__ __forceinline__ void transpose_item(const float* W, int N, int k0, int n0, bf16_t* WT, int ldt, int orow0, LAS float* scr, int lane) {
#pragma unroll 8
    for (int i = 0; i < 32; ++i) { const int kk = 2 * i + (lane >> 5); scr[kk * 33 + (lane & 31)] = W[(size_t)(k0 + kk) * N + n0 + (lane & 31)]; }
    LDS_WAIT(); asm volatile("" ::: "memory");
    const int c = lane & 7;
#pragma unroll
    for (int j = 0; j < 4; ++j) { const int n = (lane >> 3) + 8 * j; const LAS float* s = scr + (8 * c) * 33 + n;
        u32x4 o; o.x = pk2(s[0 * 33], s[1 * 33]); o.y = pk2(s[2 * 33], s[3 * 33]); o.z = pk2(s[4 * 33], s[5 * 33]); o.w = pk2(s[6 * 33], s[7 * 33]);
        *(u32x4*)(WT + (size_t)(orow0 + n) * ldt + k0 + 8 * c) = o; }
    LDS_WAIT(); asm volatile("" ::: "memory");
}

__device__ __forceinline__ void rms_row_to_bf16(const float* xrow, const float* g, bf16_t* orow, int lane) {
    const f32x4* xr = (const f32x4*)xrow + lane; const f32x4* gr = (const f32x4*)g + lane;
    f32x4 v[8]; float s = 0.f;
#pragma unroll
    for (int j = 0; j < 8; ++j) { v[j] = xr[64 * j]; s += (v[j].x * v[j].x + v[j].y * v[j].y) + (v[j].z * v[j].z + v[j].w * v[j].w); }
    const float r = 1.0f / sqrtf(wave_sum(s) * (1.f / DM) + EPS);
    unsigned long long* o8 = (unsigned long long*)orow + lane;
#pragma unroll
    for (int j = 0; j < 8; ++j) { const f32x4 gg = gr[64 * j];
        o8[64 * j] = (unsigned long long)pk2(v[j].x * r * gg.x, v[j].y * r * gg.y) | ((unsigned long long)pk2(v[j].z * r * gg.z, v[j].w * r * gg.w) << 32); }
}
__device__ __forceinline__ void rms_row_f32(float* xrow, const float* g, int lane) {
    f32x4* xr = (f32x4*)xrow + lane; const f32x4* gr = (const f32x4*)g + lane;
    f32x4 v[8]; float s = 0.f;
#pragma unroll
    for (int j = 0; j < 8; ++j) { v[j] = xr[64 * j]; s += (v[j].x * v[j].x + v[j].y * v[j].y) + (v[j].z * v[j].z + v[j].w * v[j].w); }
    const float r = 1.0f / sqrtf(wave_sum(s) * (1.f / DM) + EPS);
#pragma unroll
    for (int j = 0; j < 8; ++j) { const f32x4 gg = gr[64 * j]; xr[64 * j] = (f32x4){v[j].x * r * gg.x, v[j].y * r * gg.y, v[j].z * r * gg.z, v[j].w * r * gg.w}; }
}

__device__ __forceinline__ float dot256(const bf16_t* row, const LAS float* vec) {
    float s = 0.f;
#pragma unroll 4
    for (int c = 0; c < 32; ++c) { const u32x4 w = *(const u32x4*)(row + 8 * c); const LAS f32x4* vv = (const LAS f32x4*)(vec + 8 * c); const f32x4 a = vv[0], b = vv[1];
        s += pg8::bflo(w.x) * a.x + pg8::bfhi(w.x) * a.y + pg8::bflo(w.y) * a.z + pg8::bfhi(w.y) * a.w + pg8::bflo(w.z) * b.x + pg8::bfhi(w.z) * b.y + pg8::bflo(w.w) * b.z + pg8::bfhi(w.w) * b.w; }
    return s;
}

__global__ void __launch_bounds__(NWAVES * 64, 2) fwd_kernel(Args a) {
    extern __shared__ __attribute__((aligned(16))) unsigned char lds_raw[];
    LAS unsigned char* lds = (LAS unsigned char*)lds_raw;
    volatile LAS unsigned* MISC = (volatile LAS unsigned*)(lds + MISC_OFF);
    const int tid0 = threadIdx.x;
    const int G = gridDim.x, bx = blockIdx.x;
    const int vcu = (G % 8 == 0) ? (bx % 8) * (G / 8) + bx / 8 : bx;
    unsigned char* ws = a.ws;
    unsigned* ctl = (unsigned*)(ws + WS_CTL);
    for (int u = tid0; u < (LDS_BYTES - LDSCTL_OFF) / 4; u += NWAVES * 64) ((LAS unsigned*)(lds + LDSCTL_OFF))[u] = 0u;
    __syncthreads();
    XcdBarrier bar; bar.bar = ctl + CW_BAR; bar.x = 0; bar.st = nullptr;
    const bool multi = (a.ph_hi - a.ph_lo) > 1;
    if (multi) bar = xcd_barrier_post(ctl + CW_BAR, MISC + 8);

    bf16_t* Wt_in0 = (bf16_t*)(ws + WS_WIN0); bf16_t* Wt_in1 = (bf16_t*)(ws + WS_WIN1);
    bf16_t* Wt_out0 = (bf16_t*)(ws + WS_WOUT0); bf16_t* Wt_out1 = (bf16_t*)(ws + WS_WOUT1);
    bf16_t* Wt_kv = (bf16_t*)(ws + WS_WKV); bf16_t* Wt_grp = (bf16_t*)(ws + WS_WGRP);
    bf16_t* MEMN = (bf16_t*)(ws + WS_MEMN); bf16_t* KMAT = (bf16_t*)(ws + WS_KMAT); bf16_t* VT = (bf16_t*)(ws + WS_VT);
    bf16_t* H = (bf16_t*)(ws + WS_H); bf16_t* U = (bf16_t*)(ws + WS_U); bf16_t* POOL = (bf16_t*)(ws + WS_POOL); bf16_t* P1 = (bf16_t*)(ws + WS_P1);
    const int NGW = G * NWAVES;

    for (int p = a.ph_lo; p < a.ph_hi; ++p) {
        int tid = threadIdx.x; asm volatile("" : "+v"(tid));
        const int lane = tid & 63, wave = __builtin_amdgcn_readfirstlane(tid >> 6), gw = vcu * NWAVES + wave;
        pg8::Job J; J.kind = -1; J.grp_tiles = 1 << 20; J.grp_stride = 0; J.colscale = nullptr; J.base = nullptr; J.out = nullptr; J.O = nullptr; J.ldc = 0; J.G = G; J.c = bx;
        J.A = nullptr; J.Bt = nullptr; J.lda = 0; J.ldb = 0; J.K = 0; J.M = 0; J.N = 0;
        switch (p) {
            case 1: J.kind = 0; J.A = H; J.lda = DM; J.Bt = Wt_in0; J.ldb = DM; J.K = DM; J.M = T; J.N = N0A; J.O = U; J.ldc = N0A; break;
            case 2: if (bx < 32) { J.kind = 0; J.A = MEMN; J.lda = DM; J.Bt = Wt_kv; J.ldb = DM; J.K = DM; J.M = MROWS; J.N = 2048; J.O = KMAT; J.ldc = 2048; J.G = 32; J.c = bx; }
                    else if (bx < 64) { J.kind = 0; J.A = Wt_kv + (size_t)2048 * DM; J.lda = DM; J.Bt = MEMN; J.ldb = DM; J.K = DM; J.M = 2048; J.N = MROWS; J.O = VT; J.ldc = MROWS; J.G = 32; J.c = bx - 32; }
                    break;
            case 3: J.kind = 1; J.A = POOL; J.lda = E_MIX; J.Bt = Wt_grp; J.ldb = PGRP; J.K = PGRP; J.M = T; J.N = E_MIX; J.grp_tiles = 3; J.grp_stride = PGRP; J.O = U; J.ldc = N0A; J.colscale = a.pool_scale; break;
            case 4: J.kind = 2; J.A = H; J.lda = DM; J.Bt = Wt_in0 + (size_t)N0A * DM; J.ldb = DM; J.K = DM; J.M = T; J.N = E_BR; J.O = U; J.ldc = N0A; break;
            case 5: J.kind = 3; J.A = U; J.lda = N0A; J.Bt = Wt_out0; J.ldb = E_BR; J.K = E_BR; J.M = T; J.N = DM; J.base = a.x; J.out = a.out; J.ldc = DM; break;
            case 7: J.kind = 0; J.A = H; J.lda = DM; J.Bt = Wt_in1; J.ldb = DM; J.K = DM; J.M = T; J.N = N1A; J.O = P1; J.ldc = N1A; break;
            case 9: J.kind = 2; J.A = H; J.lda = DM; J.Bt = Wt_in1 + (size_t)N1A * DM; J.ldb = DM; J.K = DM; J.M = T; J.N = E_BR; J.O = P1 + 6144; J.ldc = N1A; break;
            case 10: J.kind = 3; J.A = P1 + 6144; J.lda = N1A; J.Bt = Wt_out1; J.ldb = E_BR; J.K = E_BR; J.M = T; J.N = DM; J.base = a.out; J.out = a.out; J.ldc = DM; break;
            default: break;
        }
        if (J.kind >= 0) pg8::gemm_phase(lds + RING_OFF, J, tid);

        if (p == 0) {
            LAS float* scr = (LAS float*)(lds + RING_OFF + wave * 16384);
            constexpr int I_IN0 = (DM / 64) * (N0 / 32), I_IN1 = (DM / 64) * (N1 / 32), I_OUT = (E_BR / 64) * (DM / 32), I_KV = (DM / 64) * (2048 / 32), I_GRP = (PGRP / 64) * (PGRP / 32);
            constexpr int NITEMS = I_IN0 + I_IN1 + 2 * I_OUT + 2 * I_KV + 4 * I_GRP;
            for (int it = gw; it < NITEMS; it += NGW) {
                int r = it;
                if (r < I_IN0) { const int nb = N0 / 32, kb = r / nb, n0 = 32 * (r % nb); transpose_item(a.pool_w_in, N0, 64 * kb, n0, Wt_in0, DM, n0, scr, lane); continue; } r -= I_IN0;
                if (r < I_IN1) { const int nb = N1 / 32, kb = r / nb, n0 = 32 * (r % nb); transpose_item(a.hgrn_w_in, N1, 64 * kb, n0, Wt_in1, DM, n0, scr, lane); continue; } r -= I_IN1;
                if (r < 2 * I_OUT) { const int l = r / I_OUT; r -= l * I_OUT; const int nb = DM / 32, kb = r / nb, n0 = 32 * (r % nb);
                    transpose_item(a.w_out + (size_t)l * E_BR * DM, DM, 64 * kb, n0, l ? Wt_out1 : Wt_out0, E_BR, n0, scr, lane); continue; } r -= 2 * I_OUT;
                if (r < 2 * I_KV) { const int l = r / I_KV; r -= l * I_KV; const int nb = 2048 / 32, kb = r / nb, n0 = 32 * (r % nb);
                    const int orow0 = (n0 < 1024) ? (l * 1024 + n0) : (2048 + l * 1024 + (n0 - 1024));
                    transpose_item(a.w_kv + (size_t)l * DM * 2048, 2048, 64 * kb, n0, Wt_kv, DM, orow0, scr, lane); continue; } r -= 2 * I_KV;
                { const int g = r / I_GRP; r -= g * I_GRP; const int nb = PGRP / 32, kb = r / nb, n0 = 32 * (r % nb);
                    transpose_item(a.pool_w_grp + (size_t)g * PGRP * PGRP, PGRP, 64 * kb, n0, Wt_grp, PGRP, g * PGRP + n0, scr, lane); }
            }
            for (int m = gw; m < T + MROWS; m += NGW) {
                if (m < T) rms_row_to_bf16(a.x + (size_t)m * DM, a.norm_g, H + (size_t)m * DM, lane);
                else rms_row_to_bf16(a.mem + (size_t)(m - T) * DM, a.mem_norm_g, MEMN + (size_t)(m - T) * DM, lane);
            }
        } else if (p == 2) {
            if (bx >= 64) {
                const int NP = (G - 64) * NWAVES * 64, me = (bx - 64) * (NWAVES * 64) + tid;
                constexpr int RB = 16, NCH = E_MIX / 8, NTASK = (T / RB) * NCH;
                for (int task = me; task < NTASK; task += NP) {
                    const int ch = task % NCH, rb = task / NCH, grp = ch / (PGRP / 8), w = 2 << grp;
                    const int t0 = rb * RB, tl0 = t0 % SEQ;
                    const bf16_t* up = U + (size_t)t0 * N0A + ch * 8;
                    float s[8];
#pragma unroll
                    for (int e = 0; e < 8; ++e) s[e] = 0.f;
                    for (int d = 1; d <= w; ++d) if (tl0 - d >= 0) { const u32x4 v = *(const u32x4*)(up - (long)d * N0A);
                        s[0] += pg8::bflo(v.x); s[1] += pg8::bfhi(v.x); s[2] += pg8::bflo(v.y); s[3] += pg8::bfhi(v.y); s[4] += pg8::bflo(v.z); s[5] += pg8::bfhi(v.z); s[6] += pg8::bflo(v.w); s[7] += pg8::bfhi(v.w); }
                    for (int r = 0; r < RB; ++r) {
                        const int tl = tl0 + r;
                        const u32x4 v = *(const u32x4*)(up + (size_t)r * N0A);
                        float c[8] = {pg8::bflo(v.x), pg8::bfhi(v.x), pg8::bflo(v.y), pg8::bfhi(v.y), pg8::bflo(v.z), pg8::bfhi(v.z), pg8::bflo(v.w), pg8::bfhi(v.w)};
#pragma unroll
                        for (int e = 0; e < 8; ++e) s[e] += c[e];
                        if (tl - w >= 0) { const u32x4 o = *(const u32x4*)(up + (long)(r - w) * N0A);
                            s[0] -= pg8::bflo(o.x); s[1] -= pg8::bfhi(o.x); s[2] -= pg8::bflo(o.y); s[3] -= pg8::bfhi(o.y); s[4] -= pg8::bflo(o.z); s[5] -= pg8::bfhi(o.z); s[6] -= pg8::bflo(o.w); s[7] -= pg8::bfhi(o.w); }
                        const float inv = 1.0f / (float)((tl + 1 < w) ? (tl + 1) : w);
                        u32x4 o4; o4.x = pk2(s[0] * inv - c[0], s[1] * inv - c[1]); o4.y = pk2(s[2] * inv - c[2], s[3] * inv - c[3]); o4.z = pk2(s[4] * inv - c[4], s[5] * inv - c[5]); o4.w = pk2(s[6] * inv - c[6], s[7] * inv - c[7]);
                        *(u32x4*)(POOL + (size_t)(t0 + r) * E_MIX + ch * 8) = o4;
                    }
                }
            }
        } else if (p == 3 || p == 8) {
            const int layer = (p == 3) ? 0 : 1;
            bf16_t* Q = layer ? (P1 + 9216) : (U + 3072); const int ldq = layer ? N1A : N0A;
            LAS float* qs = (LAS float*)(lds + RING_OFF + wave * 4096);
            LAS float* ps = qs + 256;
            int w0, nw;
            if (p == 8) { if (bx < 96) { w0 = -1; nw = 1; } else { w0 = (bx - 96) * NWAVES + wave; nw = (G - 96) * NWAVES; } }
            else { w0 = gw; nw = NGW; }
            if (w0 >= 0) for (int task = w0; task < T * 4; task += nw) {
                const int hd = task & 3, t = task >> 2, b = t / SEQ;
                bf16_t* qrow = Q + (size_t)t * ldq + hd * 256;
                { const u32x2 w = *(const u32x2*)(qrow + 4 * lane); *(LAS f32x4*)(qs + 4 * lane) = (f32x4){pg8::bflo(w.x), pg8::bfhi(w.x), pg8::bflo(w.y), pg8::bfhi(w.y)}; }
                LDS_WAIT(); asm volatile("" ::: "memory");
                float sc[4]; float mx = -3.0e38f;
#pragma unroll
                for (int j = 0; j < 4; ++j) { const int m = lane + 64 * j; sc[j] = dot256(KMAT + (size_t)(b * NMEM + m) * 2048 + layer * 1024 + hd * 256, qs) * 0.0625f; mx = fmaxf(mx, sc[j]); }
                mx = wave_max(mx); float sm = 0.f;
#pragma unroll
                for (int j = 0; j < 4; ++j) { sc[j] = __expf(sc[j] - mx); sm += sc[j]; ps[lane + 64 * j] = sc[j]; }
                sm = wave_sum(sm); const float inv = 1.0f / sm;
                LDS_WAIT(); asm volatile("" ::: "memory");
                float o[4];
#pragma unroll
                for (int j = 0; j < 4; ++j) { const int d = 4 * lane + j; o[j] = dot256(VT + (size_t)(layer * 1024 + hd * 256 + d) * MROWS + b * NMEM, ps) * inv; }
                u32x2 ow; ow.x = pk2(o[0], o[1]); ow.y = pk2(o[2], o[3]);
                *(u32x2*)(qrow + 4 * lane) = ow;
                LDS_WAIT(); asm volatile("" ::: "memory");
            }
            if (p == 8 && bx < 96) {
                const int b = bx / HG_H, hh = bx % HG_H;
                LAS float* Qs = (LAS float*)(lds + RING_OFF);
                LAS float* Fs = Qs + 16 * 128; LAS float* Ks = Fs + 16 * 128; LAS float* Vs = Ks + 16 * 128;
                LAS float* OP = Vs + 16 * 128;
                const int v = tid & 127, kg = tid >> 7;
                float St[32];
#pragma unroll
                for (int i = 0; i < 32; ++i) St[i] = 0.f;
                for (int t0 = 0; t0 < SEQ; t0 += 16) {
#pragma unroll
                    for (int r = 0; r < 4; ++r) { const int idx = tid + 512 * r, tok = idx >> 7, k = idx & 127;
                        const bf16_t* row = P1 + (size_t)(b * SEQ + t0 + tok) * N1A + hh * 128 + k;
                        const float qv = bf2f(row[0]), fx = bf2f(row[3072]), iv = bf2f(row[6144]);
                        const float l0 = a.hgrn_lb[hh * 128 + k], l1 = a.hgrn_lb[E_MIX + hh * 128 + k];
                        const float lb = 1.0f / (1.0f + __expf(l0 - l1));
                        const float f = lb + (1.0f - lb) / (1.0f + __expf(-fx));
                        Qs[idx] = qv / (1.0f + __expf(-qv)) * 0.08838834764831845f; Fs[idx] = f; Ks[idx] = 1.0f - f; Vs[idx] = iv; }
                    __syncthreads();
                    for (int tok = 0; tok < 16; ++tok) {
                        const float vv = Vs[tok * 128 + v]; float op = 0.f;
#pragma unroll
                        for (int i4 = 0; i4 < 8; ++i4) { const f32x4 f4 = *(const LAS f32x4*)(Fs + tok * 128 + kg * 32 + 4 * i4), k4 = *(const LAS f32x4*)(Ks + tok * 128 + kg * 32 + 4 * i4), q4 = *(const LAS f32x4*)(Qs + tok * 128 + kg * 32 + 4 * i4);
                            St[4 * i4 + 0] = f4.x * St[4 * i4 + 0] + k4.x * vv; op += q4.x * St[4 * i4 + 0];
                            St[4 * i4 + 1] = f4.y * St[4 * i4 + 1] + k4.y * vv; op += q4.y * St[4 * i4 + 1];
                            St[4 * i4 + 2] = f4.z * St[4 * i4 + 2] + k4.z * vv; op += q4.z * St[4 * i4 + 2];
                            St[4 * i4 + 3] = f4.w * St[4 * i4 + 3] + k4.w * vv; op += q4.w * St[4 * i4 + 3]; }
                        OP[(tok * 4 + kg) * 128 + v] = op;
                    }
                    __syncthreads();
#pragma unroll
                    for (int r = 0; r < 2; ++r) { const int tok = wave * 2 + r;
                        float o0 = 0.f, o1 = 0.f;
#pragma unroll
                        for (int g4 = 0; g4 < 4; ++g4) { o0 += OP[(tok * 4 + g4) * 128 + lane]; o1 += OP[(tok * 4 + g4) * 128 + 64 + lane]; }
                        const float ss = wave_sum(o0 * o0 + o1 * o1); const float rn = 1.0f / sqrtf(ss * (1.f / 128.f) + EPS);
                        bf16_t* orow = P1 + (size_t)(b * SEQ + t0 + tok) * N1A + 6144 + hh * 128;
                        orow[lane] = (bf16_t)f2bf(o0 * rn * a.hgrn_norm_g[hh * 128 + lane]); orow[64 + lane] = (bf16_t)f2bf(o1 * rn * a.hgrn_norm_g[hh * 128 + 64 + lane]); }
                    __syncthreads();
                }
            }
        } else if (p == 6) {
            for (int m = gw; m < T; m += NGW) rms_row_to_bf16(a.out + (size_t)m * DM, a.norm_g + DM, H + (size_t)m * DM, lane);
        } else if (p == 11) {
            for (int m = gw; m < T; m += NGW) rms_row_f32(a.out + (size_t)m * DM, a.final_g, lane);
        }
        if (p + 1 < a.ph_hi) xcd_barrier(bar);
    }
}

constexpr int N_PHASES = 12;

extern "C" void kernel_launch(void* const* d_in, const int* in_sizes, int n_in, void* d_out, int out_size, void* d_ws, size_t ws_size, hipStream_t stream) {
    static int grid = 0;
    if (grid == 0) {
        if (n_in != 13 || in_sizes[0] != T * DM || out_size != T * DM || ws_size < WS_END) {
            fprintf(stderr, "kernel_launch: unexpected shapes / workspace (n_in %d, in0 %d, out %d, ws %zu < %zu); nothing launched\n", n_in, n_in > 0 ? in_sizes[0] : -1, out_size, ws_size, (size_t)WS_END); grid = -1; return; }
        int dev = 0, cus = 0, per_cu = 0;
        if (hipGetDevice(&dev) != hipSuccess || hipDeviceGetAttribute(&cus, hipDeviceAttributeMultiprocessorCount, dev) != hipSuccess) { grid = -1; return; }
        if (hipFuncSetAttribute((const void*)fwd_kernel, hipFuncAttributeMaxDynamicSharedMemorySize, LDS_BYTES) != hipSuccess) { fprintf(stderr, "kernel_launch: hipFuncSetAttribute failed\n"); grid = -1; return; }
        if (hipOccupancyMaxActiveBlocksPerMultiprocessor(&per_cu, (const void*)fwd_kernel, NWAVES * 64, LDS_BYTES) != hipSuccess || per_cu < 1) {
            fprintf(stderr, "kernel_launch: occupancy query reports %d workgroups per CU; nothing launched\n", per_cu); (void)hipGetLastError(); grid = -1; return; }
        grid = cus;
        if (grid < 128) { fprintf(stderr, "kernel_launch: needs >= 128 CUs\n"); grid = -1; return; }
    }
    if (grid < 0) return;
    if (hipMemsetAsync((char*)d_ws + WS_CTL, 0, CTL_ZERO_BYTES, stream) != hipSuccess) return;
    Args a{};
    a.x = (const float*)d_in[0]; a.mem = (const float*)d_in[1]; a.norm_g = (const float*)d_in[2]; a.mem_norm_g = (const float*)d_in[3]; a.w_kv = (const float*)d_in[4]; a.w_out = (const float*)d_in[5];
    a.pool_w_in = (const float*)d_in[6]; a.pool_w_grp = (const float*)d_in[7]; a.pool_scale = (const float*)d_in[8]; a.hgrn_w_in = (const float*)d_in[9]; a.hgrn_lb = (const float*)d_in[10];
    a.hgrn_norm_g = (const float*)d_in[11]; a.final_g = (const float*)d_in[12]; a.out = (float*)d_out; a.ws = (unsigned char*)d_ws;
#if MK_N_LAUNCHES == 1
    a.ph_lo = 0; a.ph_hi = N_PHASES;
    hipLaunchKernelGGL(fwd_kernel, dim3(grid), dim3(NWAVES * 64), LDS_BYTES, stream, a);
#else
    for (int p = 0; p < N_PHASES; ++p) { a.ph_lo = p; a.ph_hi = p + 1; hipLaunchKernelGGL(fwd_kernel, dim3(grid), dim3(NWAVES * 64), LDS_BYTES, stream, a); }
#endif
}
```

```cpp
#include <hip/hip_runtime.h>
#include <cstdio>
#include <cstdint>

#ifndef MK_N_LAUNCHES
#define MK_N_LAUNCHES 1
#endif

#define LAS __attribute__((address_space(3)))
typedef unsigned short bf16_t;
typedef short bf16x8 __attribute__((ext_vector_type(8)));
typedef float f32x4 __attribute__((ext_vector_type(4)));
typedef float f32x2 __attribute__((ext_vector_type(2)));
typedef unsigned u32x4 __attribute__((ext_vector_type(4)));
typedef unsigned u32x2 __attribute__((ext_vector_type(2)));

constexpr int BATCH = 4, SEQ = 4096, DM = 2048, T = BATCH * SEQ;
constexpr int NMEM = 256, MROWS = BATCH * NMEM;
constexpr int E_MIX = 3072, E_CA = 1024, E_BR = 4096;
constexpr int N0 = 8192, N1 = 14336, N0A = 4096, N1A = 10240;
constexpr int PGRP = 768;
constexpr int HG_H = 24, HG_D = 128;
constexpr float EPS = 1e-6f;

constexpr size_t MiB = 1u << 20;
constexpr size_t WS_CTL = 0, CTL_ZERO_BYTES = 1 * MiB;
constexpr size_t WS_WIN1 = 1 * MiB;
constexpr size_t WS_WOUT1 = 57 * MiB;
constexpr size_t WS_KMAT = 73 * MiB;
constexpr size_t WS_VT = 77 * MiB;
constexpr size_t WS_H = 81 * MiB;
constexpr size_t WS_BIG = 145 * MiB;
constexpr size_t WS_WIN0 = WS_BIG;
constexpr size_t WS_WOUT0 = WS_BIG + 32 * MiB;
constexpr size_t WS_WKV = WS_BIG + 48 * MiB;
constexpr size_t WS_WGRP = WS_BIG + 64 * MiB;
constexpr size_t WS_MEMN = WS_BIG + 69 * MiB;
constexpr size_t WS_U = WS_BIG + 73 * MiB;
constexpr size_t WS_POOL = WS_BIG + 201 * MiB;
constexpr size_t WS_P1 = WS_BIG;
constexpr size_t WS_END = WS_BIG + 320 * MiB;
static_assert(WS_POOL + (size_t)T * E_MIX * 2 <= WS_END, "ws map");

namespace pg8 {
constexpr int BM = 256, BK = 64, HALF = 128, HTB = HALF * BK * 2, STAGE_BYTES = 8 * HTB, NXCD = 8, WGM = 8;
__host__ __device__ __forceinline__ int lds_byte(int r, int c) { const int st = (r >> 4) * 2 + (c >> 5), rr = r & 15, cc = c & 31, ob = rr * 64 + cc * 2; return st * 1024 + (ob ^ (((ob >> 9) & 1) << 5)); }
__host__ __device__ __forceinline__ void stage_rc(int b, int& R, int& C) { const int st = b / 1024, sb = b % 1024, swz = sb ^ (((sb >> 9) & 1) << 5); R = (st >> 1) * 16 + swz / 64; C = (st & 1) * 32 + (swz % 64) / 2; }
__host__ __device__ __forceinline__ int perm32(int rho) { const int n = rho >> 4, i = rho & 15; return 8 * (i >> 2) + 4 * n + (i & 3); }

struct Unit { int pm, pn; };
struct Job {
    const bf16_t* A; const bf16_t* Bt; int lda, ldb, K, M, N, G, c, grp_tiles, grp_stride;
    int kind; bf16_t* O; int ldc; const float* colscale; const float* base; float* out;
};
struct StaticOrder {
    int nM, nN, nwg, G, c;
    __device__ void init(int M, int N, int G_, int c_) { nM = M / BM; nN = N / BM; nwg = nM * nN; G = G_; c = c_; }
    __device__ bool next(int i, Unit& u) const {
        const long L = (long)i * G + c; if (L >= nwg) return false;
        int wgid = (int)L; { const int q = nwg / NXCD, r = nwg % NXCD, xcd = wgid % NXCD, off = wgid / NXCD; wgid = (xcd < r ? xcd * (q + 1) : r * (q + 1) + (xcd - r) * q) + off; }
        const int nig = WGM * nN, gid = wgid / nig, fm = gid * WGM, gsz = (nM - fm) < WGM ? (nM - fm) : WGM;
        u.pm = fm + ((wgid % nig) % gsz); u.pn = (wgid % nig) / gsz; return true;
    }
};
typedef __bf16 bf16x2_t __attribute__((ext_vector_type(2)));
__device__ __forceinline__ unsigned cvt_pk_bf16(float lo, float hi) { f32x2 v = {lo, hi}; bf16x2_t b = __builtin_convertvector(v, bf16x2_t); return __builtin_bit_cast(unsigned, b); }
__device__ __forceinline__ float bflo(unsigned w) { return __uint_as_float(w << 16); }
__device__ __forceinline__ float bfhi(unsigned w) { return __uint_as_float(w & 0xffff0000u); }
__device__ __forceinline__ float silu_f(float v) { return v * __builtin_amdgcn_rcpf(1.0f + __builtin_amdgcn_exp2f(-1.4426950408889634f * v)); }

__device__ __forceinline__ void epilogue(const Job& J, const f32x4 (&acc)[2][2][4][2], const Unit& u, int wr, int wc, int fr, int fq) {
    if (J.kind == 3) {
        const int row0 = u.pm * BM + wr * 64 + fr, col0 = u.pn * BM + wc * 32 + 4 * fq;
#pragma unroll
        for (int ai = 0; ai < 2; ++ai)
#pragma unroll
            for (int m = 0; m < 4; ++m) { const size_t off = (size_t)(row0 + ai * HALF + m * 16) * J.ldc + col0;
#pragma unroll
                for (int bj = 0; bj < 2; ++bj)
#pragma unroll
                    for (int n = 0; n < 2; ++n) { const f32x4 bs = *(const f32x4*)(J.base + off + bj * HALF + n * 16); *(f32x4*)(J.out + off + bj * HALF + n * 16) = bs + acc[ai][bj][m][n]; } }
        return;
    }
    const int row0 = u.pm * BM + wr * 64 + fr, col0 = u.pn * BM + wc * 32 + 8 * fq;
    f32x4 sc[2][2];
#pragma unroll
    for (int bj = 0; bj < 2; ++bj)
#pragma unroll
        for (int n = 0; n < 2; ++n) sc[bj][n] = (J.kind == 1) ? *(const f32x4*)(J.colscale + col0 + bj * HALF + 4 * n) : (f32x4){1.f, 1.f, 1.f, 1.f};
#pragma unroll
    for (int ai = 0; ai < 2; ++ai)
#pragma unroll
        for (int m = 0; m < 4; ++m) { bf16_t* rowp = J.O + (size_t)(row0 + ai * HALF + m * 16) * J.ldc + col0;
#pragma unroll
            for (int bj = 0; bj < 2; ++bj) { f32x4 v0 = acc[ai][bj][m][0], v1 = acc[ai][bj][m][1];
                if (J.kind == 1) { v0 = v0 * sc[bj][0]; v1 = v1 * sc[bj][1]; }
                if (J.kind == 2) { const u32x4 p = *(const u32x4*)(rowp + bj * HALF);
                    v0 = (f32x4){bflo(p.x) * silu_f(v0[0]), bfhi(p.x) * silu_f(v0[1]), bflo(p.y) * silu_f(v0[2]), bfhi(p.y) * silu_f(v0[3])};
                    v1 = (f32x4){bflo(p.z) * silu_f(v1[0]), bfhi(p.z) * silu_f(v1[1]), bflo(p.w) * silu_f(v1[2]), bfhi(p.w) * silu_f(v1[3])}; }
                u32x4 w; w.x = cvt_pk_bf16(v0[0], v0[1]); w.y = cvt_pk_bf16(v0[2], v0[3]); w.z = cvt_pk_bf16(v1[0], v1[1]); w.w = cvt_pk_bf16(v1[2], v1[3]);
                *(u32x4*)(rowp + bj * HALF) = w; } }
}

__device__ __forceinline__ void gemm_phase(LAS unsigned char* lds, const Job& J, const int tid) {
    constexpr bool ALIGN_EPI = true;
    const int wid = __builtin_amdgcn_readfirstlane(tid >> 6), lane = tid & 63, wr = wid >> 2, wc = wid & 3, fr = lane & 15, fq = lane >> 4;
    const int K = J.K, nt = K / BK;
    const bool perm = (J.kind != 3);
    StaticOrder S; S.init(J.M, J.N, J.G, J.c);
    unsigned voffA[2], voffB[2];
#pragma unroll
    for (int i = 0; i < 2; ++i) { int R, C; stage_rc(tid * 16 + i * 8192, R, C); const int Rb = perm ? ((R & ~31) + perm32(R & 31)) : R;
        voffA[i] = (unsigned)(R * J.lda + C) * 2u; voffB[i] = (unsigned)(Rb * J.ldb + C) * 2u; }
    const size_t kstep = (size_t)(BK * 2);
    const size_t hstepA = (size_t)HALF * J.lda * 2, hstepB = (size_t)HALF * J.ldb * 2;
    const size_t tstepA = 2 * hstepA, tstepB = 2 * hstepB;
    const unsigned ldsw = (unsigned)wid * 1024u;
    const int aoff = lds_byte(wr * 64 + fr, fq * 8), boff = lds_byte(wc * 32 + fr, fq * 8);
#define PG8_SA(b, h) (((b) * 2 + (h)) * HTB)
#define PG8_SB(b, h) ((4 + (b) * 2 + (h)) * HTB)
#define PG8_STAGE(bufoff, gbase, voff) do { _Pragma("unroll") for (int _i = 0; _i < 2; ++_i) \
        __builtin_amdgcn_global_load_lds((const unsigned*)((const char*)(gbase) + (voff)[_i]), (LAS unsigned*)(lds + (bufoff) + ldsw + _i * 8192), 16, 0, 0); } while (0)
#define PG8_LDA(dst, b, h) do { _Pragma("unroll") for (int m = 0; m < 4; ++m) _Pragma("unroll") for (int k = 0; k < 2; ++k) dst[m][k] = *(const LAS bf16x8*)(lds + PG8_SA(b, h) + aoff + m * 2048 + k * 1024); } while (0)
#define PG8_LDB(dst, b, h) do { _Pragma("unroll") for (int n = 0; n < 2; ++n) _Pragma("unroll") for (int k = 0; k < 2; ++k) dst[n][k] = *(const LAS bf16x8*)(lds + PG8_SB(b, h) + boff + n * 2048 + k * 1024); } while (0)
#define PG8_MMA(ai, bj, At, Bt) do { __builtin_amdgcn_s_setprio(1); _Pragma("unroll") for (int m = 0; m < 4; ++m) _Pragma("unroll") for (int n = 0; n < 2; ++n) _Pragma("unroll") for (int k = 0; k < 2; ++k) \
        acc[ai][bj][m][n] = __builtin_amdgcn_mfma_f32_16x16x32_bf16(Bt[n][k], At[m][k], acc[ai][bj][m][n], 0, 0, 0); __builtin_amdgcn_s_setprio(0); } while (0)
#define PG8_WAIT_V(n) asm volatile("s_waitcnt vmcnt(" #n ")" ::: "memory")
#define PG8_WAIT_L(n) asm volatile("s_waitcnt lgkmcnt(" #n ")" ::: "memory")
#define PG8_BAR __builtin_amdgcn_s_barrier()
#define PG8_SCHED __builtin_amdgcn_sched_barrier(0)
#define PG8_APTR(u) ((const char*)J.A + (size_t)(u).pm * tstepA + (size_t)((u).pn / J.grp_tiles) * (size_t)J.grp_stride * 2)
#define PG8_BPTR(u) ((const char*)J.Bt + (size_t)(u).pn * tstepB)
    Unit cur, nxt; int ui = 0;
    if (!S.next(0, cur)) return;
    f32x4 acc[2][2][4][2];
#pragma unroll
    for (int a = 0; a < 2; ++a)
#pragma unroll
        for (int b = 0; b < 2; ++b)
#pragma unroll
            for (int m = 0; m < 4; ++m)
#pragma unroll
                for (int n = 0; n < 2; ++n) acc[a][b][m][n] = (f32x4){0.f, 0.f, 0.f, 0.f};
    bf16x8 At[4][2], B0[2][2], B1[2][2];
    const char* cA = PG8_APTR(cur); const char* cB = PG8_BPTR(cur);
    PG8_STAGE(PG8_SB(0, 0), cB, voffB); PG8_STAGE(PG8_SB(0, 1), cB + hstepB, voffB); PG8_STAGE(PG8_SA(0, 0), cA, voffA); PG8_STAGE(PG8_SA(0, 1), cA + hstepA, voffA);
    if (wr == 1) PG8_BAR;
    PG8_WAIT_V(2); PG8_BAR;
    PG8_STAGE(PG8_SB(1, 0), cB + kstep, voffB); PG8_STAGE(PG8_SA(1, 0), cA + kstep, voffA); PG8_STAGE(PG8_SB(1, 1), cB + hstepB + kstep, voffB);
    PG8_WAIT_V(6); PG8_BAR;
    for (;;) {
        const bool has_next = S.next(ui + 1, nxt);
        const char* nA = has_next ? PG8_APTR(nxt) : cA; const char* nB = has_next ? PG8_BPTR(nxt) : cB;
        for (int t = 0; t < nt; t += 2) {
            const bool last = (t == nt - 2);
            const char* a1 = cA + (size_t)(t + 1) * kstep;
            const char* a2 = last ? nA : cA + (size_t)(t + 2) * kstep; const char* b2 = last ? nB : cB + (size_t)(t + 2) * kstep;
            const char* a3 = a2 + kstep; const char* b3 = b2 + kstep;
            PG8_LDB(B0, 0, 0); PG8_LDB(B1, 0, 1); PG8_SCHED; PG8_LDA(At, 0, 0); PG8_STAGE(PG8_SA(1, 1), a1 + hstepA, voffA);
            PG8_WAIT_V(8); PG8_WAIT_L(0); PG8_BAR; PG8_MMA(0, 0, At, B0); PG8_MMA(0, 1, At, B1); PG8_BAR; PG8_SCHED;
            PG8_LDA(At, 0, 1); PG8_STAGE(PG8_SB(0, 0), b2, voffB); PG8_STAGE(PG8_SB(0, 1), b2 + hstepB, voffB); PG8_STAGE(PG8_SA(0, 0), a2, voffA);
            PG8_WAIT_V(8); PG8_WAIT_L(0); PG8_BAR; PG8_MMA(1, 0, At, B0); PG8_MMA(1, 1, At, B1); PG8_BAR; PG8_SCHED;
            PG8_LDB(B0, 1, 0); PG8_LDB(B1, 1, 1); PG8_SCHED; PG8_LDA(At, 1, 0); PG8_STAGE(PG8_SA(0, 1), a2 + hstepA, voffA);
            PG8_WAIT_V(8); PG8_WAIT_L(0); PG8_BAR; PG8_MMA(0, 0, At, B0); PG8_MMA(0, 1, At, B1); PG8_BAR; PG8_SCHED;
            PG8_LDA(At, 1, 1); PG8_STAGE(PG8_SB(1, 0), b3, voffB); PG8_STAGE(PG8_SB(1, 1), b3 + hstepB, voffB); PG8_STAGE(PG8_SA(1, 0), a3, voffA);
            PG8_WAIT_V(8); PG8_WAIT_L(0); PG8_BAR; PG8_MMA(1, 0, At, B0); PG8_MMA(1, 1, At, B1); PG8_BAR; PG8_SCHED;
        }
        if constexpr (ALIGN_EPI) { if (wr == 0) PG8_BAR; }
        epilogue(J, acc, cur, wr, wc, fr, fq);
        if (!has_next) break;
#pragma unroll
        for (int a = 0; a < 2; ++a)
#pragma unroll
            for (int b = 0; b < 2; ++b)
#pragma unroll
                for (int m = 0; m < 4; ++m)
#pragma unroll
                    for (int n = 0; n < 2; ++n) acc[a][b][m][n] = (f32x4){0.f, 0.f, 0.f, 0.f};
        cur = nxt; cA = nA; cB = nB; ++ui;
        if constexpr (ALIGN_EPI) { if (wr == 1) PG8_BAR; }
    }
    PG8_WAIT_V(0);
    if constexpr (!ALIGN_EPI) { if (wr == 0) PG8_BAR; }
    PG8_BAR;
#undef PG8_SA
#undef PG8_SB
#undef PG8_STAGE
#undef PG8_LDA
#undef PG8_LDB
#undef PG8_MMA
#undef PG8_WAIT_V
#undef PG8_WAIT_L
#undef PG8_BAR
#undef PG8_SCHED
#undef PG8_APTR
#undef PG8_BPTR
}
}

constexpr int RING_OFF = 0, RING_BYTES = 131072;
constexpr int LDSCTL_OFF = RING_BYTES, MISC_OFF = LDSCTL_OFF + 320;
constexpr int LDS_BYTES = 147456;
constexpr int NWAVES = 8;

constexpr int CW_BAR = 4096;

#define RLX_AGENT __ATOMIC_RELAXED, __HIP_MEMORY_SCOPE_AGENT
#define LDS_WAIT() asm volatile("s_waitcnt lgkmcnt(0)" ::: "memory")
#define VM_WAIT() asm volatile("s_waitcnt vmcnt(0)" ::: "memory")
__device__ __forceinline__ unsigned f2bf(float f) { unsigned u = __builtin_bit_cast(unsigned, f); return (u + 0x7fffu + ((u >> 16) & 1u)) >> 16; }
__device__ __forceinline__ unsigned pk2(float lo, float hi) { return f2bf(lo) | (f2bf(hi) << 16); }
__device__ __forceinline__ float bf2f(bf16_t b) { return __uint_as_float((unsigned)b << 16); }

#define XB_TMO      128
#define XB_XCNT(j)  (256  + 64 * (j))
#define XB_XSUB(j)  (1280 + 64 * (j))
#define XB_XGEN(j)  (2304 + 64 * (j))
#define XB_TOP      3328
#define XB_TOPGEN   3392
#define XCD_BAR_WORDS 3456
#define XB_SPIN_CAP (1u << 20)

__device__ __forceinline__ unsigned xb_ld(unsigned* p)              { return __hip_atomic_load(p, __ATOMIC_RELAXED, __HIP_MEMORY_SCOPE_AGENT); }
__device__ __forceinline__ unsigned xb_add(unsigned* p, unsigned v) { return __hip_atomic_fetch_add(p, v, __ATOMIC_RELAXED, __HIP_MEMORY_SCOPE_AGENT); }
__device__ __forceinline__ unsigned xb_xcc_id() { return (unsigned)__builtin_amdgcn_s_getreg((3 << 11) | 20) & 0xFu; }
#define XB_SPIN(cond, bar) do { unsigned _sp = 0; while (cond) { __builtin_amdgcn_s_sleep(1); \
    if ((++_sp & 255u) == 0u) { if (xb_ld(&(bar)[XB_TMO])) break; if (_sp > XB_SPIN_CAP) { atomicAdd(&(bar)[XB_TMO], 1u); break; } } } } while (0)

struct XcdBarrier { unsigned* bar; unsigned x; volatile LAS unsigned* st; };

__device__ __forceinline__ XcdBarrier xcd_barrier_post(unsigned* bar, volatile LAS unsigned* st) {
    XcdBarrier b; b.bar = bar; b.x = xb_xcc_id(); b.st = st;
    if (threadIdx.x == 0) (void)xb_add(&bar[XB_XCNT(b.x)], 1u);
    return b;
}
__device__ __forceinline__ void xcd_barrier_complete(unsigned* bar, unsigned x, unsigned& nloc, unsigned& nx) {
    const unsigned G = gridDim.x * gridDim.y * gridDim.z;
    unsigned sum, cnt, mine, sp = 0u;
    for (;;) {
        sum = 0u; cnt = 0u; mine = 0u;
#pragma unroll
        for (unsigned j = 0; j < 16; ++j) { const unsigned c = xb_ld(&bar[XB_XCNT(j)]); sum += c; cnt += (c > 0u) ? 1u : 0u; mine = (j == x) ? c : mine; }
        if (sum == G) break;
        __builtin_amdgcn_s_sleep(1);
        if ((++sp & 255u) == 0u) { if (xb_ld(&bar[XB_TMO])) break; if (sp > XB_SPIN_CAP) { atomicAdd(&bar[XB_TMO], 1u); break; } }
    }
    nloc = mine > 0u ? mine : 1u; nx = cnt > 0u ? cnt : 1u;
}
__device__ __forceinline__ void xcd_barrier(const XcdBarrier& b) {
    asm volatile("s_waitcnt vmcnt(0)" ::: "memory");
    __syncthreads();
    if (threadIdx.x == 0) {
        unsigned* bar = b.bar;
        __builtin_amdgcn_s_waitcnt(0);
        unsigned nloc = b.st[0], nx = b.st[1];
        if (nloc == 0u) { xcd_barrier_complete(bar, b.x, nloc, nx); b.st[0] = nloc; b.st[1] = nx; }
        const unsigned old = xb_add(&bar[XB_XSUB(b.x)], 1u);
        const unsigned gen = old / nloc;
        if (old + 1u == (gen + 1u) * nloc) {
            __builtin_amdgcn_fence(__ATOMIC_RELEASE, "agent");
            asm volatile("s_waitcnt vmcnt(0)" ::: "memory");
            const unsigned og = xb_add(&bar[XB_TOP], 1u);
            const unsigned tg = og / nx;
            if (og + 1u == (tg + 1u) * nx) xb_add(&bar[XB_TOPGEN], 1u);
            else XB_SPIN(xb_ld(&bar[XB_TOPGEN]) == tg, bar);
            __builtin_amdgcn_fence(__ATOMIC_ACQUIRE, "agent");
            xb_add(&bar[XB_XGEN(b.x)], 1u);
            asm volatile("s_waitcnt vmcnt(0)" ::: "memory");
        } else {
            XB_SPIN(xb_ld(&bar[XB_XGEN(b.x)]) == gen, bar);
            __builtin_amdgcn_fence(__ATOMIC_ACQUIRE, "agent");
            asm volatile("s_waitcnt vmcnt(0)" ::: "memory");
        }
    }
    __syncthreads();
}

struct Args {
    const float* x; const float* mem; const float* norm_g; const float* mem_norm_g; const float* w_kv; const float* w_out;
    const float* pool_w_in; const float* pool_w_grp; const float* pool_scale; const float* hgrn_w_in; const float* hgrn_lb;
    const float* hgrn_norm_g; const float* final_g; float* out; unsigned char* ws; int ph_lo, ph_hi;
};

__device__ __forceinline__ float wave_sum(float v) {
#pragma unroll
    for (int o = 1; o < 64; o <<= 1) v += __shfl_xor(v, o);
    return v;
}
__device__ __forceinline__ float wave_max(float v) {
#pragma unroll
    for (int o = 1; o < 64; o <<= 1) v = fmaxf(v, __shfl_xor(v, o));
    return v;
}

__device__ __forceinline__ void transpose_item(const float* W, int N, int k0, int n0, bf16_t* WT, int ldt, int orow0, LAS float* scr, int lane) {
#pragma unroll 8
    for (int i = 0; i < 32; ++i) { const int kk = 2 * i + (lane >> 5); scr[kk * 33 + (lane & 31)] = W[(size_t)(k0 + kk) * N + n0 + (lane & 31)]; }
    LDS_WAIT(); asm volatile("" ::: "memory");
    const int c = lane & 7;
#pragma unroll
    for (int j = 0; j < 4; ++j) { const int n = (lane >> 3) + 8 * j; const LAS float* s = scr + (8 * c) * 33 + n;
        u32x4 o; o.x = pk2(s[0 * 33], s[1 * 33]); o.y = pk2(s[2 * 33], s[3 * 33]); o.z = pk2(s[4 * 33], s[5 * 33]); o.w = pk2(s[6 * 33], s[7 * 33]);
        *(u32x4*)(WT + (size_t)(orow0 + n) * ldt + k0 + 8 * c) = o; }
    LDS_WAIT(); asm volatile("" ::: "memory");
}

__device__ __forceinline__ void rms_row_to_bf16(const float* xrow, const float* g, bf16_t* orow, int lane) {
    const f32x4* xr = (const f32x4*)xrow + lane; const f32x4* gr = (const f32x4*)g + lane;
    f32x4 v[8]; float s = 0.f;
#pragma unroll
    for (int j = 0; j < 8; ++j) { v[j] = xr[64 * j]; s += (v[j].x * v[j].x + v[j].y * v[j].y) + (v[j].z * v[j].z + v[j].w * v[j].w); }
    const float r = 1.0f / sqrtf(wave_sum(s) * (1.f / DM) + EPS);
    unsigned long long* o8 = (unsigned long long*)orow + lane;
#pragma unroll
    for (int j = 0; j < 8; ++j) { const f32x4 gg = gr[64 * j];
        o8[64 * j] = (unsigned long long)pk2(v[j].x * r * gg.x, v[j].y * r * gg.y) | ((unsigned long long)pk2(v[j].z * r * gg.z, v[j].w * r * gg.w) << 32); }
}
__device__ __forceinline__ void rms_row_f32(float* xrow, const float* g, int lane) {
    f32x4* xr = (f32x4*)xrow + lane; const f32x4* gr = (const f32x4*)g + lane;
    f32x4 v[8]; float s = 0.f;
#pragma unroll
    for (int j = 0; j < 8; ++j) { v[j] = xr[64 * j]; s += (v[j].x * v[j].x + v[j].y * v[j].y) + (v[j].z * v[j].z + v[j].w * v[j].w); }
    const float r = 1.0f / sqrtf(wave_sum(s) * (1.f / DM) + EPS);
#pragma unroll
    for (int j = 0; j < 8; ++j) { const f32x4 gg = gr[64 * j]; xr[64 * j] = (f32x4){v[j].x * r * gg.x, v[j].y * r * gg.y, v[j].z * r * gg.z, v[j].w * r * gg.w}; }
}

__device__ __forceinline__ float dot256(const bf16_t* row, const LAS float* vec) {
    float s = 0.f;
#pragma unroll 4
    for (int c = 0; c < 32; ++c) { const u32x4 w = *(const u32x4*)(row + 8 * c); const LAS f32x4* vv = (const LAS f32x4*)(vec + 8 * c); const f32x4 a = vv[0], b = vv[1];
        s += pg8::bflo(w.x) * a.x + pg8::bfhi(w.x) * a.y + pg8::bflo(w.y) * a.z + pg8::bfhi(w.y) * a.w + pg8::bflo(w.z) * b.x + pg8::bfhi(w.z) * b.y + pg8::bflo(w.w) * b.z + pg8::bfhi(w.w) * b.w; }
    return s;
}


typedef float f32x16 __attribute__((ext_vector_type(16)));
typedef short s16x4 __attribute__((ext_vector_type(4)));
#define MFMA32(a, b, c) __builtin_amdgcn_mfma_f32_32x32x16_bf16((a), (b), (c), 0, 0, 0)
__device__ __forceinline__ bf16x8 pack8(const f32x16& x, int s) {
    u32x4 p; p.x = pg8::cvt_pk_bf16(x[8 * s], x[8 * s + 1]); p.y = pg8::cvt_pk_bf16(x[8 * s + 2], x[8 * s + 3]); p.z = pg8::cvt_pk_bf16(x[8 * s + 4], x[8 * s + 5]); p.w = pg8::cvt_pk_bf16(x[8 * s + 6], x[8 * s + 7]);
    return __builtin_bit_cast(bf16x8, p);
}
__device__ __forceinline__ bf16x8 cat44(u32x2 lo, u32x2 hi) { u32x4 p; p.x = lo.x; p.y = lo.y; p.z = hi.x; p.w = hi.y; return __builtin_bit_cast(bf16x8, p); }

__device__ __forceinline__ void ca_wave(bf16_t* Qw  , int ldq, const bf16_t* Kb  , const bf16_t* Vtb  , int lane) {
    const int r = lane & 31, h = lane >> 5;
    bf16x8 qf[16];
#pragma unroll
    for (int ks = 0; ks < 16; ++ks) qf[ks] = *(const bf16x8*)(Qw + (size_t)r * ldq + 16 * ks + 8 * h);
    f32x16 X[8];
#pragma unroll
    for (int kt = 0; kt < 8; ++kt) {
#pragma unroll
        for (int i = 0; i < 16; ++i) X[kt][i] = 0.f;
        const bf16_t* kp = Kb + (size_t)(32 * kt + r) * 2048 + 8 * h;
#pragma unroll
        for (int ks = 0; ks < 16; ++ks) { const bf16x8 a = *(const bf16x8*)(kp + 16 * ks); X[kt] = MFMA32(a, qf[ks], X[kt]); }
    }
    float mx = -3.0e38f;
#pragma unroll
    for (int kt = 0; kt < 8; ++kt)
#pragma unroll
        for (int i = 0; i < 16; ++i) mx = fmaxf(mx, X[kt][i]);
    mx = fmaxf(mx, __shfl_xor(mx, 32));
    const float c = 0.0625f * 1.4426950408889634f; float sm = 0.f;
#pragma unroll
    for (int kt = 0; kt < 8; ++kt)
#pragma unroll
        for (int i = 0; i < 16; ++i) { X[kt][i] = __builtin_amdgcn_exp2f((X[kt][i] - mx) * c); sm += X[kt][i]; }
    sm += __shfl_xor(sm, 32);
    const float inv = 1.0f / sm;
    bf16x8 pa[8][2];
#pragma unroll
    for (int kt = 0; kt < 8; ++kt) {
#pragma unroll
        for (int i = 0; i < 16; ++i) X[kt][i] *= inv;
        pa[kt][0] = pack8(X[kt], 0); pa[kt][1] = pack8(X[kt], 1);
    }
#pragma unroll 1
    for (int dt = 0; dt < 8; ++dt) {
        f32x16 Z;
#pragma unroll
        for (int i = 0; i < 16; ++i) Z[i] = 0.f;
        const bf16_t* vp = Vtb + (size_t)(32 * dt + r) * MROWS + 4 * h;
#pragma unroll
        for (int kt = 0; kt < 8; ++kt)
#pragma unroll
            for (int ss = 0; ss < 2; ++ss) { const u32x2 lo = *(const u32x2*)(vp + 32 * kt + 16 * ss), hi = *(const u32x2*)(vp + 32 * kt + 16 * ss + 8); Z = MFMA32(pa[kt][ss], cat44(lo, hi), Z); }
#pragma unroll
        for (int i = 0; i < 16; ++i) { const int q = (i & 3) + 8 * (i >> 2) + 4 * h; Qw[(size_t)q * ldq + 32 * dt + r] = (bf16_t)f2bf(Z[i]); }
    }
}

constexpr int HQD = 0, HKI = 17408, HKT = 34816, HVT = 53248, HDEC = 71680, HTOT = 72192, HOUT = 76288, HROW = 272, HTROW = 144, HOROW = 528;
__device__ __forceinline__ void hgrn_unit(bf16_t* P1, const float* hgrn_lb, const float* hgrn_norm_g, int b, int hh, LAS unsigned char* lds, int tid) {
    const int lane = tid & 63, w = __builtin_amdgcn_readfirstlane(tid >> 6), r = lane & 31, h = lane >> 5, tt = w >> 2, vt = w & 3;
    const int c0 = 2 * lane;
    float lb[2], ng[2];
#pragma unroll
    for (int e = 0; e < 2; ++e) { const float l0 = hgrn_lb[hh * 128 + c0 + e], l1 = hgrn_lb[E_MIX + hh * 128 + c0 + e]; lb[e] = 1.0f / (1.0f + __expf(l0 - l1)); ng[e] = hgrn_norm_g[hh * 128 + c0 + e]; }
    bf16_t* base = P1 + (size_t)(b * SEQ + 8 * w) * N1A + hh * 128 + c0;
    unsigned qw[8], fw[8], vw[8];
#pragma unroll
    for (int i = 0; i < 8; ++i) { const bf16_t* p = base + (size_t)i * N1A; qw[i] = *(const unsigned*)p; fw[i] = *(const unsigned*)(p + 3072); vw[i] = *(const unsigned*)(p + 6144); }
    f32x16 S[4];
#pragma unroll
    for (int kt = 0; kt < 4; ++kt)
#pragma unroll
        for (int i = 0; i < 16; ++i) S[kt][i] = 0.f;
#pragma unroll 1
    for (int n = 0; n < SEQ / 64; ++n) {
        float qs[8][2], kk[8][2], cum[8][2];
#pragma unroll
        for (int i = 0; i < 8; ++i)
#pragma unroll
            for (int e = 0; e < 2; ++e) {
                const float q = e ? pg8::bfhi(qw[i]) : pg8::bflo(qw[i]), x = e ? pg8::bfhi(fw[i]) : pg8::bflo(fw[i]);
                const float sg = __builtin_amdgcn_rcpf(1.0f + __builtin_amdgcn_exp2f(-1.4426950408889634f * x));
                const float f = lb[e] + (1.0f - lb[e]) * sg;
                kk[i][e] = 1.0f - f; cum[i][e] = (i == 0) ? f : cum[i - 1][e] * f;
                qs[i][e] = q * __builtin_amdgcn_rcpf(1.0f + __builtin_amdgcn_exp2f(-1.4426950408889634f * q)) * 0.08838834764831845f;
            }
        *(LAS f32x2*)(lds + HTOT + (w * 128 + c0) * 4) = (f32x2){cum[7][0], cum[7][1]};
        { u32x4 v0, v1;
          v0.x = (vw[0] & 0xffffu) | (vw[1] << 16); v0.y = (vw[2] & 0xffffu) | (vw[3] << 16); v0.z = (vw[4] & 0xffffu) | (vw[5] << 16); v0.w = (vw[6] & 0xffffu) | (vw[7] << 16);
          v1.x = (vw[0] >> 16) | (vw[1] & 0xffff0000u); v1.y = (vw[2] >> 16) | (vw[3] & 0xffff0000u); v1.z = (vw[4] >> 16) | (vw[5] & 0xffff0000u); v1.w = (vw[6] >> 16) | (vw[7] & 0xffff0000u);
          *(LAS u32x4*)(lds + HVT + c0 * HTROW + 16 * w) = v0; *(LAS u32x4*)(lds + HVT + (c0 + 1) * HTROW + 16 * w) = v1; }
        __syncthreads();
        float off[2] = {1.f, 1.f}, pl[2] = {1.f, 1.f};
#pragma unroll
        for (int w2 = 0; w2 < 8; ++w2) { const f32x2 t2 = *(const LAS f32x2*)(lds + HTOT + (w2 * 128 + c0) * 4); pl[0] *= t2.x; pl[1] *= t2.y; if (w2 < w) { off[0] *= t2.x; off[1] *= t2.y; } }
        { float kt8[2][8];
#pragma unroll
          for (int i = 0; i < 8; ++i) { float qd[2], ki[2];
#pragma unroll
              for (int e = 0; e < 2; ++e) { const float P = off[e] * cum[i][e], rP = __builtin_amdgcn_rcpf(P); qd[e] = qs[i][e] * P; ki[e] = kk[i][e] * rP; kt8[e][i] = ki[e] * pl[e]; }
              *(LAS unsigned*)(lds + HQD + (8 * w + i) * HROW + 4 * lane) = pg8::cvt_pk_bf16(qd[0], qd[1]);
              *(LAS unsigned*)(lds + HKI + (8 * w + i) * HROW + 4 * lane) = pg8::cvt_pk_bf16(ki[0], ki[1]); }
#pragma unroll
          for (int e = 0; e < 2; ++e) { u32x4 k4; k4.x = pg8::cvt_pk_bf16(kt8[e][0], kt8[e][1]); k4.y = pg8::cvt_pk_bf16(kt8[e][2], kt8[e][3]); k4.z = pg8::cvt_pk_bf16(kt8[e][4], kt8[e][5]); k4.w = pg8::cvt_pk_bf16(kt8[e][6], kt8[e][7]);
              *(LAS u32x4*)(lds + HKT + (c0 + e) * HTROW + 16 * w) = k4; } }
        if (w == 0) *(LAS f32x2*)(lds + HDEC + c0 * 4) = (f32x2){pl[0], pl[1]};
        if (n + 1 < SEQ / 64) {
#pragma unroll
            for (int i = 0; i < 8; ++i) { const bf16_t* p = base + (size_t)((n + 1) * 64 + i) * N1A; qw[i] = *(const unsigned*)p; fw[i] = *(const unsigned*)(p + 3072); vw[i] = *(const unsigned*)(p + 6144); }
        }
        __syncthreads();
        f32x16 O;
#pragma unroll
        for (int i = 0; i < 16; ++i) O[i] = 0.f;
#pragma unroll
        for (int st = 0; st < 2; ++st) if (st <= tt) {
            f32x16 X;
#pragma unroll
            for (int i = 0; i < 16; ++i) X[i] = 0.f;
#pragma unroll
            for (int ks = 0; ks < 8; ++ks) { const bf16x8 a = *(const LAS bf16x8*)(lds + HKI + (32 * st + r) * HROW + (16 * ks + 8 * h) * 2), bq = *(const LAS bf16x8*)(lds + HQD + (32 * tt + r) * HROW + (16 * ks + 8 * h) * 2); X = MFMA32(a, bq, X); }
            if (st == tt) {
#pragma unroll
                for (int i = 0; i < 16; ++i) { const int sl = (i & 3) + 8 * (i >> 2) + 4 * h; if (sl > r) X[i] = 0.f; }
            }
#pragma unroll
            for (int ss = 0; ss < 2; ++ss) { const LAS unsigned char* vp = lds + HVT + (32 * vt + r) * HTROW + (32 * st + 16 * ss + 4 * h) * 2;
                const u32x2 lo = *(const LAS u32x2*)vp, hi = *(const LAS u32x2*)(vp + 16); O = MFMA32(pack8(X, ss), cat44(lo, hi), O); }
        }
#pragma unroll
        for (int kt = 0; kt < 4; ++kt)
#pragma unroll
            for (int ss = 0; ss < 2; ++ss) { const LAS unsigned char* qp = lds + HQD + (32 * tt + r) * HROW + (32 * kt + 16 * ss + 4 * h) * 2;
                const u32x2 lo = *(const LAS u32x2*)qp, hi = *(const LAS u32x2*)(qp + 16); O = MFMA32(cat44(lo, hi), pack8(S[kt], ss), O); }
#pragma unroll
        for (int kt = 0; kt < 4; ++kt) {
#pragma unroll
            for (int g = 0; g < 4; ++g) { const f32x4 d4 = *(const LAS f32x4*)(lds + HDEC + (32 * kt + 8 * g + 4 * h) * 4); S[kt][4 * g] *= d4.x; S[kt][4 * g + 1] *= d4.y; S[kt][4 * g + 2] *= d4.z; S[kt][4 * g + 3] *= d4.w; }
#pragma unroll
            for (int ts = 0; ts < 4; ++ts) { const bf16x8 a = *(const LAS bf16x8*)(lds + HKT + (32 * kt + r) * HTROW + (16 * ts + 8 * h) * 2), bv = *(const LAS bf16x8*)(lds + HVT + (32 * vt + r) * HTROW + (16 * ts + 8 * h) * 2); S[kt] = MFMA32(a, bv, S[kt]); }
        }
#pragma unroll
        for (int i = 0; i < 16; ++i) { const int tl = (i & 3) + 8 * (i >> 2) + 4 * h; *(LAS float*)(lds + HOUT + (32 * tt + tl) * HOROW + (32 * vt + r) * 4) = O[i]; }
        __syncthreads();
#pragma unroll
        for (int i = 0; i < 8; ++i) { const f32x2 o2 = *(const LAS f32x2*)(lds + HOUT + (8 * w + i) * HOROW + c0 * 4);
            const float ss = wave_sum(o2.x * o2.x + o2.y * o2.y); const float rn = 1.0f / sqrtf(ss * (1.f / 128.f) + EPS);
            *(unsigned*)(base + (size_t)(n * 64 + i) * N1A + 6144) = pk2(o2.x * rn * ng[0], o2.y * rn * ng[1]); }
    }
}

__global__ void __launch_bounds__(NWAVES * 64, 2) fwd_kernel(Args a) {
    extern __shared__ __attribute__((aligned(16))) unsigned char lds_raw[];
    LAS unsigned char* lds = (LAS unsigned char*)lds_raw;
    volatile LAS unsigned* MISC = (volatile LAS unsigned*)(lds + MISC_OFF);
    const int tid0 = threadIdx.x;
    const int G = gridDim.x, bx = blockIdx.x;
    const int vcu = (G % 8 == 0) ? (bx % 8) * (G / 8) + bx / 8 : bx;
    unsigned char* ws = a.ws;
    unsigned* ctl = (unsigned*)(ws + WS_CTL);
    for (int u = tid0; u < (LDS_BYTES - LDSCTL_OFF) / 4; u += NWAVES * 64) ((LAS unsigned*)(lds + LDSCTL_OFF))[u] = 0u;
    __syncthreads();
    XcdBarrier bar; bar.bar = ctl + CW_BAR; bar.x = 0; bar.st = nullptr;
    const bool multi = (a.ph_hi - a.ph_lo) > 1;
    if (multi) bar = xcd_barrier_post(ctl + CW_BAR, MISC + 8);

    bf16_t* Wt_in0 = (bf16_t*)(ws + WS_WIN0); bf16_t* Wt_in1 = (bf16_t*)(ws + WS_WIN1);
    bf16_t* Wt_out0 = (bf16_t*)(ws + WS_WOUT0); bf16_t* Wt_out1 = (bf16_t*)(ws + WS_WOUT1);
    bf16_t* Wt_kv = (bf16_t*)(ws + WS_WKV); bf16_t* Wt_grp = (bf16_t*)(ws + WS_WGRP);
    bf16_t* MEMN = (bf16_t*)(ws + WS_MEMN); bf16_t* KMAT = (bf16_t*)(ws + WS_KMAT); bf16_t* VT = (bf16_t*)(ws + WS_VT);
    bf16_t* H = (bf16_t*)(ws + WS_H); bf16_t* U = (bf16_t*)(ws + WS_U); bf16_t* POOL = (bf16_t*)(ws + WS_POOL); bf16_t* P1 = (bf16_t*)(ws + WS_P1);
    const int NGW = G * NWAVES;

    for (int p = a.ph_lo; p < a.ph_hi; ++p) {
        int tid = threadIdx.x; asm volatile("" : "+v"(tid));
        const int lane = tid & 63, wave = __builtin_amdgcn_readfirstlane(tid >> 6), gw = vcu * NWAVES + wave;
        pg8::Job J; J.kind = -1; J.grp_tiles = 1 << 20; J.grp_stride = 0; J.colscale = nullptr; J.base = nullptr; J.out = nullptr; J.O = nullptr; J.ldc = 0; J.G = G; J.c = bx;
        J.A = nullptr; J.Bt = nullptr; J.lda = 0; J.ldb = 0; J.K = 0; J.M = 0; J.N = 0;
        switch (p) {
            case 1: J.kind = 0; J.A = H; J.lda = DM; J.Bt = Wt_in0; J.ldb = DM; J.K = DM; J.M = T; J.N = N0A; J.O = U; J.ldc = N0A; break;
            case 2: if (bx < 32) { J.kind = 0; J.A = MEMN; J.lda = DM; J.Bt = Wt_kv; J.ldb = DM; J.K = DM; J.M = MROWS; J.N = 2048; J.O = KMAT; J.ldc = 2048; J.G = 32; J.c = bx; }
                    else if (bx < 64) { J.kind = 0; J.A = Wt_kv + (size_t)2048 * DM; J.lda = DM; J.Bt = MEMN; J.ldb = DM; J.K = DM; J.M = 2048; J.N = MROWS; J.O = VT; J.ldc = MROWS; J.G = 32; J.c = bx - 32; }
                    break;
            case 3: J.kind = 1; J.A = POOL; J.lda = E_MIX; J.Bt = Wt_grp; J.ldb = PGRP; J.K = PGRP; J.M = T; J.N = E_MIX; J.grp_tiles = 3; J.grp_stride = PGRP; J.O = U; J.ldc = N0A; J.colscale = a.pool_scale; break;
            case 4: J.kind = 2; J.A = H; J.lda = DM; J.Bt = Wt_in0 + (size_t)N0A * DM; J.ldb = DM; J.K = DM; J.M = T; J.N = E_BR; J.O = U; J.ldc = N0A; break;
            case 5: J.kind = 3; J.A = U; J.lda = N0A; J.Bt = Wt_out0; J.ldb = E_BR; J.K = E_BR; J.M = T; J.N = DM; J.base = a.x; J.out = a.out; J.ldc = DM; break;
            case 7: J.kind = 0; J.A = H; J.lda = DM; J.Bt = Wt_in1; J.ldb = DM; J.K = DM; J.M = T; J.N = N1A; J.O = P1; J.ldc = N1A; break;
            case 9: J.kind = 2; J.A = H; J.lda = DM; J.Bt = Wt_in1 + (size_t)N1A * DM; J.ldb = DM; J.K = DM; J.M = T; J.N = E_BR; J.O = P1 + 6144; J.ldc = N1A; break;
            case 10: J.kind = 3; J.A = P1 + 6144; J.lda = N1A; J.Bt = Wt_out1; J.ldb = E_BR; J.K = E_BR; J.M = T; J.N = DM; J.base = a.out; J.out = a.out; J.ldc = DM; break;
            default: break;
        }
        if (J.kind >= 0) pg8::gemm_phase(lds + RING_OFF, J, tid);

        if (p == 0) {
            LAS float* scr = (LAS float*)(lds + RING_OFF + wave * 16384);
            constexpr int I_IN0 = (DM / 64) * (N0 / 32), I_IN1 = (DM / 64) * (N1 / 32), I_OUT = (E_BR / 64) * (DM / 32), I_KV = (DM / 64) * (2048 / 32), I_GRP = (PGRP / 64) * (PGRP / 32);
            constexpr int NITEMS = I_IN0 + I_IN1 + 2 * I_OUT + 2 * I_KV + 4 * I_GRP;
            for (int it = gw; it < NITEMS; it += NGW) {
                int r = it;
                if (r < I_IN0) { const int nb = N0 / 32, kb = r / nb, n0 = 32 * (r % nb); transpose_item(a.pool_w_in, N0, 64 * kb, n0, Wt_in0, DM, n0, scr, lane); continue; } r -= I_IN0;
                if (r < I_IN1) { const int nb = N1 / 32, kb = r / nb, n0 = 32 * (r % nb); transpose_item(a.hgrn_w_in, N1, 64 * kb, n0, Wt_in1, DM, n0, scr, lane); continue; } r -= I_IN1;
                if (r < 2 * I_OUT) { const int l = r / I_OUT; r -= l * I_OUT; const int nb = DM / 32, kb = r / nb, n0 = 32 * (r % nb);
                    transpose_item(a.w_out + (size_t)l * E_BR * DM, DM, 64 * kb, n0, l ? Wt_out1 : Wt_out0, E_BR, n0, scr, lane); continue; } r -= 2 * I_OUT;
                if (r < 2 * I_KV) { const int l = r / I_KV; r -= l * I_KV; const int nb = 2048 / 32, kb = r / nb, n0 = 32 * (r % nb);
                    const int orow0 = (n0 < 1024) ? (l * 1024 + n0) : (2048 + l * 1024 + (n0 - 1024));
                    transpose_item(a.w_kv + (size_t)l * DM * 2048, 2048, 64 * kb, n0, Wt_kv, DM, orow0, scr, lane); continue; } r -= 2 * I_KV;
                { const int g = r / I_GRP; r -= g * I_GRP; const int nb = PGRP / 32, kb = r / nb, n0 = 32 * (r % nb);
                    transpose_item(a.pool_w_grp + (size_t)g * PGRP * PGRP, PGRP, 64 * kb, n0, Wt_grp, PGRP, g * PGRP + n0, scr, lane); }
            }
            for (int m = gw; m < T + MROWS; m += NGW) {
                if (m < T) rms_row_to_bf16(a.x + (size_t)m * DM, a.norm_g, H + (size_t)m * DM, lane);
                else rms_row_to_bf16(a.mem + (size_t)(m - T) * DM, a.mem_norm_g, MEMN + (size_t)(m - T) * DM, lane);
            }
        } else if (p == 2) {
            if (bx >= 64) {
                const int NP = (G - 64) * NWAVES * 64, me = (bx - 64) * (NWAVES * 64) + tid;
                constexpr int RB = 16, NCH = E_MIX / 8, NTASK = (T / RB) * NCH;
                for (int task = me; task < NTASK; task += NP) {
                    const int ch = task % NCH, rb = task / NCH, grp = ch / (PGRP / 8), w = 2 << grp;
                    const int t0 = rb * RB, tl0 = t0 % SEQ;
                    const bf16_t* up = U + (size_t)t0 * N0A + ch * 8;
                    float s[8];
#pragma unroll
                    for (int e = 0; e < 8; ++e) s[e] = 0.f;
                    for (int d = 1; d <= w; ++d) if (tl0 - d >= 0) { const u32x4 v = *(const u32x4*)(up - (long)d * N0A);
                        s[0] += pg8::bflo(v.x); s[1] += pg8::bfhi(v.x); s[2] += pg8::bflo(v.y); s[3] += pg8::bfhi(v.y); s[4] += pg8::bflo(v.z); s[5] += pg8::bfhi(v.z); s[6] += pg8::bflo(v.w); s[7] += pg8::bfhi(v.w); }
                    for (int r = 0; r < RB; ++r) {
                        const int tl = tl0 + r;
                        const u32x4 v = *(const u32x4*)(up + (size_t)r * N0A);
                        float c[8] = {pg8::bflo(v.x), pg8::bfhi(v.x), pg8::bflo(v.y), pg8::bfhi(v.y), pg8::bflo(v.z), pg8::bfhi(v.z), pg8::bflo(v.w), pg8::bfhi(v.w)};
#pragma unroll
                        for (int e = 0; e < 8; ++e) s[e] += c[e];
                        if (tl - w >= 0) { const u32x4 o = *(const u32x4*)(up + (long)(r - w) * N0A);
                            s[0] -= pg8::bflo(o.x); s[1] -= pg8::bfhi(o.x); s[2] -= pg8::bflo(o.y); s[3] -= pg8::bfhi(o.y); s[4] -= pg8::bflo(o.z); s[5] -= pg8::bfhi(o.z); s[6] -= pg8::bflo(o.w); s[7] -= pg8::bfhi(o.w); }
                        const float inv = 1.0f / (float)((tl + 1 < w) ? (tl + 1) : w);
                        u32x4 o4; o4.x = pk2(s[0] * inv - c[0], s[1] * inv - c[1]); o4.y = pk2(s[2] * inv - c[2], s[3] * inv - c[3]); o4.z = pk2(s[4] * inv - c[4], s[5] * inv - c[5]); o4.w = pk2(s[6] * inv - c[6], s[7] * inv - c[7]);
                        *(u32x4*)(POOL + (size_t)(t0 + r) * E_MIX + ch * 8) = o4;
                    }
                }
            }
        } else if (p == 3 || p == 8) {
            const int layer = (p == 3) ? 0 : 1;
            bf16_t* Q = layer ? (P1 + 9216) : (U + 3072); const int ldq = layer ? N1A : N0A;
            if (p == 8 && bx < 96) {
                hgrn_unit(P1, a.hgrn_lb, a.hgrn_norm_g, bx / HG_H, bx % HG_H, lds + RING_OFF, tid);
            } else {
                const int w0 = (p == 8) ? (bx - 96) * NWAVES + wave : gw, nw = (p == 8) ? (G - 96) * NWAVES : NGW;
                for (int task = w0; task < (T / 32) * 4; task += nw) {
                    const int hd = task & 3, rb = task >> 2, t0 = rb * 32, b = t0 / SEQ;
                    ca_wave(Q + (size_t)t0 * ldq + hd * 256, ldq, KMAT + (size_t)(b * NMEM) * 2048 + layer * 1024 + hd * 256, VT + (size_t)(layer * 1024 + hd * 256) * MROWS + b * NMEM, lane);
                }
            }
        } else if (p == 6) {
            for (int m = gw; m < T; m += NGW) rms_row_to_bf16(a.out + (size_t)m * DM, a.norm_g + DM, H + (size_t)m * DM, lane);
        } else if (p == 11) {
            for (int m = gw; m < T; m += NGW) rms_row_f32(a.out + (size_t)m * DM, a.final_g, lane);
        }
        if (p + 1 < a.ph_hi) xcd_barrier(bar);
    }
}

constexpr int N_PHASES = 12;

extern "C" void kernel_launch(void* const* d_in, const int* in_sizes, int n_in, void* d_out, int out_size, void* d_ws, size_t ws_size, hipStream_t stream) {
    static int grid = 0;
    if (grid == 0) {
        if (n_in != 13 || in_sizes[0] != T * DM || out_size != T * DM || ws_size < WS_END) {
            fprintf(stderr, "kernel_launch: unexpected shapes / workspace (n_in %d, in0 %d, out %d, ws %zu < %zu); nothing launched\n", n_in, n_in > 0 ? in_sizes[0] : -1, out_size, ws_size, (size_t)WS_END); grid = -1; return; }
        int dev = 0, cus = 0, per_cu = 0;
        if (hipGetDevice(&dev) != hipSuccess || hipDeviceGetAttribute(&cus, hipDeviceAttributeMultiprocessorCount, dev) != hipSuccess) { grid = -1; return; }
        if (hipFuncSetAttribute((const void*)fwd_kernel, hipFuncAttributeMaxDynamicSharedMemorySize, LDS_BYTES) != hipSuccess) { fprintf(stderr, "kernel_launch: hipFuncSetAttribute failed\n"); grid = -1; return; }
        if (hipOccupancyMaxActiveBlocksPerMultiprocessor(&per_cu, (const void*)fwd_kernel, NWAVES * 64, LDS_BYTES) != hipSuccess || per_cu < 1) {
            fprintf(stderr, "kernel_launch: occupancy query reports %d workgroups per CU; nothing launched\n", per_cu); (void)hipGetLastError(); grid = -1; return; }
        grid = cus;
        if (grid < 128) { fprintf(stderr, "kernel_launch: needs >= 128 CUs\n"); grid = -1; return; }
    }
    if (grid < 0) return;
    if (hipMemsetAsync((char*)d_ws + WS_CTL, 0, CTL_ZERO_BYTES, stream) != hipSuccess) return;
    Args a{};
    a.x = (const float*)d_in[0]; a.mem = (const float*)d_in[1]; a.norm_g = (const float*)d_in[2]; a.mem_norm_g = (const float*)d_in[3]; a.w_kv = (const float*)d_in[4]; a.w_out = (const float*)d_in[5];
    a.pool_w_in = (const float*)d_in[6]; a.pool_w_grp = (const float*)d_in[7]; a.pool_scale = (const float*)d_in[8]; a.hgrn_w_in = (const float*)d_in[9]; a.hgrn_lb = (const float*)d_in[10];
    a.hgrn_norm_g = (const float*)d_in[11]; a.final_g = (const float*)d_in[12]; a.out = (float*)d_out; a.ws = (unsigned char*)d_ws;
#if MK_N_LAUNCHES == 1
    a.ph_lo = 0; a.ph_hi = N_PHASES;
    hipLaunchKernelGGL(fwd_kernel, dim3(grid), dim3(NWAVES * 64), LDS_BYTES, stream, a);
#else
    for (int p = 0; p < N_PHASES; ++p) { a.ph_lo = p; a.ph_hi = p + 1; hipLaunchKernelGGL(fwd_kernel, dim3(grid), dim3(NWAVES * 64), LDS_BYTES, stream, a); }
#endif
}
```

```cpp
#include <hip/hip_runtime.h>
#include <cstdio>
#include <cstdint>

#ifndef MK_N_LAUNCHES
#define MK_N_LAUNCHES 1
#endif

#define LAS __attribute__((address_space(3)))
typedef unsigned short bf16_t;
typedef short bf16x8 __attribute__((ext_vector_type(8)));
typedef float f32x4 __attribute__((ext_vector_type(4)));
typedef float f32x2 __attribute__((ext_vector_type(2)));
typedef unsigned u32x4 __attribute__((ext_vector_type(4)));
typedef unsigned u32x2 __attribute__((ext_vector_type(2)));

constexpr int BATCH = 4, SEQ = 4096, DM = 2048, T = BATCH * SEQ;
constexpr int NMEM = 256, MROWS = BATCH * NMEM;
constexpr int E_MIX = 3072, E_CA = 1024, E_BR = 4096;
constexpr int N0 = 8192, N1 = 14336, N0A = 4096, N1A = 10240;
constexpr int LPAD = 64;
constexpr int LDU = N0A + LPAD, LDP = N1A + LPAD, LDWO = E_BR + LPAD, LDH = DM + LPAD;
constexpr int PGRP = 768;
constexpr int HG_H = 24, HG_D = 128;
constexpr float EPS = 1e-6f;

constexpr size_t MiB = 1u << 20;
constexpr size_t WS_CTL = 0, CTL_ZERO_BYTES = 1 * MiB;
constexpr size_t WS_WIN1 = 1 * MiB;
constexpr size_t WS_WOUT1 = 59 * MiB;
constexpr size_t WS_KMAT = 76 * MiB;
constexpr size_t WS_VT = 80 * MiB;
constexpr size_t WS_H = 84 * MiB;
constexpr size_t WS_BIG = 150 * MiB;
constexpr size_t WS_WIN0 = WS_BIG;
constexpr size_t WS_WOUT0 = WS_BIG + 33 * MiB;
constexpr size_t WS_WKV = WS_BIG + 50 * MiB;
constexpr size_t WS_WGRP = WS_BIG + 67 * MiB;
constexpr size_t WS_MEMN = WS_BIG + 72 * MiB;
constexpr size_t WS_U = WS_BIG + 77 * MiB;
constexpr size_t WS_BR0 = WS_BIG + 207 * MiB;
constexpr size_t WS_WUBF = WS_BIG + 337 * MiB;
constexpr size_t WS_P1 = WS_BIG;
constexpr size_t WS_DEC = WS_BIG + 322 * MiB;
constexpr size_t WS_END = WS_DEC + 3 * MiB;
static_assert((size_t)T * LDU * 2 <= 130 * MiB && (size_t)T * LDP * 2 <= 322 * MiB && (size_t)DM * LDWO * 2 <= 17 * MiB && (size_t)N1 * LDH * 2 <= 58 * MiB && (size_t)T * LDH * 2 <= 66 * MiB && (size_t)N0 * LDH * 2 <= 33 * MiB && (size_t)4096 * LDH * 2 <= 17 * MiB && (size_t)MROWS * LDH * 2 <= 5 * MiB, "ws map");

namespace pg8 {
constexpr int BM = 256, BK = 64, HALF = 128, HTB = HALF * BK * 2, STAGE_BYTES = 8 * HTB, NXCD = 8, WGM = 8;
__host__ __device__ __forceinline__ int lds_byte(int r, int c) { const int st = (r >> 4) * 2 + (c >> 5), rr = r & 15, cc = c & 31, ob = rr * 64 + cc * 2; return st * 1024 + (ob ^ (((ob >> 9) & 1) << 5)); }
__host__ __device__ __forceinline__ void stage_rc(int b, int& R, int& C) { const int st = b / 1024, sb = b % 1024, swz = sb ^ (((sb >> 9) & 1) << 5); R = (st >> 1) * 16 + swz / 64; C = (st & 1) * 32 + (swz % 64) / 2; }
__host__ __device__ __forceinline__ int perm32(int rho) { const int n = rho >> 4, i = rho & 15; return 8 * (i >> 2) + 4 * n + (i & 3); }

struct Unit { int pm, pn; };
struct Job {
    const bf16_t* A; const bf16_t* Bt; int lda, ldb, K, M, N, G, c, grp_tiles, grp_stride, bgrp_tiles, bgrp_stride;
    int kind; bf16_t* O; int ldc; const float* colscale; const float* base; float* out;
    int wgm;
    const float* lbp;
    float* decp;
    const float* rowss;
    float* ssq;
    unsigned* pcnt;
};
struct StaticOrder {
    int nM, nN, nwg, G, c, wgm;
    __device__ void init(int M, int N, int G_, int c_, int wgm_) { nM = M / BM; nN = N / BM; nwg = nM * nN; G = G_; c = c_; wgm = wgm_; }
    __device__ bool next(int i, Unit& u) const {
        const long L = (long)i * G + c; if (L >= nwg) return false;
        if (wgm == 0) { u.pm = (int)L / nN; u.pn = (int)L % nN; return true; }
        int wgid = (int)L; { const int q = nwg / NXCD, r = nwg % NXCD, xcd = wgid % NXCD, off = wgid / NXCD; wgid = (xcd < r ? xcd * (q + 1) : r * (q + 1) + (xcd - r) * q) + off; }
        const int nig = wgm * nN, gid = wgid / nig, fm = gid * wgm, gsz = (nM - fm) < wgm ? (nM - fm) : wgm;
        u.pm = fm + ((wgid % nig) % gsz); u.pn = (wgid % nig) / gsz; return true;
    }
};
typedef __bf16 bf16x2_t __attribute__((ext_vector_type(2)));
__device__ __forceinline__ unsigned cvt_pk_bf16(float lo, float hi) { f32x2 v = {lo, hi}; bf16x2_t b = __builtin_convertvector(v, bf16x2_t); return __builtin_bit_cast(unsigned, b); }
__device__ __forceinline__ float bflo(unsigned w) { return __uint_as_float(w << 16); }
__device__ __forceinline__ float bfhi(unsigned w) { return __uint_as_float(w & 0xffff0000u); }
__device__ __forceinline__ float silu_f(float v) { return v * __builtin_amdgcn_rcpf(1.0f + __builtin_amdgcn_exp2f(-1.4426950408889634f * v)); }

#define DPPF(x, ctrl) __builtin_bit_cast(float, __builtin_amdgcn_update_dpp(0, __builtin_bit_cast(int, (x)), (ctrl), 0xF, 0xF, true))
#define DPPF1(x, ctrl) __builtin_bit_cast(float, __builtin_amdgcn_update_dpp(0x3f800000, __builtin_bit_cast(int, (x)), (ctrl), 0xF, 0xF, false))
__device__ __forceinline__ float xl_sum16(float v) { const auto r = __builtin_amdgcn_permlane16_swap(__builtin_bit_cast(unsigned, v), __builtin_bit_cast(unsigned, v), false, false); return __builtin_bit_cast(float, (unsigned)r[0]) + __builtin_bit_cast(float, (unsigned)r[1]); }
__device__ __forceinline__ float xl_sum32(float v) { const auto r = __builtin_amdgcn_permlane32_swap(__builtin_bit_cast(unsigned, v), __builtin_bit_cast(unsigned, v), false, false); return __builtin_bit_cast(float, (unsigned)r[0]) + __builtin_bit_cast(float, (unsigned)r[1]); }
__device__ __forceinline__ float xl_max16(float v) { const auto r = __builtin_amdgcn_permlane16_swap(__builtin_bit_cast(unsigned, v), __builtin_bit_cast(unsigned, v), false, false); return fmaxf(__builtin_bit_cast(float, (unsigned)r[0]), __builtin_bit_cast(float, (unsigned)r[1])); }
__device__ __forceinline__ float xl_max32(float v) { const auto r = __builtin_amdgcn_permlane32_swap(__builtin_bit_cast(unsigned, v), __builtin_bit_cast(unsigned, v), false, false); return fmaxf(__builtin_bit_cast(float, (unsigned)r[0]), __builtin_bit_cast(float, (unsigned)r[1])); }
__device__ __forceinline__ float xl_row_sum(float v) { v += DPPF(v, 0xB1); v += DPPF(v, 0x4E); v += DPPF(v, 0x141); v += DPPF(v, 0x140); return v; }
__device__ __forceinline__ float xl_row_max(float v) { v = fmaxf(v, DPPF(v, 0xB1)); v = fmaxf(v, DPPF(v, 0x4E)); v = fmaxf(v, DPPF(v, 0x141)); v = fmaxf(v, DPPF(v, 0x140)); return v; }
__device__ __forceinline__ void epilogue_hgrn(const Job& J, const f32x4 (&acc)[2][2][4][2], const float (&rs)[2][4], const Unit& u, int wr, int wc, int fr, int fq) {
    const int row0 = u.pm * BM + wr * 64 + fr, colh = wc * 32 + 8 * fq;
    f32x4 omlbv[2];
#pragma unroll
    for (int n = 0; n < 2; ++n) omlbv[n] = *(const f32x4*)(J.lbp + u.pn * 128 + colh + 4 * n);
#pragma unroll
    for (int ai = 0; ai < 2; ++ai) {
#pragma unroll
        for (int n = 0; n < 2; ++n) {
            float kk[4][4], P[4][4]; f32x4 dec;
#pragma unroll
            for (int e = 0; e < 4; ++e) { const float omlb = omlbv[n][e]; float carry = 1.0f;
#pragma unroll
                for (int m = 0; m < 4; ++m) {
                    kk[m][e] = omlb * __builtin_amdgcn_rcpf(1.0f + __builtin_amdgcn_exp2f((1.4426950408889634f * rs[ai][m]) * acc[ai][1][m][n][e]));
                    const float f = 1.0f - kk[m][e];
                    float p = f;
                    p *= DPPF1(p, 0x111); p *= DPPF1(p, 0x112); p *= DPPF1(p, 0x114); p *= DPPF1(p, 0x118);
                    const float tot = __builtin_bit_cast(float, __builtin_amdgcn_ds_swizzle(__builtin_bit_cast(int, p), 0x1F0));
                    P[m][e] = p * carry; carry *= tot; }
                dec[e] = carry; }
            if (fr == 0) *(f32x4*)(J.decp + (size_t)((u.pm * BM + ai * HALF + wr * 64) >> 6) * 3072 + u.pn * 128 + colh + 4 * n) = dec;
#pragma unroll
            for (int m = 0; m < 4; ++m) { float qd[4], ki[4];
#pragma unroll
                for (int e = 0; e < 4; ++e) { qd[e] = silu_f(acc[ai][0][m][n][e] * rs[ai][m]) * 0.08838834764831845f * P[m][e]; ki[e] = kk[m][e] * __builtin_amdgcn_rcpf(P[m][e]); }
                bf16_t* rowp = J.O + (size_t)(row0 + ai * HALF + m * 16) * J.ldc + u.pn * BM + colh + 4 * n;
                u32x2 w; w.x = cvt_pk_bf16(qd[0], qd[1]); w.y = cvt_pk_bf16(qd[2], qd[3]); *(u32x2*)rowp = w;
                w.x = cvt_pk_bf16(ki[0], ki[1]); w.y = cvt_pk_bf16(ki[2], ki[3]); *(u32x2*)(rowp + HALF) = w; }
        }
    }
}
__device__ __forceinline__ void epilogue(const Job& J, const f32x4 (&acc)[2][2][4][2], const float (&rs)[2][4], const Unit& u, int wr, int wc, int fr, int fq) {
    if (J.kind == 4 && u.pn < 24) { epilogue_hgrn(J, acc, rs, u, wr, wc, fr, fq); return; }
    if (J.kind == 3) {
        const int row0 = u.pm * BM + wr * 64 + fr, col0 = u.pn * BM + wc * 32 + 4 * fq;
#pragma unroll
        for (int ai = 0; ai < 2; ++ai) {
            f32x4 bs[4][2][2];
#pragma unroll
            for (int m = 0; m < 4; ++m)
#pragma unroll
                for (int bj = 0; bj < 2; ++bj)
#pragma unroll
                    for (int n = 0; n < 2; ++n) bs[m][bj][n] = *(const f32x4*)(J.base + (size_t)(row0 + ai * HALF + m * 16) * J.ldc + col0 + bj * HALF + n * 16);
#pragma unroll
            for (int m = 0; m < 4; ++m)
#pragma unroll
                for (int bj = 0; bj < 2; ++bj)
#pragma unroll
                    for (int n = 0; n < 2; ++n) *(f32x4*)(J.out + (size_t)(row0 + ai * HALF + m * 16) * J.ldc + col0 + bj * HALF + n * 16) = bs[m][bj][n] + acc[ai][bj][m][n];
        }
        return;
    }
    const int row0 = u.pm * BM + wr * 64 + fr, col0 = u.pn * BM + wc * 32 + 8 * fq;
    const __amdgpu_buffer_rsrc_t orsrc = __builtin_amdgcn_make_buffer_rsrc((void*)J.O, 0, 0x7ffffff0, 0x00020000);
    if (J.kind == 5) {
#pragma unroll
        for (int ai = 0; ai < 2; ++ai) {
            f32x4 bs[4][2][2];
#pragma unroll
            for (int m = 0; m < 4; ++m)
#pragma unroll
                for (int bj = 0; bj < 2; ++bj)
#pragma unroll
                    for (int n = 0; n < 2; ++n) bs[m][bj][n] = *(const f32x4*)(J.base + (size_t)(row0 + ai * HALF + m * 16) * 2048 + col0 + bj * HALF + 4 * n);
            float ss[4];
#pragma unroll
            for (int m = 0; m < 4; ++m) { ss[m] = 0.f;
#pragma unroll
                for (int bj = 0; bj < 2; ++bj) { const f32x4 v0 = bs[m][bj][0] + acc[ai][bj][m][0], v1 = bs[m][bj][1] + acc[ai][bj][m][1];
                    ss[m] += (v0[0] * v0[0] + v0[1] * v0[1]) + (v0[2] * v0[2] + v0[3] * v0[3]) + (v1[0] * v1[0] + v1[1] * v1[1]) + (v1[2] * v1[2] + v1[3] * v1[3]);
                    u32x4 w; w.x = cvt_pk_bf16(v0[0], v0[1]); w.y = cvt_pk_bf16(v0[2], v0[3]); w.z = cvt_pk_bf16(v1[0], v1[1]); w.w = cvt_pk_bf16(v1[2], v1[3]);
                    __builtin_amdgcn_raw_buffer_store_b128(w, orsrc, ((unsigned)(row0 + ai * HALF + m * 16) * (unsigned)J.ldc + (unsigned)(col0 + bj * HALF)) * 2u, 0, 16); } }
#pragma unroll
            for (int m = 0; m < 4; ++m) { float t = ss[m]; t = xl_sum16(t); t = xl_sum32(t);
                if (fq == 0) (void)__hip_atomic_fetch_add(J.ssq + row0 + ai * HALF + m * 16, t, __ATOMIC_RELAXED, __HIP_MEMORY_SCOPE_AGENT); }
        }
        return;
    }
    if (J.kind == 6) {
#pragma unroll
        for (int ai = 0; ai < 2; ++ai) {
            u32x4 p[4][2];
#pragma unroll
            for (int m = 0; m < 4; ++m)
#pragma unroll
                for (int bj = 0; bj < 2; ++bj) p[m][bj] = *(const u32x4*)(J.O + (size_t)(row0 + ai * HALF + m * 16) * J.ldc + col0 + bj * HALF);
#pragma unroll
            for (int m = 0; m < 4; ++m)
#pragma unroll
                for (int bj = 0; bj < 2; ++bj) { const f32x4 v0 = acc[ai][bj][m][0], v1 = acc[ai][bj][m][1]; const u32x4 q = p[m][bj]; u32x4 w;
                    w.x = cvt_pk_bf16(bflo(q.x) + v0[0], bfhi(q.x) + v0[1]); w.y = cvt_pk_bf16(bflo(q.y) + v0[2], bfhi(q.y) + v0[3]);
                    w.z = cvt_pk_bf16(bflo(q.z) + v1[0], bfhi(q.z) + v1[1]); w.w = cvt_pk_bf16(bflo(q.w) + v1[2], bfhi(q.w) + v1[3]);
                    *(u32x4*)(J.O + (size_t)(row0 + ai * HALF + m * 16) * J.ldc + col0 + bj * HALF) = w; }
        }
        return;
    }
    if (J.kind == 2) {
        u32x4 p[4][2], w[4][2];
#define K2_OFF(ai, m, bj) (((unsigned)(row0 + (ai) * HALF + (m) * 16) * (unsigned)J.ldc + (unsigned)col0) * 2u + (bj) * (HALF * 2))
#define K2_LOAD(ai) _Pragma("unroll") for (int m = 0; m < 4; ++m) _Pragma("unroll") for (int bj = 0; bj < 2; ++bj) p[m][bj] = __builtin_bit_cast(u32x4, __builtin_amdgcn_raw_buffer_load_b128(orsrc, K2_OFF(ai, m, bj), 0, 0))
#define K2_MATH(ai) _Pragma("unroll") for (int m = 0; m < 4; ++m) _Pragma("unroll") for (int bj = 0; bj < 2; ++bj) { const f32x4 v0 = acc[ai][bj][m][0] * rs[ai][m], v1 = acc[ai][bj][m][1] * rs[ai][m]; const u32x4 q = p[m][bj]; \
            w[m][bj].x = cvt_pk_bf16(bflo(q.x) * silu_f(v0[0]), bfhi(q.x) * silu_f(v0[1])); w[m][bj].y = cvt_pk_bf16(bflo(q.y) * silu_f(v0[2]), bfhi(q.y) * silu_f(v0[3])); \
            w[m][bj].z = cvt_pk_bf16(bflo(q.z) * silu_f(v1[0]), bfhi(q.z) * silu_f(v1[1])); w[m][bj].w = cvt_pk_bf16(bflo(q.w) * silu_f(v1[2]), bfhi(q.w) * silu_f(v1[3])); }
#define K2_STORE(ai) _Pragma("unroll") for (int m = 0; m < 4; ++m) _Pragma("unroll") for (int bj = 0; bj < 2; ++bj) __builtin_amdgcn_raw_buffer_store_b128(w[m][bj], orsrc, K2_OFF(ai, m, bj), 0, 0)
        K2_LOAD(0); K2_MATH(0); asm volatile("" ::: "memory");
        K2_LOAD(1); asm volatile("" ::: "memory");
        K2_STORE(0); K2_MATH(1); K2_STORE(1);
#undef K2_LOAD
#undef K2_OFF
#undef K2_MATH
#undef K2_STORE
        return;
    }
    if (J.kind == 1) {
        f32x4 sc[2][2];
#pragma unroll
        for (int bj = 0; bj < 2; ++bj)
#pragma unroll
            for (int n = 0; n < 2; ++n) sc[bj][n] = *(const f32x4*)(J.colscale + col0 + bj * HALF + 4 * n);
#pragma unroll
        for (int ai = 0; ai < 2; ++ai)
#pragma unroll
            for (int m = 0; m < 4; ++m) { bf16_t* rowp = J.O + (size_t)(row0 + ai * HALF + m * 16) * J.ldc + col0;
#pragma unroll
                for (int bj = 0; bj < 2; ++bj) { const f32x4 v0 = acc[ai][bj][m][0] * sc[bj][0], v1 = acc[ai][bj][m][1] * sc[bj][1];
                    u32x4 w; w.x = cvt_pk_bf16(v0[0], v0[1]); w.y = cvt_pk_bf16(v0[2], v0[3]); w.z = cvt_pk_bf16(v1[0], v1[1]); w.w = cvt_pk_bf16(v1[2], v1[3]);
                    *(u32x4*)(rowp + bj * HALF) = w; } }
        return;
    }
#pragma unroll
    for (int ai = 0; ai < 2; ++ai)
#pragma unroll
        for (int m = 0; m < 4; ++m) { const unsigned rowoff = ((unsigned)(row0 + ai * HALF + m * 16) * (unsigned)J.ldc + (unsigned)col0) * 2u;
#pragma unroll
            for (int bj = 0; bj < 2; ++bj) { const f32x4 v0 = acc[ai][bj][m][0] * rs[ai][m], v1 = acc[ai][bj][m][1] * rs[ai][m];
                u32x4 w; w.x = cvt_pk_bf16(v0[0], v0[1]); w.y = cvt_pk_bf16(v0[2], v0[3]); w.z = cvt_pk_bf16(v1[0], v1[1]); w.w = cvt_pk_bf16(v1[2], v1[3]);
                __builtin_amdgcn_raw_buffer_store_b128(w, orsrc, rowoff + bj * (HALF * 2), 0, 16); } }
}

__device__ __forceinline__ void epilogue_final(const Job& J, f32x4 (&acc)[2][2][4][2], const Unit& u, int wid, int wr, int wc, int fr, int fq) {
    const int row0 = u.pm * BM + wr * 64 + fr, col0 = u.pn * BM + wc * 32 + 8 * fq;
    float ss[2][4];
    u32x4 p[2][4][2];
#pragma unroll
    for (int ai = 0; ai < 2; ++ai)
#pragma unroll
        for (int m = 0; m < 4; ++m)
#pragma unroll
            for (int bj = 0; bj < 2; ++bj) p[ai][m][bj] = *(const u32x4*)(J.O + (size_t)(row0 + ai * HALF + m * 16) * J.ldc + col0 + bj * HALF);
#pragma unroll
    for (int ai = 0; ai < 2; ++ai)
#pragma unroll
        for (int m = 0; m < 4; ++m) { float t = 0.f;
#pragma unroll
            for (int bj = 0; bj < 2; ++bj) { const u32x4 q = p[ai][m][bj];
                f32x4 v0 = acc[ai][bj][m][0], v1 = acc[ai][bj][m][1];
                v0[0] += bflo(q.x); v0[1] += bfhi(q.x); v0[2] += bflo(q.y); v0[3] += bfhi(q.y); v1[0] += bflo(q.z); v1[1] += bfhi(q.z); v1[2] += bflo(q.w); v1[3] += bfhi(q.w);
                t += (v0[0] * v0[0] + v0[1] * v0[1]) + (v0[2] * v0[2] + v0[3] * v0[3]) + (v1[0] * v1[0] + v1[1] * v1[1]) + (v1[2] * v1[2] + v1[3] * v1[3]);
                acc[ai][bj][m][0] = v0; acc[ai][bj][m][1] = v1; }
            ss[ai][m] = t; }
#pragma unroll
    for (int ai = 0; ai < 2; ++ai)
#pragma unroll
        for (int m = 0; m < 4; ++m) { const float t = xl_sum32(xl_sum16(ss[ai][m]));
            if (fq == 0) (void)__hip_atomic_fetch_add(J.ssq + row0 + ai * HALF + m * 16, t, __ATOMIC_RELAXED, __HIP_MEMORY_SCOPE_AGENT); }
    asm volatile("s_waitcnt vmcnt(0)" ::: "memory");
    __builtin_amdgcn_s_barrier();
    if (wid == 0 && fr == 0 && fq == 0) {
        unsigned* pc = J.pcnt + u.pm;
        (void)__hip_atomic_fetch_add(pc, 1u, __ATOMIC_RELAXED, __HIP_MEMORY_SCOPE_AGENT);
        unsigned sp = 0u;
        while (__hip_atomic_load(pc, __ATOMIC_RELAXED, __HIP_MEMORY_SCOPE_AGENT) < 8u) { __builtin_amdgcn_s_sleep(1); if (++sp > (1u << 22)) break; }
    }
    __builtin_amdgcn_s_barrier();
    f32x4 gn[2][2];
#pragma unroll
    for (int bj = 0; bj < 2; ++bj)
#pragma unroll
        for (int n = 0; n < 2; ++n) gn[bj][n] = *(const f32x4*)(J.colscale + col0 + bj * HALF + 4 * n);
#pragma unroll
    for (int ai = 0; ai < 2; ++ai)
#pragma unroll
        for (int m = 0; m < 4; ++m) ss[ai][m] = __hip_atomic_load(J.ssq + row0 + ai * HALF + m * 16, __ATOMIC_RELAXED, __HIP_MEMORY_SCOPE_AGENT);
#pragma unroll
    for (int ai = 0; ai < 2; ++ai)
#pragma unroll
        for (int m = 0; m < 4; ++m) { const float r = 1.0f / sqrtf(ss[ai][m] * (1.f / 2048.f) + 1e-6f);
            float* orow = J.out + (size_t)(row0 + ai * HALF + m * 16) * 2048 + col0;
#pragma unroll
            for (int bj = 0; bj < 2; ++bj) { *(f32x4*)(orow + bj * HALF) = acc[ai][bj][m][0] * r * gn[bj][0]; *(f32x4*)(orow + bj * HALF + 4) = acc[ai][bj][m][1] * r * gn[bj][1]; } }
}

__device__ __forceinline__ void gemm_phase(LAS unsigned char* lds, const Job& J, const int tid) {
    constexpr bool ALIGN_EPI = true;
    const int wid = __builtin_amdgcn_readfirstlane(tid >> 6), lane = tid & 63, wr = wid >> 2, wc = wid & 3, fr = lane & 15, fq = lane >> 4;
    const int K = J.K, nt = K / BK;
    const bool perm = (J.kind != 3);
    StaticOrder S; S.init(J.M, J.N, J.G, J.c, J.wgm);
    unsigned voffA[2], voffB[2];
#pragma unroll
    for (int i = 0; i < 2; ++i) { int R, C; stage_rc(tid * 16 + i * 8192, R, C); const int Rb = perm ? ((R & ~31) + perm32(R & 31)) : R;
        voffA[i] = (unsigned)(R * J.lda + C) * 2u; voffB[i] = (unsigned)(Rb * J.ldb + C) * 2u; }
    const size_t kstep = (size_t)(BK * 2);
    const size_t hstepA = (size_t)HALF * J.lda * 2, hstepB = (size_t)HALF * J.ldb * 2;
    const size_t tstepA = 2 * hstepA, tstepB = 2 * hstepB;
    const unsigned ldsw = (unsigned)wid * 1024u;
    const int aoff = lds_byte(wr * 64 + fr, fq * 8), boff = lds_byte(wc * 32 + fr, fq * 8);
#define PG8_SA(b, h) (((b) * 2 + (h)) * HTB)
#define PG8_SB(b, h) ((4 + (b) * 2 + (h)) * HTB)
#define PG8_STAGE(bufoff, gbase, voff) do { _Pragma("unroll") for (int _i = 0; _i < 2; ++_i) \
        __builtin_amdgcn_global_load_lds((const unsigned*)((const char*)(gbase) + (voff)[_i]), (LAS unsigned*)(lds + (bufoff) + ldsw + _i * 8192), 16, 0, 0); } while (0)
#define PG8_LDA(dst, b, h) do { _Pragma("unroll") for (int m = 0; m < 4; ++m) _Pragma("unroll") for (int k = 0; k < 2; ++k) dst[m][k] = *(const LAS bf16x8*)(lds + PG8_SA(b, h) + aoff + m * 2048 + k * 1024); } while (0)
#define PG8_LDB(dst, b, h) do { _Pragma("unroll") for (int n = 0; n < 2; ++n) _Pragma("unroll") for (int k = 0; k < 2; ++k) dst[n][k] = *(const LAS bf16x8*)(lds + PG8_SB(b, h) + boff + n * 2048 + k * 1024); } while (0)
#define PG8_MMA(ai, bj, At, Bt) do { __builtin_amdgcn_s_setprio(1); _Pragma("unroll") for (int m = 0; m < 4; ++m) _Pragma("unroll") for (int n = 0; n < 2; ++n) _Pragma("unroll") for (int k = 0; k < 2; ++k) \
        acc[ai][bj][m][n] = __builtin_amdgcn_mfma_f32_16x16x32_bf16(Bt[n][k], At[m][k], acc[ai][bj][m][n], 0, 0, 0); __builtin_amdgcn_s_setprio(0); } while (0)
#define PG8_WAIT_V(n) asm volatile("s_waitcnt vmcnt(" #n ")" ::: "memory")
#define PG8_WAIT_L(n) asm volatile("s_waitcnt lgkmcnt(" #n ")" ::: "memory")
#define PG8_BAR __builtin_amdgcn_s_barrier()
#define PG8_SCHED __builtin_amdgcn_sched_barrier(0)
#define PG8_APTR(u) ((const char*)J.A + (size_t)(u).pm * tstepA + (size_t)((u).pn / J.grp_tiles) * (size_t)J.grp_stride * 2)
#define PG8_BPTR(u) ((const char*)J.Bt + (size_t)(u).pn * tstepB + (size_t)((u).pm / J.bgrp_tiles) * (size_t)J.bgrp_stride * 2)
    Unit cur, nxt; int ui = 0;
    if (!S.next(0, cur)) return;
    f32x4 acc[2][2][4][2];
#pragma unroll
    for (int a = 0; a < 2; ++a)
#pragma unroll
        for (int b = 0; b < 2; ++b)
#pragma unroll
            for (int m = 0; m < 4; ++m)
#pragma unroll
                for (int n = 0; n < 2; ++n) acc[a][b][m][n] = (f32x4){0.f, 0.f, 0.f, 0.f};
    bf16x8 At[4][2], B0[2][2], B1[2][2];
    const char* cA = PG8_APTR(cur); const char* cB = PG8_BPTR(cur);
    PG8_STAGE(PG8_SB(0, 0), cB, voffB); PG8_STAGE(PG8_SB(0, 1), cB + hstepB, voffB); PG8_STAGE(PG8_SA(0, 0), cA, voffA); PG8_STAGE(PG8_SA(0, 1), cA + hstepA, voffA);
    if (wr == 1) PG8_BAR;
    PG8_WAIT_V(2); PG8_BAR;
    PG8_STAGE(PG8_SB(1, 0), cB + kstep, voffB); PG8_STAGE(PG8_SA(1, 0), cA + kstep, voffA); PG8_STAGE(PG8_SB(1, 1), cB + hstepB + kstep, voffB);
    PG8_WAIT_V(6); PG8_BAR;
    for (;;) {
        const bool has_next = S.next(ui + 1, nxt);
        const char* nA = has_next ? PG8_APTR(nxt) : cA; const char* nB = has_next ? PG8_BPTR(nxt) : cB;
        for (int t = 0; t < nt; t += 2) {
            const bool last = (t == nt - 2);
            const char* a1 = cA + (size_t)(t + 1) * kstep;
            const char* a2 = last ? nA : cA + (size_t)(t + 2) * kstep; const char* b2 = last ? nB : cB + (size_t)(t + 2) * kstep;
            const char* a3 = a2 + kstep; const char* b3 = b2 + kstep;
            PG8_LDB(B0, 0, 0); PG8_LDB(B1, 0, 1); PG8_SCHED; PG8_LDA(At, 0, 0); PG8_STAGE(PG8_SA(1, 1), a1 + hstepA, voffA);
            PG8_WAIT_V(8); PG8_WAIT_L(0); PG8_BAR; PG8_MMA(0, 0, At, B0); PG8_MMA(0, 1, At, B1); PG8_BAR; PG8_SCHED;
            PG8_LDA(At, 0, 1); PG8_STAGE(PG8_SB(0, 0), b2, voffB); PG8_STAGE(PG8_SB(0, 1), b2 + hstepB, voffB); PG8_STAGE(PG8_SA(0, 0), a2, voffA);
            PG8_WAIT_V(8); PG8_WAIT_L(0); PG8_BAR; PG8_MMA(1, 0, At, B0); PG8_MMA(1, 1, At, B1); PG8_BAR; PG8_SCHED;
            PG8_LDB(B0, 1, 0); PG8_LDB(B1, 1, 1); PG8_SCHED; PG8_LDA(At, 1, 0); PG8_STAGE(PG8_SA(0, 1), a2 + hstepA, voffA);
            PG8_WAIT_V(8); PG8_WAIT_L(0); PG8_BAR; PG8_MMA(0, 0, At, B0); PG8_MMA(0, 1, At, B1); PG8_BAR; PG8_SCHED;
            PG8_LDA(At, 1, 1); PG8_STAGE(PG8_SB(1, 0), b3, voffB); PG8_STAGE(PG8_SB(1, 1), b3 + hstepB, voffB); PG8_STAGE(PG8_SA(1, 0), a3, voffA);
            PG8_WAIT_V(8); PG8_WAIT_L(0); PG8_BAR; PG8_MMA(1, 0, At, B0); PG8_MMA(1, 1, At, B1); PG8_BAR; PG8_SCHED;
        }
        if constexpr (ALIGN_EPI) { if (wr == 0) PG8_BAR; }
        int fr_e = fr, fq_e = fq; asm volatile("" : "+v"(fr_e), "+v"(fq_e));
        float rs[2][4];
#pragma unroll
        for (int a = 0; a < 2; ++a)
#pragma unroll
            for (int m = 0; m < 4; ++m) rs[a][m] = 0.f;
        if (J.rowss != nullptr) {
#pragma unroll
            for (int a = 0; a < 2; ++a)
#pragma unroll
                for (int m = 0; m < 4; ++m) rs[a][m] = J.rowss[cur.pm * BM + wr * 64 + fr_e + a * HALF + m * 16];
        }
#pragma unroll
        for (int a = 0; a < 2; ++a)
#pragma unroll
            for (int m = 0; m < 4; ++m) rs[a][m] = (J.rowss != nullptr) ? 1.0f / sqrtf(rs[a][m] * (1.f / 2048.f) + 1e-6f) : 1.0f;
        if (J.kind == 7) epilogue_final(J, acc, cur, wid, wr, wc, fr_e, fq_e); else epilogue(J, acc, rs, cur, wr, wc, fr_e, fq_e);
        if (!has_next) break;
#pragma unroll
        for (int a = 0; a < 2; ++a)
#pragma unroll
            for (int b = 0; b < 2; ++b)
#pragma unroll
                for (int m = 0; m < 4; ++m)
#pragma unroll
                    for (int n = 0; n < 2; ++n) acc[a][b][m][n] = (f32x4){0.f, 0.f, 0.f, 0.f};
        cur = nxt; cA = nA; cB = nB; ++ui;
        if constexpr (ALIGN_EPI) { if (wr == 1) PG8_BAR; }
    }
    PG8_WAIT_V(0);
    if constexpr (!ALIGN_EPI) { if (wr == 0) PG8_BAR; }
    PG8_BAR;
#undef PG8_SA
#undef PG8_SB
#undef PG8_STAGE
#undef PG8_LDA
#undef PG8_LDB
#undef PG8_MMA
#undef PG8_WAIT_V
#undef PG8_WAIT_L
#undef PG8_BAR
#undef PG8_SCHED
#undef PG8_APTR
#undef PG8_BPTR
}
}

constexpr int RING_OFF = 0, RING_BYTES = 131072;
constexpr int LDS_BYTES = 163840;
constexpr int LDSCTL_OFF = LDS_BYTES - 1024, MISC_OFF = LDSCTL_OFF + 320;
constexpr int NWAVES = 8;

constexpr int CW_BAR = 4096, CW_SUB = 8192;

#define RLX_AGENT __ATOMIC_RELAXED, __HIP_MEMORY_SCOPE_AGENT
#define LDS_WAIT() asm volatile("s_waitcnt lgkmcnt(0)" ::: "memory")
#define VM_WAIT() asm volatile("s_waitcnt vmcnt(0)" ::: "memory")
__device__ __forceinline__ unsigned f2bf(float f) { unsigned u = __builtin_bit_cast(unsigned, f); return (u + 0x7fffu + ((u >> 16) & 1u)) >> 16; }
__device__ __forceinline__ unsigned pk2(float lo, float hi) { return f2bf(lo) | (f2bf(hi) << 16); }
__device__ __forceinline__ float bf2f(bf16_t b) { return __uint_as_float((unsigned)b << 16); }

#define XB_TMO      128
#define XB_XCNT(j)  (256  + 64 * (j))
#define XB_XSUB(j)  (1280 + 64 * (j))
#define XB_XGEN(j)  (2304 + 64 * (j))
#define XB_TOP      3328
#define XB_TOPGEN   3392
#define XCD_BAR_WORDS 3456
#define XB_SPIN_CAP (1u << 20)

__device__ __forceinline__ unsigned xb_ld(unsigned* p)              { return __hip_atomic_load(p, __ATOMIC_RELAXED, __HIP_MEMORY_SCOPE_AGENT); }
__device__ __forceinline__ unsigned xb_add(unsigned* p, unsigned v) { return __hip_atomic_fetch_add(p, v, __ATOMIC_RELAXED, __HIP_MEMORY_SCOPE_AGENT); }
__device__ __forceinline__ unsigned xb_xcc_id() { return (unsigned)__builtin_amdgcn_s_getreg((3 << 11) | 20) & 0xFu; }
#define XB_SPIN(cond, bar) do { unsigned _sp = 0; while (cond) { __builtin_amdgcn_s_sleep(1); \
    if ((++_sp & 255u) == 0u) { if (xb_ld(&(bar)[XB_TMO])) break; if (_sp > XB_SPIN_CAP) { atomicAdd(&(bar)[XB_TMO], 1u); break; } } } } while (0)

__device__ __forceinline__ int lane_id_now() { int l; asm volatile("v_mbcnt_lo_u32_b32 %0, -1, 0\n\tv_mbcnt_hi_u32_b32 %0, -1, %0" : "=v"(l)); return l; }

struct XcdBarrier { unsigned* bar; unsigned x; volatile LAS unsigned* st; };

__device__ __forceinline__ XcdBarrier xcd_barrier_post(unsigned* bar, volatile LAS unsigned* st) {
    XcdBarrier b; b.bar = bar; b.x = xb_xcc_id(); b.st = st;
    if (threadIdx.x == 0) (void)xb_add(&bar[XB_XCNT(b.x)], 1u);
    return b;
}
__device__ __forceinline__ void xcd_barrier_complete(unsigned* bar, unsigned x, unsigned& nloc, unsigned& nx) {
    const unsigned G = gridDim.x * gridDim.y * gridDim.z;
    unsigned sum, cnt, mine, sp = 0u;
    for (;;) {
        sum = 0u; cnt = 0u; mine = 0u;
#pragma unroll
        for (unsigned j = 0; j < 16; ++j) { const unsigned c = xb_ld(&bar[XB_XCNT(j)]); sum += c; cnt += (c > 0u) ? 1u : 0u; mine = (j == x) ? c : mine; }
        if (sum == G) break;
        __builtin_amdgcn_s_sleep(1);
        if ((++sp & 255u) == 0u) { if (xb_ld(&bar[XB_TMO])) break; if (sp > XB_SPIN_CAP) { atomicAdd(&bar[XB_TMO], 1u); break; } }
    }
    nloc = mine > 0u ? mine : 1u; nx = cnt > 0u ? cnt : 1u;
}
__device__ __forceinline__ void xcd_barrier(const XcdBarrier& b, int wave_s) {
    asm volatile("s_waitcnt vmcnt(0)" ::: "memory");
    __syncthreads();
    if (wave_s == 0 && lane_id_now() == 0) {
        unsigned* bar = b.bar;
        __builtin_amdgcn_s_waitcnt(0);
        unsigned nloc = b.st[0], nx = b.st[1];
        if (nloc == 0u) { xcd_barrier_complete(bar, b.x, nloc, nx); b.st[0] = nloc; b.st[1] = nx; }
        const unsigned old = xb_add(&bar[XB_XSUB(b.x)], 1u);
        const unsigned gen = old / nloc;
        if (old + 1u == (gen + 1u) * nloc) {
            __builtin_amdgcn_fence(__ATOMIC_RELEASE, "agent");
            asm volatile("s_waitcnt vmcnt(0)" ::: "memory");
            const unsigned og = xb_add(&bar[XB_TOP], 1u);
            const unsigned tg = og / nx;
            if (og + 1u == (tg + 1u) * nx) xb_add(&bar[XB_TOPGEN], 1u);
            else XB_SPIN(xb_ld(&bar[XB_TOPGEN]) == tg, bar);
            __builtin_amdgcn_fence(__ATOMIC_ACQUIRE, "agent");
            xb_add(&bar[XB_XGEN(b.x)], 1u);
            asm volatile("s_waitcnt vmcnt(0)" ::: "memory");
        } else {
            XB_SPIN(xb_ld(&bar[XB_XGEN(b.x)]) == gen, bar);
            __builtin_amdgcn_fence(__ATOMIC_ACQUIRE, "agent");
            asm volatile("s_waitcnt vmcnt(0)" ::: "memory");
        }
    }
    __syncthreads();
}

struct Args {
    const float* x; const float* mem; const float* norm_g; const float* mem_norm_g; const float* w_kv; const float* w_out;
    const float* pool_w_in; const float* pool_w_grp; const float* pool_scale; const float* hgrn_w_in; const float* hgrn_lb;
    const float* hgrn_norm_g; const float* final_g; float* out; unsigned char* ws; int ph_lo, ph_hi;
};

__device__ __forceinline__ float wave_sum(float v) { return pg8::xl_sum32(pg8::xl_sum16(pg8::xl_row_sum(v))); }
__device__ __forceinline__ float wave_max(float v) { return pg8::xl_max32(pg8::xl_max16(pg8::xl_row_max(v))); }

template <bool GAIN = false>
__device__ __forceinline__ void transpose_item(const float* W, int N, int k0, int n0, bf16_t* WT, int ldt, int orow0, LAS float* scr, int lane, const float* gk = nullptr) {
    f32x4 v[16]; float gs[16];
    const float* src = W + (size_t)(k0 + (lane >> 4)) * N + n0 + 4 * (lane & 15);
#pragma unroll
    for (int j = 0; j < 16; ++j) v[j] = *(const f32x4*)(src + (size_t)(4 * j) * N);
    if constexpr (GAIN) {
#pragma unroll
        for (int j = 0; j < 16; ++j) gs[j] = gk[k0 + 4 * j + (lane >> 4)];
#pragma unroll
        for (int j = 0; j < 16; ++j) v[j] = v[j] * gs[j];
    }
#pragma unroll
    for (int j = 0; j < 16; ++j) { LAS float* d = scr + (4 * j + (lane >> 4)) * 65 + 4 * (lane & 15); d[0] = v[j].x; d[1] = v[j].y; d[2] = v[j].z; d[3] = v[j].w; }
    LDS_WAIT(); asm volatile("" ::: "memory");
    const int c = lane & 7;
#pragma unroll
    for (int j = 0; j < 8; ++j) { const int n = (lane >> 3) + 8 * j; const LAS float* s = scr + (8 * c) * 65 + n;
        u32x4 o; o.x = pk2(s[0 * 65], s[1 * 65]); o.y = pk2(s[2 * 65], s[3 * 65]); o.z = pk2(s[4 * 65], s[5 * 65]); o.w = pk2(s[6 * 65], s[7 * 65]);
        *(u32x4*)(WT + (size_t)(orow0 + n) * ldt + k0 + 8 * c) = o; }
    LDS_WAIT(); asm volatile("" ::: "memory");
}

__device__ __forceinline__ void rms_row_to_bf16(const float* xrow, const f32x4 (&gv)[8], bf16_t* orow, int lane) {
    const f32x4* xr = (const f32x4*)xrow + lane;
    f32x4 v[8]; float s = 0.f;
#pragma unroll
    for (int j = 0; j < 8; ++j) v[j] = xr[64 * j];
    asm volatile("" ::: "memory");
#pragma unroll
    for (int j = 0; j < 8; ++j) s += (v[j].x * v[j].x + v[j].y * v[j].y) + (v[j].z * v[j].z + v[j].w * v[j].w);
    const float r = 1.0f / sqrtf(wave_sum(s) * (1.f / DM) + EPS);
    unsigned long long* o8 = (unsigned long long*)orow + lane;
#pragma unroll
    for (int j = 0; j < 8; ++j) { const f32x4 gg = gv[j];
        o8[64 * j] = (unsigned long long)pk2(v[j].x * r * gg.x, v[j].y * r * gg.y) | ((unsigned long long)pk2(v[j].z * r * gg.z, v[j].w * r * gg.w) << 32); }
}
__device__ __forceinline__ void rms_row2_to_bf16(const float* x0, const float* x1, const f32x4 (&gv)[8], bf16_t* o0, bf16_t* o1, int lane) {
    const f32x4* xr0 = (const f32x4*)x0 + lane; const f32x4* xr1 = (const f32x4*)x1 + lane;
    f32x4 v0[8], v1[8]; float s0 = 0.f, s1 = 0.f;
#pragma unroll
    for (int j = 0; j < 8; ++j) { v0[j] = xr0[64 * j]; v1[j] = xr1[64 * j]; }
    asm volatile("" ::: "memory");
#pragma unroll
    for (int j = 0; j < 8; ++j) { s0 += (v0[j].x * v0[j].x + v0[j].y * v0[j].y) + (v0[j].z * v0[j].z + v0[j].w * v0[j].w); s1 += (v1[j].x * v1[j].x + v1[j].y * v1[j].y) + (v1[j].z * v1[j].z + v1[j].w * v1[j].w); }
    s0 = wave_sum(s0); s1 = wave_sum(s1);
    const float r0 = 1.0f / sqrtf(s0 * (1.f / DM) + EPS), r1 = 1.0f / sqrtf(s1 * (1.f / DM) + EPS);
    unsigned long long* p0 = (unsigned long long*)o0 + lane; unsigned long long* p1 = (unsigned long long*)o1 + lane;
#pragma unroll
    for (int j = 0; j < 8; ++j) { const f32x4 gg = gv[j];
        p0[64 * j] = (unsigned long long)pk2(v0[j].x * r0 * gg.x, v0[j].y * r0 * gg.y) | ((unsigned long long)pk2(v0[j].z * r0 * gg.z, v0[j].w * r0 * gg.w) << 32);
        p1[64 * j] = (unsigned long long)pk2(v1[j].x * r1 * gg.x, v1[j].y * r1 * gg.y) | ((unsigned long long)pk2(v1[j].z * r1 * gg.z, v1[j].w * r1 * gg.w) << 32); }
}
__device__ __forceinline__ void rms_row_f32(float* xrow, const f32x4 (&gv)[8], int lane) {
    f32x4* xr = (f32x4*)xrow + lane;
    f32x4 v[8]; float s = 0.f;
#pragma unroll
    for (int j = 0; j < 8; ++j) v[j] = xr[64 * j];
    asm volatile("" ::: "memory");
#pragma unroll
    for (int j = 0; j < 8; ++j) s += (v[j].x * v[j].x + v[j].y * v[j].y) + (v[j].z * v[j].z + v[j].w * v[j].w);
    const float r = 1.0f / sqrtf(wave_sum(s) * (1.f / DM) + EPS);
#pragma unroll
    for (int j = 0; j < 8; ++j) { const f32x4 gg = gv[j]; xr[64 * j] = (f32x4){v[j].x * r * gg.x, v[j].y * r * gg.y, v[j].z * r * gg.z, v[j].w * r * gg.w}; }
}
__device__ __forceinline__ void rms_row_bf16_to_f32(const bf16_t* hrow, const f32x4 (&gv)[8], float* orow, int lane) {
    const u32x2* hr = (const u32x2*)hrow + lane;
    u32x2 v[8]; float s = 0.f;
#pragma unroll
    for (int j = 0; j < 8; ++j) v[j] = hr[64 * j];
    asm volatile("" ::: "memory");
    f32x4 f[8];
#pragma unroll
    for (int j = 0; j < 8; ++j) { f[j] = (f32x4){pg8::bflo(v[j].x), pg8::bfhi(v[j].x), pg8::bflo(v[j].y), pg8::bfhi(v[j].y)}; s += (f[j].x * f[j].x + f[j].y * f[j].y) + (f[j].z * f[j].z + f[j].w * f[j].w); }
    const float r = 1.0f / sqrtf(wave_sum(s) * (1.f / DM) + EPS);
    f32x4* o = (f32x4*)orow + lane;
#pragma unroll
    for (int j = 0; j < 8; ++j) { const f32x4 gg = gv[j]; o[64 * j] = (f32x4){f[j].x * r * gg.x, f[j].y * r * gg.y, f[j].z * r * gg.z, f[j].w * r * gg.w}; }
}
__device__ __forceinline__ void rms_row2_bf16_to_f32(const bf16_t* h0, const bf16_t* h1, const f32x4 (&gv)[8], float* o0, float* o1, int lane) {
    const u32x2* hr0 = (const u32x2*)h0 + lane; const u32x2* hr1 = (const u32x2*)h1 + lane;
    u32x2 v0[8], v1[8]; float s0 = 0.f, s1 = 0.f;
#pragma unroll
    for (int j = 0; j < 8; ++j) { v0[j] = hr0[64 * j]; v1[j] = hr1[64 * j]; }
    asm volatile("" ::: "memory");
#pragma unroll
    for (int j = 0; j < 8; ++j) { const float a = pg8::bflo(v0[j].x), b = pg8::bfhi(v0[j].x), c = pg8::bflo(v0[j].y), d = pg8::bfhi(v0[j].y); s0 += (a * a + b * b) + (c * c + d * d);
        const float e = pg8::bflo(v1[j].x), f = pg8::bfhi(v1[j].x), g = pg8::bflo(v1[j].y), h = pg8::bfhi(v1[j].y); s1 += (e * e + f * f) + (g * g + h * h); }
    s0 = wave_sum(s0); s1 = wave_sum(s1);
    const float r0 = 1.0f / sqrtf(s0 * (1.f / DM) + EPS), r1 = 1.0f / sqrtf(s1 * (1.f / DM) + EPS);
    f32x4* p0 = (f32x4*)o0 + lane; f32x4* p1 = (f32x4*)o1 + lane;
#pragma unroll
    for (int j = 0; j < 8; ++j) { const f32x4 gg = gv[j];
        p0[64 * j] = (f32x4){pg8::bflo(v0[j].x) * r0 * gg.x, pg8::bfhi(v0[j].x) * r0 * gg.y, pg8::bflo(v0[j].y) * r0 * gg.z, pg8::bfhi(v0[j].y) * r0 * gg.w};
        p1[64 * j] = (f32x4){pg8::bflo(v1[j].x) * r1 * gg.x, pg8::bfhi(v1[j].x) * r1 * gg.y, pg8::bflo(v1[j].y) * r1 * gg.z, pg8::bfhi(v1[j].y) * r1 * gg.w}; }
}
__device__ __forceinline__ void load_gain(const float* g, f32x4 (&gv)[8], int lane) {
#pragma unroll
    for (int j = 0; j < 8; ++j) gv[j] = *((const f32x4*)g + lane + 64 * j);
}

__device__ __forceinline__ float dot256(const bf16_t* row, const LAS float* vec) {
    float s = 0.f;
#pragma unroll 4
    for (int c = 0; c < 32; ++c) { const u32x4 w = *(const u32x4*)(row + 8 * c); const LAS f32x4* vv = (const LAS f32x4*)(vec + 8 * c); const f32x4 a = vv[0], b = vv[1];
        s += pg8::bflo(w.x) * a.x + pg8::bfhi(w.x) * a.y + pg8::bflo(w.y) * a.z + pg8::bfhi(w.y) * a.w + pg8::bflo(w.z) * b.x + pg8::bfhi(w.z) * b.y + pg8::bflo(w.w) * b.z + pg8::bfhi(w.w) * b.w; }
    return s;
}


typedef float f32x16 __attribute__((ext_vector_type(16)));
typedef short s16x4 __attribute__((ext_vector_type(4)));
#define MFMA32(a, b, c) __builtin_amdgcn_mfma_f32_32x32x16_bf16((a), (b), (c), 0, 0, 0)
__device__ __forceinline__ bf16x8 pack8(const f32x16& x, int s) {
    u32x4 p; p.x = pg8::cvt_pk_bf16(x[8 * s], x[8 * s + 1]); p.y = pg8::cvt_pk_bf16(x[8 * s + 2], x[8 * s + 3]); p.z = pg8::cvt_pk_bf16(x[8 * s + 4], x[8 * s + 5]); p.w = pg8::cvt_pk_bf16(x[8 * s + 6], x[8 * s + 7]);
    return __builtin_bit_cast(bf16x8, p);
}
__device__ __forceinline__ bf16x8 cat44(u32x2 lo, u32x2 hi) { u32x4 p; p.x = lo.x; p.y = lo.y; p.z = hi.x; p.w = hi.y; return __builtin_bit_cast(bf16x8, p); }

constexpr int CAROW = 528, CATILE = 32 * CAROW, CASTG = 2 * CATILE, CASROW = 80;
__device__ __forceinline__ void ca_unit(const bf16_t* Qu  , bf16_t* Ou  , int ldq, int ldo, const bf16_t* Kb  , const bf16_t* Vtb  , LAS unsigned char* lds, int tid) {
    const int lane = tid & 63, w = __builtin_amdgcn_readfirstlane(tid >> 6), r = lane & 31, h = lane >> 5;
    const int srow = tid >> 4, spc = tid & 15;
    bf16x8 qf[16];
#pragma unroll
    for (int ks = 0; ks < 16; ++ks) qf[ks] = *(const bf16x8*)(Qu + (size_t)(32 * w + r) * ldq + 16 * ks + 8 * h);
    u32x4 sr[2][2];
    const __amdgpu_buffer_rsrc_t krs = __builtin_amdgcn_make_buffer_rsrc((void*)Kb, 0, 0x7ffffff0, 0x00020000), vrs = __builtin_amdgcn_make_buffer_rsrc((void*)Vtb, 0, 0x7ffffff0, 0x00020000);
    const unsigned kvo = ((unsigned)srow * 2048u + 16u * spc) * 2u, vvo = ((unsigned)srow * (unsigned)MROWS + 16u * spc) * 2u;
#define CA_LOAD(t) do { if ((t) < 8) { sr[(t) & 1][0] = __builtin_bit_cast(u32x4, __builtin_amdgcn_raw_buffer_load_b128(krs, kvo, (t) * (32 * 2048 * 2), 0)); sr[(t) & 1][1] = __builtin_bit_cast(u32x4, __builtin_amdgcn_raw_buffer_load_b128(krs, kvo + 16u, (t) * (32 * 2048 * 2), 0)); } \
        else { sr[(t) & 1][0] = __builtin_bit_cast(u32x4, __builtin_amdgcn_raw_buffer_load_b128(vrs, vvo, ((t) - 8) * (32 * MROWS * 2), 0)); sr[(t) & 1][1] = __builtin_bit_cast(u32x4, __builtin_amdgcn_raw_buffer_load_b128(vrs, vvo + 16u, ((t) - 8) * (32 * MROWS * 2), 0)); } } while (0)
#define CA_WRITE(t) do { LAS unsigned char* d_ = lds + ((t) & 1) * CATILE + srow * CAROW + 32 * spc; *(LAS u32x4*)d_ = sr[(t) & 1][0]; *(LAS u32x4*)(d_ + 16) = sr[(t) & 1][1]; } while (0)
    CA_LOAD(0); CA_LOAD(1); CA_WRITE(0); CA_LOAD(2);
    __syncthreads();
    f32x16 X[8];
#pragma unroll
    for (int kt = 0; kt < 8; ++kt) {
        if (kt >= 1) CA_LOAD(kt + 2);
#pragma unroll
        for (int i = 0; i < 16; ++i) X[kt][i] = 0.f;
        const LAS unsigned char* kp = lds + (kt & 1) * CATILE + r * CAROW + h * 16;
#pragma unroll
        for (int ks = 0; ks < 16; ++ks) { const bf16x8 a = *(const LAS bf16x8*)(kp + 32 * ks); X[kt] = MFMA32(a, qf[ks], X[kt]); }
        CA_WRITE(kt + 1);
        __syncthreads();
    }
    float mx = -3.0e38f;
#pragma unroll
    for (int kt = 0; kt < 8; ++kt)
#pragma unroll
        for (int i = 0; i < 16; ++i) mx = fmaxf(mx, X[kt][i]);
    mx = pg8::xl_max32(mx);
    const float c = 0.0625f * 1.4426950408889634f; float sm = 0.f;
#pragma unroll
    for (int kt = 0; kt < 8; ++kt)
#pragma unroll
        for (int i = 0; i < 16; ++i) { X[kt][i] = __builtin_amdgcn_exp2f((X[kt][i] - mx) * c); sm += X[kt][i]; }
    sm = pg8::xl_sum32(sm);
    const float inv = 1.0f / sm;
    bf16x8 pa[8][2];
#pragma unroll
    for (int kt = 0; kt < 8; ++kt) {
#pragma unroll
        for (int i = 0; i < 16; ++i) X[kt][i] *= inv;
        pa[kt][0] = pack8(X[kt], 0); pa[kt][1] = pack8(X[kt], 1);
    }
    LAS unsigned char* stg = lds + CASTG + w * (32 * CASROW);
#define CA_PV(dt) do { f32x16 Z; if ((dt) < 6) CA_LOAD(8 + (dt) + 2); \
        _Pragma("unroll") for (int i = 0; i < 16; ++i) Z[i] = 0.f; \
        const LAS unsigned char* vp = lds + ((dt) & 1) * CATILE + r * CAROW + h * 8; \
        _Pragma("unroll") for (int kt = 0; kt < 8; ++kt) _Pragma("unroll") for (int ss = 0; ss < 2; ++ss) { const u32x2 lo = *(const LAS u32x2*)(vp + (32 * kt + 16 * ss) * 2), hi = *(const LAS u32x2*)(vp + (32 * kt + 16 * ss) * 2 + 16); Z = MFMA32(cat44(lo, hi), pa[kt][ss], Z); } \
          \
        _Pragma("unroll") for (int g = 0; g < 4; ++g) { u32x2 o; o.x = pg8::cvt_pk_bf16(Z[4 * g], Z[4 * g + 1]); o.y = pg8::cvt_pk_bf16(Z[4 * g + 2], Z[4 * g + 3]); *(LAS u32x2*)(stg + r * CASROW + (8 * g + 4 * h) * 2) = o; } \
        if ((dt) < 7) CA_WRITE(8 + (dt) + 1);        \
        LDS_WAIT(); asm volatile("" ::: "memory"); \
        { const int q = lane >> 1, hf = lane & 1; const u32x4 v0 = *(const LAS u32x4*)(stg + q * CASROW + 32 * hf), v1 = *(const LAS u32x4*)(stg + q * CASROW + 32 * hf + 16); \
          bf16_t* op = Ou + (size_t)(32 * w + q) * ldo + 32 * (dt) + 16 * hf; *(u32x4*)op = v0; *(u32x4*)(op + 8) = v1; } \
        __syncthreads(); } while (0)
#pragma unroll 1
    for (int d2 = 0; d2 < 8; d2 += 2) { CA_PV(d2); CA_PV(d2 + 1); }
#undef CA_PV
#undef CA_LOAD
#undef CA_WRITE
}

constexpr int HROW = 272, HKROW = 256, HVROW = 320, HQD = 0, HKI = 17408, HV = HKI + 64 * HKROW, HDEC = HV + 64 * HVROW, HSET = HDEC + 512, HOUT = 2 * HSET, HOROW = 272, HOUTB = 64 * HOROW, HNG = HOUT + 2 * HOUTB;
static_assert(HNG + 512 <= LDSCTL_OFF, "hgrn LDS map");
#define RAW_BAR() do { asm volatile("s_waitcnt lgkmcnt(0)" ::: "memory"); __builtin_amdgcn_s_barrier(); asm volatile("" ::: "memory"); } while (0)
typedef short v4i16_t __attribute__((ext_vector_type(4)));
__device__ __forceinline__ u32x2 tr_read(const LAS unsigned char* p) { return __builtin_bit_cast(u32x2, __builtin_amdgcn_ds_read_tr16_b64_v4i16((LAS v4i16_t*)p)); }
__device__ __forceinline__ void hgrn_unit(bf16_t* P1, const float* DECG, const float* hgrn_norm_g, int b, int hh, LAS unsigned char* lds, int tid, bf16_t* Ob, int ldo, int rowmask) {
    const int lane = tid & 63, w = __builtin_amdgcn_readfirstlane(tid >> 6);
    constexpr int NCH = SEQ / 64;
    if (w < 4) {
        const int vt = w, r = lane & 31, h = lane >> 5;
        const int trq = (lane & 15) >> 2, trg = (lane >> 4) & 1, trp = lane & 3;
        const int trlv = trq * HVROW + (16 * trg + 4 * trp) * 2;
        const int kxb = r * HKROW + (((4 * (r & 3) + ((r >> 2) & 3)) ^ h) << 4);
        const int pp = ((trp & 1) << 1) | (trp >> 1);
        int knb[2];
#pragma unroll
        for (int d = 0; d < 2; ++d) knb[d] = (8 * h + 4 * d + trq) * HKROW + (((2 * trg + (pp >> 1)) ^ (4 * trq + 2 * h + d)) << 4) + 8 * (pp & 1);
        f32x16 S[4];
#pragma unroll
        for (int kt = 0; kt < 4; ++kt)
#pragma unroll
            for (int i = 0; i < 16; ++i) S[kt][i] = 0.f;
        RAW_BAR();
#define SB() __builtin_amdgcn_sched_barrier(0)
#define LDX(ks, A0, A1, B0, B1) do { A0 = *(const LAS bf16x8*)(lds + ((pKx) ^ (32 * (ks)))); A1 = *(const LAS bf16x8*)(lds + ((pKx + 32 * HKROW) ^ (32 * (ks)))); B0 = *(const LAS bf16x8*)(pQD + 32 * (ks)); B1 = *(const LAS bf16x8*)(pQD + 32 * HROW + 32 * (ks)); } while (0)
#define MMX(A0, A1, B0, B1) do { X00 = MFMA32(A0, B0, X00); X01 = MFMA32(A0, B1, X01); X11 = MFMA32(A1, B1, X11); } while (0)
#define LDV(ss, st) cat44(tr_read(pVp + (32 * (st) + 16 * (ss)) * HVROW), tr_read(pVp + (32 * (st) + 16 * (ss) + 8) * HVROW))
#define LDQ(j, tt) (*(const LAS bf16x8*)(pQD + 32 * (tt) * HROW + 32 * (j)))
#pragma unroll 1
        for (int n = 0; n < NCH; ++n) {
            const LAS unsigned char* sb = lds + (n & 1) * HSET;
            const int sbo = (n & 1) * HSET, pKx = sbo + HKI + kxb, pKn0 = sbo + HKI + knb[0], pKn1 = sbo + HKI + knb[1];
            const LAS unsigned char* pQD = sb + HQD + r * HROW + h * 16;
            const LAS unsigned char* pVp = sb + HV + trlv + 64 * vt + 4 * h * HVROW;
            const LAS unsigned char* pVn = sb + HV + trlv + 64 * vt + 8 * h * HVROW;
            f32x16 X00, X01, X11;
#pragma unroll
            for (int i = 0; i < 16; ++i) { X00[i] = 0.f; X01[i] = 0.f; X11[i] = 0.f; }
            bf16x8 fa0, fa1, fb0, fb1, ga0, ga1, gb0, gb1;
            LDX(0, fa0, fa1, fb0, fb1); LDX(1, ga0, ga1, gb0, gb1); SB();
            MMX(fa0, fa1, fb0, fb1); SB(); LDX(2, fa0, fa1, fb0, fb1); SB();
            MMX(ga0, ga1, gb0, gb1); SB(); LDX(3, ga0, ga1, gb0, gb1); SB();
            MMX(fa0, fa1, fb0, fb1); SB(); LDX(4, fa0, fa1, fb0, fb1); SB();
            MMX(ga0, ga1, gb0, gb1); SB(); LDX(5, ga0, ga1, gb0, gb1); SB();
            MMX(fa0, fa1, fb0, fb1); SB(); LDX(6, fa0, fa1, fb0, fb1); SB();
            MMX(ga0, ga1, gb0, gb1); SB(); LDX(7, ga0, ga1, gb0, gb1); SB();
            const bf16x8 av00 = LDV(0, 0), av01 = LDV(0, 1), av10 = LDV(1, 0), av11 = LDV(1, 1); SB();
            MMX(fa0, fa1, fb0, fb1); SB();
            bf16x8 q00 = LDQ(0, 0), q01 = LDQ(0, 1), q10 = LDQ(1, 0), q11 = LDQ(1, 1); SB();
            MMX(ga0, ga1, gb0, gb1); SB();
#pragma unroll
            for (int i = 0; i < 16; ++i) { const int sl = (i & 3) + 8 * (i >> 2) + 4 * h; if (sl > r) { X00[i] = 0.f; X11[i] = 0.f; } }
            f32x16 OT0, OT1;
#pragma unroll
            for (int i = 0; i < 16; ++i) { OT0[i] = 0.f; OT1[i] = 0.f; }
            OT0 = MFMA32(av00, pack8(X00, 0), OT0); OT1 = MFMA32(av00, pack8(X01, 0), OT1); OT1 = MFMA32(av01, pack8(X11, 0), OT1);
            OT0 = MFMA32(av10, pack8(X00, 1), OT0); OT1 = MFMA32(av10, pack8(X01, 1), OT1); OT1 = MFMA32(av11, pack8(X11, 1), OT1); SB();
#define INTER(j, QA, QB) do { const bf16x8 sa = pack8(S[(j) >> 1], (j) & 1); OT0 = MFMA32(sa, QA, OT0); OT1 = MFMA32(sa, QB, OT1); } while (0)
            INTER(0, q00, q01); SB(); q00 = LDQ(2, 0); q01 = LDQ(2, 1); SB();
            INTER(1, q10, q11); SB(); q10 = LDQ(3, 0); q11 = LDQ(3, 1); SB();
            INTER(2, q00, q01); SB(); q00 = LDQ(4, 0); q01 = LDQ(4, 1); SB();
            INTER(3, q10, q11); SB(); q10 = LDQ(5, 0); q11 = LDQ(5, 1); SB();
            INTER(4, q00, q01); SB(); q00 = LDQ(6, 0); q01 = LDQ(6, 1); SB();
            INTER(5, q10, q11); SB(); q10 = LDQ(7, 0); q11 = LDQ(7, 1); SB();
            INTER(6, q00, q01); SB();
            bf16x8 bv[4];
#pragma unroll
            for (int ts = 0; ts < 4; ++ts) bv[ts] = cat44(tr_read(pVn + 16 * ts * HVROW), tr_read(pVn + (16 * ts + 4) * HVROW));
            SB(); INTER(7, q10, q11); SB();
            bf16x8 ka[4], kb[4]; f32x4 da[4], db[4];
            const LAS unsigned char* pDC = sb + HDEC + h * 32;
#define LDK(kt, KF, DF) do { _Pragma("unroll") for (int ts = 0; ts < 4; ++ts) KF[ts] = cat44(tr_read(lds + ((pKn0 ^ (64 * (kt))) + 16 * ts * HKROW)), tr_read(lds + ((pKn1 ^ (64 * (kt))) + 16 * ts * HKROW))); _Pragma("unroll") for (int g = 0; g < 4; ++g) DF[g] = *(const LAS f32x4*)(pDC + (32 * (kt) + 16 * (g >> 1) + 4 * (g & 1)) * 4); } while (0)
#define UPD(kt, KF, DF) do { _Pragma("unroll") for (int ts = 0; ts < 4; ++ts) S[kt] = MFMA32(KF[ts], bv[ts], S[kt]); \
                _Pragma("unroll") for (int g = 0; g < 4; ++g) { S[kt][4 * g] *= DF[g].x; S[kt][4 * g + 1] *= DF[g].y; S[kt][4 * g + 2] *= DF[g].z; S[kt][4 * g + 3] *= DF[g].w; } } while (0)
#define UPD2(k0, KF0, DF0, k1, KF1, DF1) do { _Pragma("unroll") for (int ts = 0; ts < 4; ++ts) { S[k0] = MFMA32(KF0[ts], bv[ts], S[k0]); S[k1] = MFMA32(KF1[ts], bv[ts], S[k1]); } \
                _Pragma("unroll") for (int g = 0; g < 4; ++g) { S[k0][4 * g] *= DF0[g].x; S[k0][4 * g + 1] *= DF0[g].y; S[k0][4 * g + 2] *= DF0[g].z; S[k0][4 * g + 3] *= DF0[g].w; } \
                _Pragma("unroll") for (int g = 0; g < 4; ++g) { S[k1][4 * g] *= DF1[g].x; S[k1][4 * g + 1] *= DF1[g].y; S[k1][4 * g + 2] *= DF1[g].z; S[k1][4 * g + 3] *= DF1[g].w; } } while (0)
            LDK(0, ka, da); SB();
            { LAS unsigned char* ob = lds + HOUT + (n & 1) * HOUTB;
#pragma unroll
              for (int g = 0; g < 4; ++g) {
                u32x2 o0, o1; o0.x = pg8::cvt_pk_bf16(OT0[4 * g], OT0[4 * g + 1]); o0.y = pg8::cvt_pk_bf16(OT0[4 * g + 2], OT0[4 * g + 3]); o1.x = pg8::cvt_pk_bf16(OT1[4 * g], OT1[4 * g + 1]); o1.y = pg8::cvt_pk_bf16(OT1[4 * g + 2], OT1[4 * g + 3]);
                *(LAS u32x2*)(ob + r * HOROW + (32 * vt + 8 * g + 4 * h) * 2) = o0; *(LAS u32x2*)(ob + (32 + r) * HOROW + (32 * vt + 8 * g + 4 * h) * 2) = o1; } }
            SB();
            LDK(1, kb, db); SB(); UPD2(0, ka, da, 1, kb, db); SB();
            LDK(2, ka, da); LDK(3, kb, db); SB(); UPD2(2, ka, da, 3, kb, db); SB();
            RAW_BAR();
        }
#undef LDX
#undef MMX
#undef LDV
#undef LDQ
#undef INTER
#undef LDK
#undef UPD
#undef UPD2
#undef SB
    } else {
        const int pw = w - 4;
        const int nt = pw * 64 + lane, nrow = nt >> 2, nq = nt & 3;
        if (pw == 0) { *(LAS f32x2*)(lds + HNG + 8 * lane) = *(const f32x2*)(hgrn_norm_g + hh * 128 + 2 * lane); }
        const __amdgpu_buffer_rsrc_t rs = __builtin_amdgcn_make_buffer_rsrc((void*)P1, 0, (int)((size_t)T * LDP * 2), 0x00020000);
        const int crow = 16 * pw + (lane >> 4), cch = lane & 15;
        const int voff0 = (int)(((size_t)(b * SEQ + crow) * LDP + 256 * hh + 8 * cch) * 2);
        const int vso = (6144 + 128 * hh - 256 * hh) * 2;
        const int lq = crow * HROW + 16 * cch, lv = crow * HVROW + 16 * cch;
        const float* decg = DECG + (size_t)(b * (SEQ / 64)) * 3072 + hh * 128 + 32 * pw + 4 * (lane & 7);
        u32x4 qA[4], fA[4], vA[4], qB[4], fB[4], vB[4]; f32x4 dA, dB;
#define HG_LOAD(c_, QW, FW, VW, DW) do { const int c = ((c_) < NCH) ? (c_) : (NCH - 1); const int so_ = c * (64 * LDP * 2);       \
            DW = *(const f32x4*)(decg + (size_t)c * 3072); _Pragma("unroll") for (int j = 0; j < 4; ++j) { \
            QW[j] = __builtin_bit_cast(u32x4, __builtin_amdgcn_raw_buffer_load_b128(rs, voff0, so_ + 4 * j * (LDP * 2), 0)); FW[j] = __builtin_bit_cast(u32x4, __builtin_amdgcn_raw_buffer_load_b128(rs, voff0, so_ + 4 * j * (LDP * 2) + 256, 0)); \
            VW[j] = __builtin_bit_cast(u32x4, __builtin_amdgcn_raw_buffer_load_b128(rs, voff0, so_ + 4 * j * (LDP * 2) + vso, 0)); } } while (0)
#define HG_NORM(n_) do { u32x4 ov[4]; float ss = 0.f; const LAS unsigned char* ob = lds + HOUT + (((n_) - 1) & 1) * HOUTB; \
            _Pragma("unroll") for (int j = 0; j < 4; ++j) ov[j] = *(const LAS u32x4*)(ob + nrow * HOROW + nq * 64 + 16 * j); \
            _Pragma("unroll") for (int j = 0; j < 4; ++j) { const float x0 = pg8::bflo(ov[j].x), x1 = pg8::bfhi(ov[j].x), x2 = pg8::bflo(ov[j].y), x3 = pg8::bfhi(ov[j].y), x4 = pg8::bflo(ov[j].z), x5 = pg8::bfhi(ov[j].z), x6 = pg8::bflo(ov[j].w), x7 = pg8::bfhi(ov[j].w); \
                ss += (x0 * x0 + x1 * x1) + (x2 * x2 + x3 * x3) + (x4 * x4 + x5 * x5) + (x6 * x6 + x7 * x7); } \
            ss += DPPF(ss, 0xB1); ss += DPPF(ss, 0x4E); \
            const float rn = 1.0f / sqrtf(ss * (1.f / 128.f) + EPS); \
            bf16_t* op = Ob + (size_t)((b * SEQ + ((n_) - 1) * 64 + nrow) & rowmask) * ldo + hh * 128 + 32 * nq; \
            _Pragma("unroll") for (int j = 0; j < 4; ++j) { const f32x4 g0 = *(const LAS f32x4*)(lds + HNG + (32 * nq + 8 * j) * 4), g1 = *(const LAS f32x4*)(lds + HNG + (32 * nq + 8 * j + 4) * 4); u32x4 o; \
                o.x = pg8::cvt_pk_bf16(pg8::bflo(ov[j].x) * rn * g0.x, pg8::bfhi(ov[j].x) * rn * g0.y); o.y = pg8::cvt_pk_bf16(pg8::bflo(ov[j].y) * rn * g0.z, pg8::bfhi(ov[j].y) * rn * g0.w); \
                o.z = pg8::cvt_pk_bf16(pg8::bflo(ov[j].z) * rn * g1.x, pg8::bfhi(ov[j].z) * rn * g1.y); o.w = pg8::cvt_pk_bf16(pg8::bflo(ov[j].w) * rn * g1.z, pg8::bfhi(ov[j].w) * rn * g1.w); *(u32x4*)(op + 8 * j) = o; } } while (0)
#define HG_STEP(n_, QC, FC, VC, DC, QN, FN, VN, DN, DO_NORM) do { const int n = (n_); \
            HG_LOAD(n + 2, QN, FN, VN, DN); \
            if (DO_NORM) HG_NORM(n); \
            LAS unsigned char* sb = lds + ((n + 1) & 1) * HSET; \
            _Pragma("unroll") for (int j = 0; j < 4; ++j) { *(LAS u32x4*)(sb + HQD + lq + 4 * j * HROW) = QC[j]; *(LAS u32x4*)(sb + HKI + (crow + 4 * j) * HKROW + ((cch ^ (4 * (lane >> 4) + j)) << 4)) = FC[j]; *(LAS u32x4*)(sb + HV + lv + 4 * j * HVROW) = VC[j]; } \
            if (lane < 8) *(LAS f32x4*)(lds + ((n + 1) & 1) * HSET + HDEC + (32 * pw + 4 * lane) * 4) = DC; \
            RAW_BAR();                                                          \
        } while (0)
        HG_LOAD(0, qA, fA, vA, dA);
        HG_STEP(-1, qA, fA, vA, dA, qB, fB, vB, dB, false);
        HG_STEP(0, qB, fB, vB, dB, qA, fA, vA, dA, false);
#pragma unroll 1
        for (int n2 = 1; n2 < NCH - 1; n2 += 2) {
            HG_STEP(n2, qA, fA, vA, dA, qB, fB, vB, dB, true);
            HG_STEP(n2 + 1, qB, fB, vB, dB, qA, fA, vA, dA, true);
        }
        HG_STEP(NCH - 1, qA, fA, vA, dA, qB, fB, vB, dB, true);
        HG_NORM(NCH);
#undef HG_LOAD
#undef HG_NORM
#undef HG_STEP
    }
    __syncthreads();
}

template <int W, int RWS> __device__ __forceinline__ void pool_task(const bf16_t* up, bf16_t* op, const float* scp, int tl0) {
    constexpr int NH = W - 1;
    u32x4 R[NH + RWS];
    const f32x4 sc0 = *(const f32x4*)scp, sc1 = *(const f32x4*)(scp + 4);
#pragma unroll
    for (int i = 0; i < NH; ++i) { const int d = NH - i; const bool ok = (tl0 - d >= 0); const u32x4 v = *(const u32x4*)(up - (long)(ok ? d : 0) * LDU); R[i] = ok ? v : (u32x4){0u, 0u, 0u, 0u}; }
#pragma unroll
    for (int r = 0; r < RWS; ++r) R[NH + r] = *(const u32x4*)(up + (size_t)r * LDU);
    float s[8];
#pragma unroll
    for (int e = 0; e < 8; ++e) s[e] = 0.f;
#pragma unroll
    for (int i = 0; i < NH; ++i) { s[0] += pg8::bflo(R[i].x); s[1] += pg8::bfhi(R[i].x); s[2] += pg8::bflo(R[i].y); s[3] += pg8::bfhi(R[i].y); s[4] += pg8::bflo(R[i].z); s[5] += pg8::bfhi(R[i].z); s[6] += pg8::bflo(R[i].w); s[7] += pg8::bfhi(R[i].w); }
#pragma unroll
    for (int r = 0; r < RWS; ++r) {
        const u32x4 v = R[NH + r];
        const float c[8] = {pg8::bflo(v.x), pg8::bfhi(v.x), pg8::bflo(v.y), pg8::bfhi(v.y), pg8::bflo(v.z), pg8::bfhi(v.z), pg8::bflo(v.w), pg8::bfhi(v.w)};
#pragma unroll
        for (int e = 0; e < 8; ++e) s[e] += c[e];
        if (r >= 1) { const u32x4 o = R[r - 1]; s[0] -= pg8::bflo(o.x); s[1] -= pg8::bfhi(o.x); s[2] -= pg8::bflo(o.y); s[3] -= pg8::bfhi(o.y); s[4] -= pg8::bflo(o.z); s[5] -= pg8::bfhi(o.z); s[6] -= pg8::bflo(o.w); s[7] -= pg8::bfhi(o.w); }
        const int tl = tl0 + r; const float inv = 1.0f / (float)((tl + 1 < W) ? (tl + 1) : W);
        u32x4 o4; o4.x = pk2((s[0] * inv - c[0]) * sc0.x, (s[1] * inv - c[1]) * sc0.y); o4.y = pk2((s[2] * inv - c[2]) * sc0.z, (s[3] * inv - c[3]) * sc0.w);
        o4.z = pk2((s[4] * inv - c[4]) * sc1.x, (s[5] * inv - c[5]) * sc1.y); o4.w = pk2((s[6] * inv - c[6]) * sc1.z, (s[7] * inv - c[7]) * sc1.w);
        *(u32x4*)(op + (size_t)r * LDU) = o4;
    }
}

__global__ void __launch_bounds__(NWAVES * 64, 2) fwd_kernel(Args a) {
    extern __shared__ __attribute__((aligned(16))) unsigned char lds_raw[];
    LAS unsigned char* lds = (LAS unsigned char*)lds_raw;
    volatile LAS unsigned* MISC = (volatile LAS unsigned*)(lds + MISC_OFF);
    const int tid0 = threadIdx.x;
    const int wave_s = __builtin_amdgcn_readfirstlane(tid0 >> 6);
    const int G = gridDim.x, bx = blockIdx.x;
    const int vcu = (G % 8 == 0) ? (bx % 8) * (G / 8) + bx / 8 : bx;
    unsigned char* ws = a.ws;
    unsigned* ctl = (unsigned*)(ws + WS_CTL);
    for (int u = tid0; u < (LDS_BYTES - LDSCTL_OFF) / 4; u += NWAVES * 64) ((LAS unsigned*)(lds + LDSCTL_OFF))[u] = 0u;
    __syncthreads();
    XcdBarrier bar; bar.bar = ctl + CW_BAR; bar.x = 0; bar.st = nullptr;
    const bool multi = (a.ph_hi - a.ph_lo) > 1;
    if (multi) bar = xcd_barrier_post(ctl + CW_BAR, MISC + 8);
#ifdef PROBE_A
    unsigned long long* tsb = (unsigned long long*)(ws + WS_CTL + 65536);
    if (bx == 0 && tid0 == 0) tsb[0] = __builtin_amdgcn_s_memrealtime();
#endif

    bf16_t* Wt_in0 = (bf16_t*)(ws + WS_WIN0); bf16_t* Wt_in1 = (bf16_t*)(ws + WS_WIN1);
    bf16_t* Wt_out0 = (bf16_t*)(ws + WS_WOUT0); bf16_t* Wt_out1 = (bf16_t*)(ws + WS_WOUT1);
    bf16_t* Wt_kv = (bf16_t*)(ws + WS_WKV); bf16_t* Wt_grp = (bf16_t*)(ws + WS_WGRP);
    bf16_t* MEMN = (bf16_t*)(ws + WS_MEMN); bf16_t* KMAT = (bf16_t*)(ws + WS_KMAT); bf16_t* VT = (bf16_t*)(ws + WS_VT);
    bf16_t* H = (bf16_t*)(ws + WS_H); bf16_t* U = (bf16_t*)(ws + WS_U); bf16_t* BR0 = (bf16_t*)(ws + WS_BR0); bf16_t* WUBF = (bf16_t*)(ws + WS_WUBF); bf16_t* P1 = (bf16_t*)(ws + WS_P1);
    float* SSQ1 = (float*)(ws + WS_CTL + 262144);
    float* OMLB = (float*)(ws + WS_CTL + 393216);
    float* SSQ2 = (float*)(ws + WS_CTL + 458752);
    const int NGW = G * NWAVES;

    for (int p = a.ph_lo, sub = 0; p < a.ph_hi; ) {
        if (p == 6 || p == 11) { ++p; continue; }
#ifdef REPEAT_MASK
        const int nrep = ((REPEAT_MASK >> p) & 1) ? 2 : 1;
        for (int rep = 0; rep < nrep; ++rep) {
        const bool dummy = (rep + 1 < nrep);
#else
        constexpr bool dummy = false;
#endif
        int tid = (wave_s << 6) | lane_id_now(); asm volatile("" : "+v"(tid));
        const int lane = tid & 63, wave = __builtin_amdgcn_readfirstlane(tid >> 6), gw = vcu * NWAVES + wave;
        pg8::Job J; J.kind = -1; J.grp_tiles = 1 << 20; J.grp_stride = 0; J.bgrp_tiles = 1 << 20; J.bgrp_stride = 0; J.colscale = nullptr; J.base = nullptr; J.out = nullptr; J.O = nullptr; J.ldc = 0; J.G = G; J.c = bx;
        J.A = nullptr; J.Bt = nullptr; J.lda = 0; J.ldb = 0; J.K = 0; J.M = 0; J.N = 0; J.wgm = 8; J.lbp = OMLB; J.decp = (float*)(ws + WS_DEC); J.rowss = nullptr; J.ssq = nullptr; J.pcnt = nullptr;
        switch (p) {
            case 1: if (bx < 32) { J.kind = 0; J.A = MEMN; J.lda = LDH; J.Bt = Wt_kv; J.ldb = LDH; J.K = DM; J.M = MROWS; J.N = 2048; J.O = KMAT; J.ldc = 2048; J.G = 32; J.c = bx; }
                    else if (bx < 64) { J.kind = 0; J.A = Wt_kv + (size_t)2048 * LDH; J.lda = LDH; J.Bt = MEMN; J.ldb = LDH; J.K = DM; J.M = 2048; J.N = MROWS; J.O = VT; J.ldc = MROWS; J.G = 32; J.c = bx - 32; }
                    else if (bx < 160) { J.kind = 0; J.A = Wt_grp; J.lda = PGRP; J.Bt = WUBF; J.ldb = E_MIX; J.bgrp_tiles = 3; J.bgrp_stride = PGRP; J.K = PGRP; J.M = E_MIX; J.N = DM; J.O = Wt_in0; J.ldc = LDH; J.G = 96; J.c = bx - 64; }
                    break;
            case 2: J.kind = 0; J.A = H; J.lda = LDH; J.Bt = Wt_in0; J.ldb = LDH; J.K = DM; J.M = T; J.N = N0A; J.O = U; J.ldc = LDU; break;
            case 4: J.kind = 2; J.A = H; J.lda = LDH; J.Bt = Wt_in0 + (size_t)N0A * LDH; J.ldb = LDH; J.K = DM; J.M = T; J.N = E_BR; J.O = BR0; J.ldc = LDU; break;
            case 5: J.kind = 5; J.A = BR0; J.lda = LDU; J.Bt = Wt_out0; J.ldb = LDWO; J.K = E_BR; J.M = T; J.N = DM; J.base = a.x; J.O = H; J.ldc = LDH; J.ssq = SSQ1; J.wgm = 4; break;
            case 7: J.kind = 4; J.rowss = SSQ1; J.A = H; J.lda = LDH; J.Bt = Wt_in1; J.ldb = LDH; J.K = DM; J.M = T; J.N = N1A; J.O = P1; J.ldc = LDP; break;
            case 9: J.kind = 2; J.rowss = SSQ1; J.A = H; J.lda = LDH; J.Bt = Wt_in1 + (size_t)N1A * LDH; J.ldb = LDH; J.K = DM; J.M = T; J.N = E_MIX; J.O = P1 + 6144; J.ldc = LDP; break;
            case 10: J.kind = 7; J.A = P1 + 6144; J.lda = LDP; J.Bt = Wt_out1; J.ldb = LDWO; J.K = E_BR; J.M = T; J.N = DM; J.O = H; J.ldc = LDH; J.wgm = 4;
                     J.ssq = SSQ2; J.pcnt = (unsigned*)(ws + WS_CTL + 589824); J.colscale = a.final_g; J.out = a.out; break;
            default: break;
        }
        if (J.kind >= 0) pg8::gemm_phase(lds + RING_OFF, J, tid);

        if (p == 0 || p == 1) {
            LAS float* scr = (LAS float*)(lds + RING_OFF + wave * 16640);
            constexpr int I_IN0 = (DM / 64) * (N0 / 64), I_IN1 = (DM / 64) * (N1 / 64), I_OUT = (E_BR / 64) * (DM / 64), I_KV = (DM / 64) * (2048 / 64), I_GRP = (PGRP / 64) * (PGRP / 64);
            constexpr int NITEMS = I_IN0 + I_IN1 + 2 * I_OUT + 2 * I_KV + 4 * I_GRP;
            const bool listA = (p == 0);
            if (listA) for (int i = bx * (NWAVES * 64) + tid; i < 3072; i += G * NWAVES * 64) OMLB[i] = 1.0f - 1.0f / (1.0f + __expf(a.hgrn_lb[i] - a.hgrn_lb[3072 + i]));
            f32x4 gv[8];
            if (listA) load_gain(a.mem_norm_g, gv, lane); else load_gain(a.norm_g, gv, lane);
            const int nidx = NITEMS + (listA ? MROWS : T);
            int vfirst, vcount, vstride;
            if (listA || G != 256) { vfirst = gw; vcount = 1; vstride = NGW; }
            else { constexpr int SA = 4, SB = 10, SC = 13, TOT = NWAVES * (64 * SA + 96 * SB + 96 * SC);
                vstride = TOT;
                if (bx < 64) { vfirst = (bx * NWAVES + wave) * SA; vcount = SA; }
                else if (bx < 160) { vfirst = 64 * NWAVES * SA + ((bx - 64) * NWAVES + wave) * SB; vcount = SB; }
                else { vfirst = 64 * NWAVES * SA + 96 * NWAVES * SB + ((bx - 160) * NWAVES + wave) * SC; vcount = SC; } }
            for (int vi = 0; vi < vcount; ++vi)
            for (int it = vfirst + vi; it < nidx; it += vstride) {
                if (it >= NITEMS) { const int m = it - NITEMS;
                    if (listA) rms_row_to_bf16(a.mem + (size_t)m * DM, gv, MEMN + (size_t)m * LDH, lane); else rms_row_to_bf16(a.x + (size_t)m * DM, gv, H + (size_t)m * LDH, lane);
                    continue; }
                int r = it;
                if (r < I_IN0) { const int nb = N0 / 64, kb = r / nb, n0 = 64 * (r % nb);
                    if (n0 >= E_MIX) { if (!listA) transpose_item(a.pool_w_in, N0, 64 * kb, n0, Wt_in0, LDH, n0, scr, lane); }
                    else if (listA) {
#pragma unroll
                        for (int j = 0; j < 8; ++j) { const int k = 64 * kb + 8 * j + (lane >> 3); const float* src = a.pool_w_in + (size_t)k * N0 + n0 + 8 * (lane & 7);
                            const f32x4 v0 = *(const f32x4*)src, v1 = *(const f32x4*)(src + 4); u32x4 o; o.x = pk2(v0.x, v0.y); o.y = pk2(v0.z, v0.w); o.z = pk2(v1.x, v1.y); o.w = pk2(v1.z, v1.w);
                            *(u32x4*)(WUBF + (size_t)k * E_MIX + n0 + 8 * (lane & 7)) = o; } }
                    continue; } r -= I_IN0;
                if (r < I_IN1) { if (!listA) { const int nb = N1 / 64, kb = r / nb, n0 = 64 * (r % nb);
                    if (G == 256 && n0 >= N1A && n0 < N1A + E_MIX) continue;
                    const int orow0 = (n0 < 3072) ? (256 * (n0 >> 7) + (n0 & 127)) : (n0 < 6144) ? (256 * ((n0 - 3072) >> 7) + 128 + (n0 & 127)) : n0;
                    transpose_item<true>(a.hgrn_w_in, N1, 64 * kb, n0, Wt_in1, LDH, orow0, scr, lane, a.norm_g + DM); } continue; } r -= I_IN1;
                if (r < 2 * I_OUT) { if (!listA) { const int l = r / I_OUT; r -= l * I_OUT; const int nb = DM / 64, kb = r / nb, n0 = 64 * (r % nb);
                    if (!(l == 1 && G == 256)) transpose_item(a.w_out + (size_t)l * E_BR * DM, DM, 64 * kb, n0, l ? Wt_out1 : Wt_out0, LDWO, n0, scr, lane); } continue; } r -= 2 * I_OUT;
                if (!listA) continue;
                if (r < 2 * I_KV) { const int l = r / I_KV; r -= l * I_KV; const int nb = 2048 / 64, kb = r / nb, n0 = 64 * (r % nb);
                    const int orow0 = (n0 < 1024) ? (l * 1024 + n0) : (2048 + l * 1024 + (n0 - 1024));
                    transpose_item(a.w_kv + (size_t)l * DM * 2048, 2048, 64 * kb, n0, Wt_kv, LDH, orow0, scr, lane); continue; } r -= 2 * I_KV;
                { const int g = r / I_GRP; r -= g * I_GRP; const int nb = PGRP / 64, kb = r / nb, n0 = 64 * (r % nb);
                    transpose_item(a.pool_w_grp + (size_t)g * PGRP * PGRP, PGRP, 64 * kb, n0, Wt_grp, PGRP, g * PGRP + n0, scr, lane); }
            }
        } else if (p == 3 || p == 8) {
            if (p == 3 && sub == (bx & 1)) {
                const int NP = G * NWAVES * 64, me = bx * (NWAVES * 64) + tid;
                constexpr int NCH = PGRP / 8, NT16 = NCH * (T / 16), NT8 = NCH * (T / 8);
                for (int task = me; task < 3 * NT16 + NT8; task += NP) {
                    int grp, rem, rws; if (task < 3 * NT16) { grp = task / NT16; rem = task - grp * NT16; rws = 16; } else { grp = 3; rem = task - 3 * NT16; rws = 8; }
                    const int chl = rem % NCH, rb = rem / NCH, ch = grp * NCH + chl;
                    const int t0 = rb * rws, tl0 = t0 % SEQ;
                    const bf16_t* up = U + (size_t)t0 * LDU + ch * 8; bf16_t* op = BR0 + (size_t)t0 * LDU + ch * 8; const float* scp = a.pool_scale + ch * 8;
                    if (grp == 0) pool_task<2, 16>(up, op, scp, tl0); else if (grp == 1) pool_task<4, 16>(up, op, scp, tl0); else if (grp == 2) pool_task<8, 16>(up, op, scp, tl0); else pool_task<16, 8>(up, op, scp, tl0);
                }
            } else {
            const int layer = (p == 3) ? 0 : 1;
            bf16_t* Q = layer ? (P1 + 9216) : (U + 3072); const int ldq = layer ? LDP : LDU;
#ifndef DBG_MODE
#define DBG_MODE 0
#endif
            if (p == 8 && bx < 96) {
                if (!(dummy && (DBG_MODE & 64))) {
#if defined(REPEAT_MASK) && !(DBG_MODE & 64)
                if (dummy) hgrn_unit(P1, (const float*)(ws + WS_DEC), a.hgrn_norm_g, bx / HG_H, bx % HG_H, lds + RING_OFF, tid, (bf16_t*)(ws + WS_END), E_MIX, 4095);
                else
#endif
                hgrn_unit(P1, (const float*)(ws + WS_DEC), a.hgrn_norm_g, bx / HG_H, bx % HG_H, lds + RING_OFF, tid, P1 + 6144, LDP, -1);
                }
            } else if (!(dummy && (DBG_MODE & 32))) {
                const int u0 = (p == 8) ? (bx - 96) : bx, nu = (p == 8) ? (G - 96) : G;
                bf16_t* Oq = dummy ? (bf16_t*)(ws + WS_END) : (layer ? Q : (BR0 + 3072)); const int ldoq = dummy ? 1024 : ldq;
                for (int unit = u0; unit < (T / 256) * 4; unit += nu) {
                    const int hd = unit & 3, rb = unit >> 2, t0 = rb * 256, b = t0 / SEQ;
                    ca_unit(Q + (size_t)t0 * ldq + hd * 256, Oq + (size_t)t0 * ldoq + hd * 256, ldq, ldoq, KMAT + (size_t)(b * NMEM) * 2048 + layer * 1024 + hd * 256, VT + (size_t)(layer * 1024 + hd * 256) * MROWS + b * NMEM, lds + RING_OFF, tid);
                }
                if (p == 8 && (!dummy || (DBG_MODE & 128))) {
                    asm volatile("s_waitcnt vmcnt(0)" ::: "memory");
                    __syncthreads();
                    pg8::Job J2 = J; J2.kind = 2; J2.rowss = SSQ1; J2.A = H; J2.lda = LDH; J2.Bt = Wt_in1 + (size_t)(N1A + E_MIX) * LDH; J2.ldb = LDH; J2.K = DM; J2.M = T; J2.N = E_CA; J2.O = P1 + 6144 + E_MIX; J2.ldc = LDP; J2.G = G - 96; J2.c = bx - 96; J2.wgm = 0;
                    if (dummy) { J2.O = (bf16_t*)(ws + WS_END); J2.ldc = 1024; }
                    pg8::gemm_phase(lds + RING_OFF, J2, tid);
                    if (G == 256 && bx >= 192 && !dummy) {
                        LAS float* scr = (LAS float*)(lds + RING_OFF + wave * 16640);
                        constexpr int I_OUT1 = (E_BR / 64) * (DM / 64);
                        constexpr int I_GM = (DM / 64) * (E_MIX / 64);
                        for (int r = (bx - 192) * NWAVES + wave; r < I_GM; r += 64 * NWAVES) { const int nb = E_MIX / 64, kb = r / nb, n0 = N1A + 64 * (r % nb);
                            transpose_item<true>(a.hgrn_w_in, N1, 64 * kb, n0, Wt_in1, LDH, n0, scr, lane, a.norm_g + DM); }
                        for (int r = (bx - 192) * NWAVES + wave; r < I_OUT1; r += 64 * NWAVES) { const int nb = DM / 64, kb = r / nb, n0 = 64 * (r % nb);
                            transpose_item(a.w_out + (size_t)E_BR * DM, DM, 64 * kb, n0, Wt_out1, LDWO, n0, scr, lane); }
                    }
                }
            }
            }
        }
#ifdef REPEAT_MASK
        if (rep + 1 < nrep) xcd_barrier(bar, wave_s);
        }
#endif
        if (p == 3 && sub == 0) { sub = 1; continue; }
        sub = 0;
        if (p + 1 < a.ph_hi && p != 10) xcd_barrier(bar, wave_s);
#ifdef PROBE_A
        if (bx == 0 && tid0 == 0) tsb[p + 1] = __builtin_amdgcn_s_memrealtime();
#endif
        ++p;
    }
#ifdef PROBE_A
    if (bx == 0 && tid0 == 0) { float* pv = (float*)(ws + WS_CTL + 131072);
        pv[0] = (float)(tsb[PROBE_A + 1] - tsb[PROBE_A]) * 0.1f; pv[1] = (float)(tsb[PROBE_B + 1] - tsb[PROBE_B]) * 0.1f; }
    xcd_barrier(bar, wave_s);
    { const float* pv = (const float*)(ws + WS_CTL + 131072); const float av = pv[0], bv = pv[1];
      for (size_t i = (size_t)bx * 512 + tid0; i < (size_t)T * DM; i += (size_t)G * 512) a.out[i] = (i == 0) ? av : bv; }
#endif
}

constexpr int N_PHASES = 12;

extern "C" void kernel_launch(void* const* d_in, const int* in_sizes, int n_in, void* d_out, int out_size, void* d_ws, size_t ws_size, hipStream_t stream) {
    static int grid = 0;
    if (grid == 0) {
        if (n_in != 13 || in_sizes[0] != T * DM || out_size != T * DM || ws_size < WS_WUBF + 12 * MiB) {
            fprintf(stderr, "kernel_launch: unexpected shapes / workspace (n_in %d, in0 %d, out %d, ws %zu < %zu); nothing launched\n", n_in, n_in > 0 ? in_sizes[0] : -1, out_size, ws_size, (size_t)WS_END); grid = -1; return; }
        int dev = 0, cus = 0, per_cu = 0;
        if (hipGetDevice(&dev) != hipSuccess || hipDeviceGetAttribute(&cus, hipDeviceAttributeMultiprocessorCount, dev) != hipSuccess) { grid = -1; return; }
        if (hipFuncSetAttribute((const void*)fwd_kernel, hipFuncAttributeMaxDynamicSharedMemorySize, LDS_BYTES) != hipSuccess) { fprintf(stderr, "kernel_launch: hipFuncSetAttribute failed\n"); grid = -1; return; }
        if (hipOccupancyMaxActiveBlocksPerMultiprocessor(&per_cu, (const void*)fwd_kernel, NWAVES * 64, LDS_BYTES) != hipSuccess || per_cu < 1) {
            fprintf(stderr, "kernel_launch: occupancy query reports %d workgroups per CU; nothing launched\n", per_cu); (void)hipGetLastError(); grid = -1; return; }
        grid = cus;
        if (grid != 256) { fprintf(stderr, "kernel_launch: built for 256 CUs (tile orders / panel exchange), found %d\n", grid); grid = -1; return; }
    }
    if (grid < 0) return;
    if (hipMemsetAsync((char*)d_ws + WS_CTL, 0, CTL_ZERO_BYTES, stream) != hipSuccess) return;
    Args a{};
    a.x = (const float*)d_in[0]; a.mem = (const float*)d_in[1]; a.norm_g = (const float*)d_in[2]; a.mem_norm_g = (const float*)d_in[3]; a.w_kv = (const float*)d_in[4]; a.w_out = (const float*)d_in[5];
    a.pool_w_in = (const float*)d_in[6]; a.pool_w_grp = (const float*)d_in[7]; a.pool_scale = (const float*)d_in[8]; a.hgrn_w_in = (const float*)d_in[9]; a.hgrn_lb = (const float*)d_in[10];
    a.hgrn_norm_g = (const float*)d_in[11]; a.final_g = (const float*)d_in[12]; a.out = (float*)d_out; a.ws = (unsigned char*)d_ws;
#if MK_N_LAUNCHES == 1
    a.ph_lo = 0; a.ph_hi = N_PHASES;
    hipLaunchKernelGGL(fwd_kernel, dim3(grid), dim3(NWAVES * 64), LDS_BYTES, stream, a);
#else
    for (int p = 0; p < N_PHASES; ++p) { a.ph_lo = p; a.ph_hi = p + 1; hipLaunchKernelGGL(fwd_kernel, dim3(grid), dim3(NWAVES * 64), LDS_BYTES, stream, a); }
#endif
}
```

```cpp
#include <hip/hip_runtime.h>
#include <cstdio>
#include <cstdint>

#ifndef MK_N_LAUNCHES
#define MK_N_LAUNCHES 1
#endif

#define LAS __attribute__((address_space(3)))
typedef unsigned short bf16_t;
typedef short bf16x8 __attribute__((ext_vector_type(8)));
typedef float f32x4 __attribute__((ext_vector_type(4)));
typedef float f32x2 __attribute__((ext_vector_type(2)));
typedef unsigned u32x4 __attribute__((ext_vector_type(4)));
typedef unsigned u32x2 __attribute__((ext_vector_type(2)));

constexpr int BATCH = 4, SEQ = 4096, DM = 2048, T = BATCH * SEQ;
constexpr int NMEM = 256, MROWS = BATCH * NMEM;
constexpr int E_MIX = 3072, E_CA = 1024, E_BR = 4096;
constexpr int N0 = 8192, N1 = 14336, N0A = 4096, N1A = 10240;
constexpr int LPAD = 64;
constexpr int LDU = N0A + LPAD, LDP = N1A + LPAD, LDWO = E_BR + LPAD, LDH = DM + LPAD;
constexpr int PGRP = 768;
constexpr int HG_H = 24, HG_D = 128;
constexpr float EPS = 1e-6f;

constexpr size_t MiB = 1u << 20;
constexpr size_t WS_CTL = 0, CTL_ZERO_BYTES = 1 * MiB;
constexpr size_t WS_WIN1 = 1 * MiB;
constexpr size_t WS_WOUT1 = 59 * MiB;
constexpr size_t WS_KMAT = 76 * MiB;
constexpr size_t WS_VT = 80 * MiB;
constexpr size_t WS_H = 84 * MiB;
constexpr size_t WS_BIG = 150 * MiB;
constexpr size_t WS_WIN0 = WS_BIG;
constexpr size_t WS_WOUT0 = WS_BIG + 33 * MiB;
constexpr size_t WS_WKV = WS_BIG + 50 * MiB;
constexpr size_t WS_WGRP = WS_BIG + 67 * MiB;
constexpr size_t WS_MEMN = WS_BIG + 72 * MiB;
constexpr size_t WS_U = WS_BIG + 77 * MiB;
constexpr size_t WS_BR0 = WS_BIG + 207 * MiB;
constexpr size_t WS_WUBF = WS_BIG + 337 * MiB;
constexpr size_t WS_P1 = WS_BIG;
constexpr size_t WS_DEC = WS_BIG + 322 * MiB;
constexpr size_t WS_END = WS_DEC + 3 * MiB;
static_assert((size_t)T * LDU * 2 <= 130 * MiB && (size_t)T * LDP * 2 <= 322 * MiB && (size_t)DM * LDWO * 2 <= 17 * MiB && (size_t)N1 * LDH * 2 <= 58 * MiB && (size_t)T * LDH * 2 <= 66 * MiB && (size_t)N0 * LDH * 2 <= 33 * MiB && (size_t)4096 * LDH * 2 <= 17 * MiB && (size_t)MROWS * LDH * 2 <= 5 * MiB, "ws map");

namespace pg8 {
constexpr int BM = 256, BK = 64, HALF = 128, HTB = HALF * BK * 2, STAGE_BYTES = 8 * HTB, NXCD = 8, WGM = 8;
__host__ __device__ __forceinline__ int lds_byte(int r, int c) { const int st = (r >> 4) * 2 + (c >> 5), rr = r & 15, cc = c & 31, ob = rr * 64 + cc * 2; return st * 1024 + (ob ^ (((ob >> 9) & 1) << 5)); }
__host__ __device__ __forceinline__ void stage_rc(int b, int& R, int& C) { const int st = b / 1024, sb = b % 1024, swz = sb ^ (((sb >> 9) & 1) << 5); R = (st >> 1) * 16 + swz / 64; C = (st & 1) * 32 + (swz % 64) / 2; }
__host__ __device__ __forceinline__ int perm32(int rho) { const int n = rho >> 4, i = rho & 15; return 8 * (i >> 2) + 4 * n + (i & 3); }

struct Unit { int pm, pn; };
struct Job {
    const bf16_t* A; const bf16_t* Bt; int lda, ldb, K, M, N, G, c, grp_tiles, grp_stride, bgrp_tiles, bgrp_stride;
    int kind; bf16_t* O; int ldc; const float* colscale; const float* base; float* out;
    int wgm;
    const float* lbp;
    float* decp;
    const float* rowss;
    float* ssq;
    unsigned* pcnt;
};
struct StaticOrder {
    int nM, nN, nwg, G, c, wgm;
    __device__ void init(int M, int N, int G_, int c_, int wgm_) { nM = M / BM; nN = N / BM; nwg = nM * nN; G = G_; c = c_; wgm = wgm_; }
    __device__ bool next(int i, Unit& u) const {
        const long L = (long)i * G + c; if (L >= nwg) return false;
        if (wgm == 0) { u.pm = (int)L / nN; u.pn = (int)L % nN; return true; }
        int wgid = (int)L; { const int q = nwg / NXCD, r = nwg % NXCD, xcd = wgid % NXCD, off = wgid / NXCD; wgid = (xcd < r ? xcd * (q + 1) : r * (q + 1) + (xcd - r) * q) + off; }
        const int nig = wgm * nN, gid = wgid / nig, fm = gid * wgm, gsz = (nM - fm) < wgm ? (nM - fm) : wgm;
        u.pm = fm + ((wgid % nig) % gsz); u.pn = (wgid % nig) / gsz; return true;
    }
};
typedef __bf16 bf16x2_t __attribute__((ext_vector_type(2)));
__device__ __forceinline__ unsigned cvt_pk_bf16(float lo, float hi) { f32x2 v = {lo, hi}; bf16x2_t b = __builtin_convertvector(v, bf16x2_t); return __builtin_bit_cast(unsigned, b); }
__device__ __forceinline__ float bflo(unsigned w) { return __uint_as_float(w << 16); }
__device__ __forceinline__ float bfhi(unsigned w) { return __uint_as_float(w & 0xffff0000u); }
__device__ __forceinline__ float silu_f(float v) { return v * __builtin_amdgcn_rcpf(1.0f + __builtin_amdgcn_exp2f(-1.4426950408889634f * v)); }

#define DPPF(x, ctrl) __builtin_bit_cast(float, __builtin_amdgcn_update_dpp(0, __builtin_bit_cast(int, (x)), (ctrl), 0xF, 0xF, true))
#define DPPF1(x, ctrl) __builtin_bit_cast(float, __builtin_amdgcn_update_dpp(0x3f800000, __builtin_bit_cast(int, (x)), (ctrl), 0xF, 0xF, false))
__device__ __forceinline__ float xl_sum16(float v) { const auto r = __builtin_amdgcn_permlane16_swap(__builtin_bit_cast(unsigned, v), __builtin_bit_cast(unsigned, v), false, false); return __builtin_bit_cast(float, (unsigned)r[0]) + __builtin_bit_cast(float, (unsigned)r[1]); }
__device__ __forceinline__ float xl_sum32(float v) { const auto r = __builtin_amdgcn_permlane32_swap(__builtin_bit_cast(unsigned, v), __builtin_bit_cast(unsigned, v), false, false); return __builtin_bit_cast(float, (unsigned)r[0]) + __builtin_bit_cast(float, (unsigned)r[1]); }
__device__ __forceinline__ float xl_max16(float v) { const auto r = __builtin_amdgcn_permlane16_swap(__builtin_bit_cast(unsigned, v), __builtin_bit_cast(unsigned, v), false, false); return fmaxf(__builtin_bit_cast(float, (unsigned)r[0]), __builtin_bit_cast(float, (unsigned)r[1])); }
__device__ __forceinline__ float xl_max32(float v) { const auto r = __builtin_amdgcn_permlane32_swap(__builtin_bit_cast(unsigned, v), __builtin_bit_cast(unsigned, v), false, false); return fmaxf(__builtin_bit_cast(float, (unsigned)r[0]), __builtin_bit_cast(float, (unsigned)r[1])); }
__device__ __forceinline__ float xl_row_sum(float v) { v += DPPF(v, 0xB1); v += DPPF(v, 0x4E); v += DPPF(v, 0x141); v += DPPF(v, 0x140); return v; }
__device__ __forceinline__ float xl_row_max(float v) { v = fmaxf(v, DPPF(v, 0xB1)); v = fmaxf(v, DPPF(v, 0x4E)); v = fmaxf(v, DPPF(v, 0x141)); v = fmaxf(v, DPPF(v, 0x140)); return v; }
__device__ __forceinline__ void epilogue_hgrn(const Job& J, const f32x4 (&acc)[2][2][4][2], const float (&rs)[2][4], const Unit& u, int wr, int wc, int fr, int fq) {
    const int row0 = u.pm * BM + wr * 64 + fr, colh = wc * 32 + 8 * fq;
    f32x4 omlbv[2];
#pragma unroll
    for (int n = 0; n < 2; ++n) omlbv[n] = *(const f32x4*)(J.lbp + u.pn * 128 + colh + 4 * n);
#pragma unroll
    for (int ai = 0; ai < 2; ++ai) {
#pragma unroll
        for (int n = 0; n < 2; ++n) {
            float kk[4][4], P[4][4]; f32x4 dec;
#pragma unroll
            for (int e = 0; e < 4; ++e) { const float omlb = omlbv[n][e];
                float pl[4];
#pragma unroll
                for (int m = 0; m < 4; ++m) { kk[m][e] = omlb * __builtin_amdgcn_rcpf(1.0f + __builtin_amdgcn_exp2f((1.4426950408889634f * rs[ai][m]) * acc[ai][1][m][n][e]));
                    const float f = 1.0f - kk[m][e]; pl[m] = (m == 0) ? f : pl[m - 1] * f; }
                float t = pl[3];
                t *= DPPF1(t, 0x111); t *= DPPF1(t, 0x112); t *= DPPF1(t, 0x114); t *= DPPF1(t, 0x118);
                const float ex = DPPF1(t, 0x111);
#pragma unroll
                for (int m = 0; m < 4; ++m) P[m][e] = ex * pl[m];
                dec[e] = __builtin_bit_cast(float, __builtin_amdgcn_ds_swizzle(__builtin_bit_cast(int, t), 0x1F0)); }
            if (fr == 0) *(f32x4*)(J.decp + (size_t)((u.pm * BM + ai * HALF + wr * 64) >> 6) * 3072 + u.pn * 128 + colh + 4 * n) = dec;
#pragma unroll
            for (int m = 0; m < 4; ++m) { float qd[4], ki[4];
#pragma unroll
                for (int e = 0; e < 4; ++e) { qd[e] = silu_f(acc[ai][0][m][n][e] * rs[ai][m]) * 0.08838834764831845f * P[m][e]; ki[e] = kk[m][e] * __builtin_amdgcn_rcpf(P[m][e]); }
                bf16_t* rowp = J.O + (size_t)(row0 - fr + ai * HALF + 4 * fr + m) * J.ldc + u.pn * BM + colh + 4 * n;
                u32x2 w; w.x = cvt_pk_bf16(qd[0], qd[1]); w.y = cvt_pk_bf16(qd[2], qd[3]); *(u32x2*)rowp = w;
                w.x = cvt_pk_bf16(ki[0], ki[1]); w.y = cvt_pk_bf16(ki[2], ki[3]); *(u32x2*)(rowp + HALF) = w; }
        }
    }
}
__device__ __forceinline__ void epilogue(const Job& J, const f32x4 (&acc)[2][2][4][2], const float (&rs)[2][4], const Unit& u, int wr, int wc, int fr, int fq) {
    if (J.kind == 4 && u.pn < 24) { epilogue_hgrn(J, acc, rs, u, wr, wc, fr, fq); return; }
    if (J.kind == 3) {
        const int row0 = u.pm * BM + wr * 64 + fr, col0 = u.pn * BM + wc * 32 + 4 * fq;
#pragma unroll
        for (int ai = 0; ai < 2; ++ai) {
            f32x4 bs[4][2][2];
#pragma unroll
            for (int m = 0; m < 4; ++m)
#pragma unroll
                for (int bj = 0; bj < 2; ++bj)
#pragma unroll
                    for (int n = 0; n < 2; ++n) bs[m][bj][n] = *(const f32x4*)(J.base + (size_t)(row0 + ai * HALF + m * 16) * J.ldc + col0 + bj * HALF + n * 16);
#pragma unroll
            for (int m = 0; m < 4; ++m)
#pragma unroll
                for (int bj = 0; bj < 2; ++bj)
#pragma unroll
                    for (int n = 0; n < 2; ++n) *(f32x4*)(J.out + (size_t)(row0 + ai * HALF + m * 16) * J.ldc + col0 + bj * HALF + n * 16) = bs[m][bj][n] + acc[ai][bj][m][n];
        }
        return;
    }
    const int row0 = u.pm * BM + wr * 64 + fr, col0 = u.pn * BM + wc * 32 + 8 * fq;
    const __amdgpu_buffer_rsrc_t orsrc = __builtin_amdgcn_make_buffer_rsrc((void*)J.O, 0, 0x7ffffff0, 0x00020000);
    if (J.kind == 5) {
#pragma unroll
        for (int ai = 0; ai < 2; ++ai) {
            f32x4 bs[4][2][2];
#pragma unroll
            for (int m = 0; m < 4; ++m)
#pragma unroll
                for (int bj = 0; bj < 2; ++bj)
#pragma unroll
                    for (int n = 0; n < 2; ++n) bs[m][bj][n] = *(const f32x4*)(J.base + (size_t)(row0 + ai * HALF + m * 16) * 2048 + col0 + bj * HALF + 4 * n);
            float ss[4];
#pragma unroll
            for (int m = 0; m < 4; ++m) { ss[m] = 0.f;
#pragma unroll
                for (int bj = 0; bj < 2; ++bj) { const f32x4 v0 = bs[m][bj][0] + acc[ai][bj][m][0], v1 = bs[m][bj][1] + acc[ai][bj][m][1];
                    ss[m] += (v0[0] * v0[0] + v0[1] * v0[1]) + (v0[2] * v0[2] + v0[3] * v0[3]) + (v1[0] * v1[0] + v1[1] * v1[1]) + (v1[2] * v1[2] + v1[3] * v1[3]);
                    u32x4 w; w.x = cvt_pk_bf16(v0[0], v0[1]); w.y = cvt_pk_bf16(v0[2], v0[3]); w.z = cvt_pk_bf16(v1[0], v1[1]); w.w = cvt_pk_bf16(v1[2], v1[3]);
                    __builtin_amdgcn_raw_buffer_store_b128(w, orsrc, ((unsigned)(row0 + ai * HALF + m * 16) * (unsigned)J.ldc + (unsigned)(col0 + bj * HALF)) * 2u, 0, 16); } }
#pragma unroll
            for (int m = 0; m < 4; ++m) { float t = ss[m]; t = xl_sum16(t); t = xl_sum32(t);
                if (fq == 0) (void)__hip_atomic_fetch_add(J.ssq + row0 + ai * HALF + m * 16, t, __ATOMIC_RELAXED, __HIP_MEMORY_SCOPE_AGENT); }
        }
        return;
    }
    if (J.kind == 6) {
#pragma unroll
        for (int ai = 0; ai < 2; ++ai) {
            u32x4 p[4][2];
#pragma unroll
            for (int m = 0; m < 4; ++m)
#pragma unroll
                for (int bj = 0; bj < 2; ++bj) p[m][bj] = *(const u32x4*)(J.O + (size_t)(row0 + ai * HALF + m * 16) * J.ldc + col0 + bj * HALF);
#pragma unroll
            for (int m = 0; m < 4; ++m)
#pragma unroll
                for (int bj = 0; bj < 2; ++bj) { const f32x4 v0 = acc[ai][bj][m][0], v1 = acc[ai][bj][m][1]; const u32x4 q = p[m][bj]; u32x4 w;
                    w.x = cvt_pk_bf16(bflo(q.x) + v0[0], bfhi(q.x) + v0[1]); w.y = cvt_pk_bf16(bflo(q.y) + v0[2], bfhi(q.y) + v0[3]);
                    w.z = cvt_pk_bf16(bflo(q.z) + v1[0], bfhi(q.z) + v1[1]); w.w = cvt_pk_bf16(bflo(q.w) + v1[2], bfhi(q.w) + v1[3]);
                    *(u32x4*)(J.O + (size_t)(row0 + ai * HALF + m * 16) * J.ldc + col0 + bj * HALF) = w; }
        }
        return;
    }
    if (J.kind == 2) {
#pragma unroll
        for (int ai = 0; ai < 2; ++ai) {
            u32x4 p[4][2];
#pragma unroll
            for (int m = 0; m < 4; ++m)
#pragma unroll
                for (int bj = 0; bj < 2; ++bj) p[m][bj] = *(const u32x4*)(J.O + (size_t)(row0 + ai * HALF + m * 16) * J.ldc + col0 + bj * HALF);
#pragma unroll
            for (int m = 0; m < 4; ++m)
#pragma unroll
                for (int bj = 0; bj < 2; ++bj) { const f32x4 v0 = acc[ai][bj][m][0] * rs[ai][m], v1 = acc[ai][bj][m][1] * rs[ai][m]; const u32x4 q = p[m][bj]; u32x4 w;
                    w.x = cvt_pk_bf16(bflo(q.x) * silu_f(v0[0]), bfhi(q.x) * silu_f(v0[1])); w.y = cvt_pk_bf16(bflo(q.y) * silu_f(v0[2]), bfhi(q.y) * silu_f(v0[3]));
                    w.z = cvt_pk_bf16(bflo(q.z) * silu_f(v1[0]), bfhi(q.z) * silu_f(v1[1])); w.w = cvt_pk_bf16(bflo(q.w) * silu_f(v1[2]), bfhi(q.w) * silu_f(v1[3]));
                    *(u32x4*)(J.O + (size_t)(row0 + ai * HALF + m * 16) * J.ldc + col0 + bj * HALF) = w; }
        }
        return;
    }
    if (J.kind == 1) {
        f32x4 sc[2][2];
#pragma unroll
        for (int bj = 0; bj < 2; ++bj)
#pragma unroll
            for (int n = 0; n < 2; ++n) sc[bj][n] = *(const f32x4*)(J.colscale + col0 + bj * HALF + 4 * n);
#pragma unroll
        for (int ai = 0; ai < 2; ++ai)
#pragma unroll
            for (int m = 0; m < 4; ++m) { bf16_t* rowp = J.O + (size_t)(row0 + ai * HALF + m * 16) * J.ldc + col0;
#pragma unroll
                for (int bj = 0; bj < 2; ++bj) { const f32x4 v0 = acc[ai][bj][m][0] * sc[bj][0], v1 = acc[ai][bj][m][1] * sc[bj][1];
                    u32x4 w; w.x = cvt_pk_bf16(v0[0], v0[1]); w.y = cvt_pk_bf16(v0[2], v0[3]); w.z = cvt_pk_bf16(v1[0], v1[1]); w.w = cvt_pk_bf16(v1[2], v1[3]);
                    *(u32x4*)(rowp + bj * HALF) = w; } }
        return;
    }
#pragma unroll
    for (int ai = 0; ai < 2; ++ai)
#pragma unroll
        for (int m = 0; m < 4; ++m) { const int rr = (J.kind == 4) ? (row0 - fr + ai * HALF + 4 * fr + m) : (row0 + ai * HALF + m * 16);
            const unsigned rowoff = ((unsigned)rr * (unsigned)J.ldc + (unsigned)col0) * 2u;
#pragma unroll
            for (int bj = 0; bj < 2; ++bj) { const f32x4 v0 = acc[ai][bj][m][0] * rs[ai][m], v1 = acc[ai][bj][m][1] * rs[ai][m];
                u32x4 w; w.x = cvt_pk_bf16(v0[0], v0[1]); w.y = cvt_pk_bf16(v0[2], v0[3]); w.z = cvt_pk_bf16(v1[0], v1[1]); w.w = cvt_pk_bf16(v1[2], v1[3]);
                __builtin_amdgcn_raw_buffer_store_b128(w, orsrc, rowoff + bj * (HALF * 2), 0, 16); } }
}

__device__ __forceinline__ void epilogue_final(const Job& J, f32x4 (&acc)[2][2][4][2], const Unit& u, int wid, int wr, int wc, int fr, int fq) {
    const int row0 = u.pm * BM + wr * 64 + fr, col0 = u.pn * BM + wc * 32 + 8 * fq;
    float ss[2][4];
#pragma unroll
    for (int ai = 0; ai < 2; ++ai) {
        u32x4 p[4][2];
#pragma unroll
        for (int m = 0; m < 4; ++m)
#pragma unroll
            for (int bj = 0; bj < 2; ++bj) p[m][bj] = *(const u32x4*)(J.O + (size_t)(row0 + ai * HALF + m * 16) * J.ldc + col0 + bj * HALF);
#pragma unroll
        for (int m = 0; m < 4; ++m) { float t = 0.f;
#pragma unroll
            for (int bj = 0; bj < 2; ++bj) { const u32x4 q = p[m][bj];
                f32x4 v0 = acc[ai][bj][m][0], v1 = acc[ai][bj][m][1];
                v0[0] += bflo(q.x); v0[1] += bfhi(q.x); v0[2] += bflo(q.y); v0[3] += bfhi(q.y); v1[0] += bflo(q.z); v1[1] += bfhi(q.z); v1[2] += bflo(q.w); v1[3] += bfhi(q.w);
                t += (v0[0] * v0[0] + v0[1] * v0[1]) + (v0[2] * v0[2] + v0[3] * v0[3]) + (v1[0] * v1[0] + v1[1] * v1[1]) + (v1[2] * v1[2] + v1[3] * v1[3]);
                acc[ai][bj][m][0] = v0; acc[ai][bj][m][1] = v1; }
            ss[ai][m] = t; }
    }
#pragma unroll
    for (int ai = 0; ai < 2; ++ai)
#pragma unroll
        for (int m = 0; m < 4; ++m) { const float t = xl_sum32(xl_sum16(ss[ai][m]));
            if (fq == 0) (void)__hip_atomic_fetch_add(J.ssq + row0 + ai * HALF + m * 16, t, __ATOMIC_RELAXED, __HIP_MEMORY_SCOPE_AGENT); }
    asm volatile("s_waitcnt vmcnt(0)" ::: "memory");
    __builtin_amdgcn_s_barrier();
    if (wid == 0 && fr == 0 && fq == 0) {
        unsigned* pc = J.pcnt + u.pm;
        (void)__hip_atomic_fetch_add(pc, 1u, __ATOMIC_RELAXED, __HIP_MEMORY_SCOPE_AGENT);
        unsigned sp = 0u;
        while (__hip_atomic_load(pc, __ATOMIC_RELAXED, __HIP_MEMORY_SCOPE_AGENT) < 8u) { __builtin_amdgcn_s_sleep(1); if (++sp > (1u << 22)) break; }
    }
    __builtin_amdgcn_s_barrier();
    f32x4 gn[2][2];
#pragma unroll
    for (int bj = 0; bj < 2; ++bj)
#pragma unroll
        for (int n = 0; n < 2; ++n) gn[bj][n] = *(const f32x4*)(J.colscale + col0 + bj * HALF + 4 * n);
#pragma unroll
    for (int ai = 0; ai < 2; ++ai)
#pragma unroll
        for (int m = 0; m < 4; ++m) ss[ai][m] = __hip_atomic_load(J.ssq + row0 + ai * HALF + m * 16, __ATOMIC_RELAXED, __HIP_MEMORY_SCOPE_AGENT);
#pragma unroll
    for (int ai = 0; ai < 2; ++ai)
#pragma unroll
        for (int m = 0; m < 4; ++m) { const float r = 1.0f / sqrtf(ss[ai][m] * (1.f / 2048.f) + 1e-6f);
            float* orow = J.out + (size_t)(row0 + ai * HALF + m * 16) * 2048 + col0;
#pragma unroll
            for (int bj = 0; bj < 2; ++bj) { *(f32x4*)(orow + bj * HALF) = acc[ai][bj][m][0] * r * gn[bj][0]; *(f32x4*)(orow + bj * HALF + 4) = acc[ai][bj][m][1] * r * gn[bj][1]; } }
}

__device__ __forceinline__ void gemm_phase(LAS unsigned char* lds, const Job& J, const int tid) {
    constexpr bool ALIGN_EPI = true;
    const int wid = __builtin_amdgcn_readfirstlane(tid >> 6), lane = tid & 63, wr = wid >> 2, wc = wid & 3, fr = lane & 15, fq = lane >> 4;
    const int K = J.K, nt = K / BK;
    const bool perm = (J.kind != 3);
    StaticOrder S; S.init(J.M, J.N, J.G, J.c, J.wgm);
    unsigned voffA[2], voffB[2];
#pragma unroll
    for (int i = 0; i < 2; ++i) { int R, C; stage_rc(tid * 16 + i * 8192, R, C); const int Rb = perm ? ((R & ~31) + perm32(R & 31)) : R;
        const int Ra = (J.kind == 4) ? ((R & ~63) + 4 * (R & 15) + ((R >> 4) & 3)) : R;
        voffA[i] = (unsigned)(Ra * J.lda + C) * 2u; voffB[i] = (unsigned)(Rb * J.ldb + C) * 2u; }
    const size_t kstep = (size_t)(BK * 2);
    const size_t hstepA = (size_t)HALF * J.lda * 2, hstepB = (size_t)HALF * J.ldb * 2;
    const size_t tstepA = 2 * hstepA, tstepB = 2 * hstepB;
    const unsigned ldsw = (unsigned)wid * 1024u;
    const int aoff = lds_byte(wr * 64 + fr, fq * 8), boff = lds_byte(wc * 32 + fr, fq * 8);
#define PG8_SA(b, h) (((b) * 2 + (h)) * HTB)
#define PG8_SB(b, h) ((4 + (b) * 2 + (h)) * HTB)
#define PG8_STAGE(bufoff, gbase, voff) do { _Pragma("unroll") for (int _i = 0; _i < 2; ++_i) \
        __builtin_amdgcn_global_load_lds((const unsigned*)((const char*)(gbase) + (voff)[_i]), (LAS unsigned*)(lds + (bufoff) + ldsw + _i * 8192), 16, 0, 0); } while (0)
#define PG8_LDA(dst, b, h) do { _Pragma("unroll") for (int m = 0; m < 4; ++m) _Pragma("unroll") for (int k = 0; k < 2; ++k) dst[m][k] = *(const LAS bf16x8*)(lds + PG8_SA(b, h) + aoff + m * 2048 + k * 1024); } while (0)
#define PG8_LDB(dst, b, h) do { _Pragma("unroll") for (int n = 0; n < 2; ++n) _Pragma("unroll") for (int k = 0; k < 2; ++k) dst[n][k] = *(const LAS bf16x8*)(lds + PG8_SB(b, h) + boff + n * 2048 + k * 1024); } while (0)
#define PG8_MMA(ai, bj, At, Bt) do { __builtin_amdgcn_s_setprio(1); _Pragma("unroll") for (int m = 0; m < 4; ++m) _Pragma("unroll") for (int n = 0; n < 2; ++n) _Pragma("unroll") for (int k = 0; k < 2; ++k) \
        acc[ai][bj][m][n] = __builtin_amdgcn_mfma_f32_16x16x32_bf16(Bt[n][k], At[m][k], acc[ai][bj][m][n], 0, 0, 0); __builtin_amdgcn_s_setprio(0); } while (0)
#define PG8_WAIT_V(n) asm volatile("s_waitcnt vmcnt(" #n ")" ::: "memory")
#define PG8_WAIT_L(n) asm volatile("s_waitcnt lgkmcnt(" #n ")" ::: "memory")
#define PG8_BAR __builtin_amdgcn_s_barrier()
#define PG8_SCHED __builtin_amdgcn_sched_barrier(0)
#define PG8_APTR(u) ((const char*)J.A + (size_t)(u).pm * tstepA + (size_t)((u).pn / J.grp_tiles) * (size_t)J.grp_stride * 2)
#define PG8_BPTR(u) ((const char*)J.Bt + (size_t)(u).pn * tstepB + (size_t)((u).pm / J.bgrp_tiles) * (size_t)J.bgrp_stride * 2)
    Unit cur, nxt; int ui = 0;
    if (!S.next(0, cur)) return;
    f32x4 acc[2][2][4][2];
#pragma unroll
    for (int a = 0; a < 2; ++a)
#pragma unroll
        for (int b = 0; b < 2; ++b)
#pragma unroll
            for (int m = 0; m < 4; ++m)
#pragma unroll
                for (int n = 0; n < 2; ++n) acc[a][b][m][n] = (f32x4){0.f, 0.f, 0.f, 0.f};
    bf16x8 At[4][2], B0[2][2], B1[2][2];
    const char* cA = PG8_APTR(cur); const char* cB = PG8_BPTR(cur);
    PG8_STAGE(PG8_SB(0, 0), cB, voffB); PG8_STAGE(PG8_SB(0, 1), cB + hstepB, voffB); PG8_STAGE(PG8_SA(0, 0), cA, voffA); PG8_STAGE(PG8_SA(0, 1), cA + hstepA, voffA);
    if (wr == 1) PG8_BAR;
    PG8_WAIT_V(2); PG8_BAR;
    PG8_STAGE(PG8_SB(1, 0), cB + kstep, voffB); PG8_STAGE(PG8_SA(1, 0), cA + kstep, voffA); PG8_STAGE(PG8_SB(1, 1), cB + hstepB + kstep, voffB);
    PG8_WAIT_V(6); PG8_BAR;
    for (;;) {
        const bool has_next = S.next(ui + 1, nxt);
        const char* nA = has_next ? PG8_APTR(nxt) : cA; const char* nB = has_next ? PG8_BPTR(nxt) : cB;
        for (int t = 0; t < nt; t += 2) {
            const bool last = (t == nt - 2);
            const char* a1 = cA + (size_t)(t + 1) * kstep;
            const char* a2 = last ? nA : cA + (size_t)(t + 2) * kstep; const char* b2 = last ? nB : cB + (size_t)(t + 2) * kstep;
            const char* a3 = a2 + kstep; const char* b3 = b2 + kstep;
            PG8_LDB(B0, 0, 0); PG8_LDB(B1, 0, 1); PG8_SCHED; PG8_LDA(At, 0, 0); PG8_STAGE(PG8_SA(1, 1), a1 + hstepA, voffA);
            PG8_WAIT_V(8); PG8_WAIT_L(0); PG8_BAR; PG8_MMA(0, 0, At, B0); PG8_MMA(0, 1, At, B1); PG8_BAR; PG8_SCHED;
            PG8_LDA(At, 0, 1); PG8_STAGE(PG8_SB(0, 0), b2, voffB); PG8_STAGE(PG8_SB(0, 1), b2 + hstepB, voffB); PG8_STAGE(PG8_SA(0, 0), a2, voffA);
            PG8_WAIT_V(8); PG8_WAIT_L(0); PG8_BAR; PG8_MMA(1, 0, At, B0); PG8_MMA(1, 1, At, B1); PG8_BAR; PG8_SCHED;
            PG8_LDB(B0, 1, 0); PG8_LDB(B1, 1, 1); PG8_SCHED; PG8_LDA(At, 1, 0); PG8_STAGE(PG8_SA(0, 1), a2 + hstepA, voffA);
            PG8_WAIT_V(8); PG8_WAIT_L(0); PG8_BAR; PG8_MMA(0, 0, At, B0); PG8_MMA(0, 1, At, B1); PG8_BAR; PG8_SCHED;
            PG8_LDA(At, 1, 1); PG8_STAGE(PG8_SB(1, 0), b3, voffB); PG8_STAGE(PG8_SB(1, 1), b3 + hstepB, voffB); PG8_STAGE(PG8_SA(1, 0), a3, voffA);
            PG8_WAIT_V(8); PG8_WAIT_L(0); PG8_BAR; PG8_MMA(1, 0, At, B0); PG8_MMA(1, 1, At, B1); PG8_BAR; PG8_SCHED;
        }
        if constexpr (ALIGN_EPI) { if (wr == 0) PG8_BAR; }
        int fr_e = fr, fq_e = fq; asm volatile("" : "+v"(fr_e), "+v"(fq_e));
        float rs[2][4];
#pragma unroll
        for (int a = 0; a < 2; ++a)
#pragma unroll
            for (int m = 0; m < 4; ++m) rs[a][m] = 0.f;
        if (J.rowss != nullptr) {
#pragma unroll
            for (int a = 0; a < 2; ++a)
#pragma unroll
                for (int m = 0; m < 4; ++m) rs[a][m] = J.rowss[cur.pm * BM + wr * 64 + a * HALF + ((J.kind == 4) ? (4 * fr_e + m) : (fr_e + m * 16))];
        }
#pragma unroll
        for (int a = 0; a < 2; ++a)
#pragma unroll
            for (int m = 0; m < 4; ++m) rs[a][m] = (J.rowss != nullptr) ? 1.0f / sqrtf(rs[a][m] * (1.f / 2048.f) + 1e-6f) : 1.0f;
        if (J.kind == 7) epilogue_final(J, acc, cur, wid, wr, wc, fr_e, fq_e); else epilogue(J, acc, rs, cur, wr, wc, fr_e, fq_e);
        if (!has_next) break;
#pragma unroll
        for (int a = 0; a < 2; ++a)
#pragma unroll
            for (int b = 0; b < 2; ++b)
#pragma unroll
                for (int m = 0; m < 4; ++m)
#pragma unroll
                    for (int n = 0; n < 2; ++n) acc[a][b][m][n] = (f32x4){0.f, 0.f, 0.f, 0.f};
        cur = nxt; cA = nA; cB = nB; ++ui;
        if constexpr (ALIGN_EPI) { if (wr == 1) PG8_BAR; }
    }
    PG8_WAIT_V(0);
    if constexpr (!ALIGN_EPI) { if (wr == 0) PG8_BAR; }
    PG8_BAR;
#undef PG8_SA
#undef PG8_SB
#undef PG8_STAGE
#undef PG8_LDA
#undef PG8_LDB
#undef PG8_MMA
#undef PG8_WAIT_V
#undef PG8_WAIT_L
#undef PG8_BAR
#undef PG8_SCHED
#undef PG8_APTR
#undef PG8_BPTR
}
}

constexpr int RING_OFF = 0, RING_BYTES = 131072;
constexpr int LDS_BYTES = 163840;
constexpr int LDSCTL_OFF = LDS_BYTES - 1024, MISC_OFF = LDSCTL_OFF + 320;
constexpr int NWAVES = 8;

constexpr int CW_BAR = 4096, CW_SUB = 8192;

#define RLX_AGENT __ATOMIC_RELAXED, __HIP_MEMORY_SCOPE_AGENT
#define LDS_WAIT() asm volatile("s_waitcnt lgkmcnt(0)" ::: "memory")
#define VM_WAIT() asm volatile("s_waitcnt vmcnt(0)" ::: "memory")
__device__ __forceinline__ unsigned f2bf(float f) { unsigned u = __builtin_bit_cast(unsigned, f); return (u + 0x7fffu + ((u >> 16) & 1u)) >> 16; }
__device__ __forceinline__ unsigned pk2(float lo, float hi) { return f2bf(lo) | (f2bf(hi) << 16); }
__device__ __forceinline__ float bf2f(bf16_t b) { return __uint_as_float((unsigned)b << 16); }

#define XB_TMO      128
#define XB_XCNT(j)  (256  + 64 * (j))
#define XB_XSUB(j)  (1280 + 64 * (j))
#define XB_XGEN(j)  (2304 + 64 * (j))
#define XB_TOP      3328
#define XB_TOPGEN   3392
#define XCD_BAR_WORDS 3456
#define XB_SPIN_CAP (1u << 20)

__device__ __forceinline__ unsigned xb_ld(unsigned* p)              { return __hip_atomic_load(p, __ATOMIC_RELAXED, __HIP_MEMORY_SCOPE_AGENT); }
__device__ __forceinline__ unsigned xb_add(unsigned* p, unsigned v) { return __hip_atomic_fetch_add(p, v, __ATOMIC_RELAXED, __HIP_MEMORY_SCOPE_AGENT); }
__device__ __forceinline__ unsigned xb_xcc_id() { return (unsigned)__builtin_amdgcn_s_getreg((3 << 11) | 20) & 0xFu; }
#define XB_SPIN(cond, bar) do { unsigned _sp = 0; while (cond) { __builtin_amdgcn_s_sleep(1); \
    if ((++_sp & 255u) == 0u) { if (xb_ld(&(bar)[XB_TMO])) break; if (_sp > XB_SPIN_CAP) { atomicAdd(&(bar)[XB_TMO], 1u); break; } } } } while (0)

__device__ __forceinline__ int lane_id_now() { int l; asm volatile("v_mbcnt_lo_u32_b32 %0, -1, 0\n\tv_mbcnt_hi_u32_b32 %0, -1, %0" : "=v"(l)); return l; }

struct XcdBarrier { unsigned* bar; unsigned x; volatile LAS unsigned* st; };

__device__ __forceinline__ XcdBarrier xcd_barrier_post(unsigned* bar, volatile LAS unsigned* st) {
    XcdBarrier b; b.bar = bar; b.x = xb_xcc_id(); b.st = st;
    if (threadIdx.x == 0) (void)xb_add(&bar[XB_XCNT(b.x)], 1u);
    return b;
}
__device__ __forceinline__ void xcd_barrier_complete(unsigned* bar, unsigned x, unsigned& nloc, unsigned& nx) {
    const unsigned G = gridDim.x * gridDim.y * gridDim.z;
    unsigned sum, cnt, mine, sp = 0u;
    for (;;) {
        sum = 0u; cnt = 0u; mine = 0u;
#pragma unroll
        for (unsigned j = 0; j < 16; ++j) { const unsigned c = xb_ld(&bar[XB_XCNT(j)]); sum += c; cnt += (c > 0u) ? 1u : 0u; mine = (j == x) ? c : mine; }
        if (sum == G) break;
        __builtin_amdgcn_s_sleep(1);
        if ((++sp & 255u) == 0u) { if (xb_ld(&bar[XB_TMO])) break; if (sp > XB_SPIN_CAP) { atomicAdd(&bar[XB_TMO], 1u); break; } }
    }
    nloc = mine > 0u ? mine : 1u; nx = cnt > 0u ? cnt : 1u;
}
__device__ __forceinline__ void xcd_barrier(const XcdBarrier& b, int wave_s) {
    asm volatile("s_waitcnt vmcnt(0)" ::: "memory");
    __syncthreads();
    if (wave_s == 0 && lane_id_now() == 0) {
        unsigned* bar = b.bar;
        __builtin_amdgcn_s_waitcnt(0);
        unsigned nloc = b.st[0], nx = b.st[1];
        if (nloc == 0u) { xcd_barrier_complete(bar, b.x, nloc, nx); b.st[0] = nloc; b.st[1] = nx; }
        const unsigned old = xb_add(&bar[XB_XSUB(b.x)], 1u);
        const unsigned gen = old / nloc;
        if (old + 1u == (gen + 1u) * nloc) {
            __builtin_amdgcn_fence(__ATOMIC_RELEASE, "agent");
            asm volatile("s_waitcnt vmcnt(0)" ::: "memory");
            const unsigned og = xb_add(&bar[XB_TOP], 1u);
            const unsigned tg = og / nx;
            if (og + 1u == (tg + 1u) * nx) xb_add(&bar[XB_TOPGEN], 1u);
            else XB_SPIN(xb_ld(&bar[XB_TOPGEN]) == tg, bar);
            __builtin_amdgcn_fence(__ATOMIC_ACQUIRE, "agent");
            xb_add(&bar[XB_XGEN(b.x)], 1u);
            asm volatile("s_waitcnt vmcnt(0)" ::: "memory");
        } else {
            XB_SPIN(xb_ld(&bar[XB_XGEN(b.x)]) == gen, bar);
            __builtin_amdgcn_fence(__ATOMIC_ACQUIRE, "agent");
            asm volatile("s_waitcnt vmcnt(0)" ::: "memory");
        }
    }
    __syncthreads();
}

struct Args {
    const float* x; const float* mem; const float* norm_g; const float* mem_norm_g; const float* w_kv; const float* w_out;
    const float* pool_w_in; const float* pool_w_grp; const float* pool_scale; const float* hgrn_w_in; const float* hgrn_lb;
    const float* hgrn_norm_g; const float* final_g; float* out; unsigned char* ws; int ph_lo, ph_hi;
};

__device__ __forceinline__ float wave_sum(float v) { return pg8::xl_sum32(pg8::xl_sum16(pg8::xl_row_sum(v))); }
__device__ __forceinline__ float wave_max(float v) { return pg8::xl_max32(pg8::xl_max16(pg8::xl_row_max(v))); }

template <bool GAIN = false>
__device__ __forceinline__ void transpose_item(const float* W, int N, int k0, int n0, bf16_t* WT, int ldt, int orow0, LAS float* scr, int lane, const float* gk = nullptr) {
    f32x4 v[16]; float gs[16];
    const float* src = W + (size_t)(k0 + (lane >> 4)) * N + n0 + 4 * (lane & 15);
#pragma unroll
    for (int j = 0; j < 16; ++j) v[j] = *(const f32x4*)(src + (size_t)(4 * j) * N);
    if constexpr (GAIN) {
#pragma unroll
        for (int j = 0; j < 16; ++j) gs[j] = gk[k0 + 4 * j + (lane >> 4)];
#pragma unroll
        for (int j = 0; j < 16; ++j) v[j] = v[j] * gs[j];
    }
#pragma unroll
    for (int j = 0; j < 16; ++j) { LAS float* d = scr + (4 * j + (lane >> 4)) * 65 + 4 * (lane & 15); d[0] = v[j].x; d[1] = v[j].y; d[2] = v[j].z; d[3] = v[j].w; }
    LDS_WAIT(); asm volatile("" ::: "memory");
    const int c = lane & 7;
#pragma unroll
    for (int j = 0; j < 8; ++j) { const int n = (lane >> 3) + 8 * j; const LAS float* s = scr + (8 * c) * 65 + n;
        u32x4 o; o.x = pk2(s[0 * 65], s[1 * 65]); o.y = pk2(s[2 * 65], s[3 * 65]); o.z = pk2(s[4 * 65], s[5 * 65]); o.w = pk2(s[6 * 65], s[7 * 65]);
        *(u32x4*)(WT + (size_t)(orow0 + n) * ldt + k0 + 8 * c) = o; }
    LDS_WAIT(); asm volatile("" ::: "memory");
}

__device__ __forceinline__ void rms_row_to_bf16(const float* xrow, const f32x4 (&gv)[8], bf16_t* orow, int lane) {
    const f32x4* xr = (const f32x4*)xrow + lane;
    f32x4 v[8]; float s = 0.f;
#pragma unroll
    for (int j = 0; j < 8; ++j) v[j] = xr[64 * j];
    asm volatile("" ::: "memory");
#pragma unroll
    for (int j = 0; j < 8; ++j) s += (v[j].x * v[j].x + v[j].y * v[j].y) + (v[j].z * v[j].z + v[j].w * v[j].w);
    const float r = 1.0f / sqrtf(wave_sum(s) * (1.f / DM) + EPS);
    unsigned long long* o8 = (unsigned long long*)orow + lane;
#pragma unroll
    for (int j = 0; j < 8; ++j) { const f32x4 gg = gv[j];
        o8[64 * j] = (unsigned long long)pk2(v[j].x * r * gg.x, v[j].y * r * gg.y) | ((unsigned long long)pk2(v[j].z * r * gg.z, v[j].w * r * gg.w) << 32); }
}
__device__ __forceinline__ void rms_row2_to_bf16(const float* x0, const float* x1, const f32x4 (&gv)[8], bf16_t* o0, bf16_t* o1, int lane) {
    const f32x4* xr0 = (const f32x4*)x0 + lane; const f32x4* xr1 = (const f32x4*)x1 + lane;
    f32x4 v0[8], v1[8]; float s0 = 0.f, s1 = 0.f;
#pragma unroll
    for (int j = 0; j < 8; ++j) { v0[j] = xr0[64 * j]; v1[j] = xr1[64 * j]; }
    asm volatile("" ::: "memory");
#pragma unroll
    for (int j = 0; j < 8; ++j) { s0 += (v0[j].x * v0[j].x + v0[j].y * v0[j].y) + (v0[j].z * v0[j].z + v0[j].w * v0[j].w); s1 += (v1[j].x * v1[j].x + v1[j].y * v1[j].y) + (v1[j].z * v1[j].z + v1[j].w * v1[j].w); }
    s0 = wave_sum(s0); s1 = wave_sum(s1);
    const float r0 = 1.0f / sqrtf(s0 * (1.f / DM) + EPS), r1 = 1.0f / sqrtf(s1 * (1.f / DM) + EPS);
    unsigned long long* p0 = (unsigned long long*)o0 + lane; unsigned long long* p1 = (unsigned long long*)o1 + lane;
#pragma unroll
    for (int j = 0; j < 8; ++j) { const f32x4 gg = gv[j];
        p0[64 * j] = (unsigned long long)pk2(v0[j].x * r0 * gg.x, v0[j].y * r0 * gg.y) | ((unsigned long long)pk2(v0[j].z * r0 * gg.z, v0[j].w * r0 * gg.w) << 32);
        p1[64 * j] = (unsigned long long)pk2(v1[j].x * r1 * gg.x, v1[j].y * r1 * gg.y) | ((unsigned long long)pk2(v1[j].z * r1 * gg.z, v1[j].w * r1 * gg.w) << 32); }
}
__device__ __forceinline__ void rms_row_f32(float* xrow, const f32x4 (&gv)[8], int lane) {
    f32x4* xr = (f32x4*)xrow + lane;
    f32x4 v[8]; float s = 0.f;
#pragma unroll
    for (int j = 0; j < 8; ++j) v[j] = xr[64 * j];
    asm volatile("" ::: "memory");
#pragma unroll
    for (int j = 0; j < 8; ++j) s += (v[j].x * v[j].x + v[j].y * v[j].y) + (v[j].z * v[j].z + v[j].w * v[j].w);
    const float r = 1.0f / sqrtf(wave_sum(s) * (1.f / DM) + EPS);
#pragma unroll
    for (int j = 0; j < 8; ++j) { const f32x4 gg = gv[j]; xr[64 * j] = (f32x4){v[j].x * r * gg.x, v[j].y * r * gg.y, v[j].z * r * gg.z, v[j].w * r * gg.w}; }
}
__device__ __forceinline__ void rms_row_bf16_to_f32(const bf16_t* hrow, const f32x4 (&gv)[8], float* orow, int lane) {
    const u32x2* hr = (const u32x2*)hrow + lane;
    u32x2 v[8]; float s = 0.f;
#pragma unroll
    for (int j = 0; j < 8; ++j) v[j] = hr[64 * j];
    asm volatile("" ::: "memory");
    f32x4 f[8];
#pragma unroll
    for (int j = 0; j < 8; ++j) { f[j] = (f32x4){pg8::bflo(v[j].x), pg8::bfhi(v[j].x), pg8::bflo(v[j].y), pg8::bfhi(v[j].y)}; s += (f[j].x * f[j].x + f[j].y * f[j].y) + (f[j].z * f[j].z + f[j].w * f[j].w); }
    const float r = 1.0f / sqrtf(wave_sum(s) * (1.f / DM) + EPS);
    f32x4* o = (f32x4*)orow + lane;
#pragma unroll
    for (int j = 0; j < 8; ++j) { const f32x4 gg = gv[j]; o[64 * j] = (f32x4){f[j].x * r * gg.x, f[j].y * r * gg.y, f[j].z * r * gg.z, f[j].w * r * gg.w}; }
}
__device__ __forceinline__ void rms_row2_bf16_to_f32(const bf16_t* h0, const bf16_t* h1, const f32x4 (&gv)[8], float* o0, float* o1, int lane) {
    const u32x2* hr0 = (const u32x2*)h0 + lane; const u32x2* hr1 = (const u32x2*)h1 + lane;
    u32x2 v0[8], v1[8]; float s0 = 0.f, s1 = 0.f;
#pragma unroll
    for (int j = 0; j < 8; ++j) { v0[j] = hr0[64 * j]; v1[j] = hr1[64 * j]; }
    asm volatile("" ::: "memory");
#pragma unroll
    for (int j = 0; j < 8; ++j) { const float a = pg8::bflo(v0[j].x), b = pg8::bfhi(v0[j].x), c = pg8::bflo(v0[j].y), d = pg8::bfhi(v0[j].y); s0 += (a * a + b * b) + (c * c + d * d);
        const float e = pg8::bflo(v1[j].x), f = pg8::bfhi(v1[j].x), g = pg8::bflo(v1[j].y), h = pg8::bfhi(v1[j].y); s1 += (e * e + f * f) + (g * g + h * h); }
    s0 = wave_sum(s0); s1 = wave_sum(s1);
    const float r0 = 1.0f / sqrtf(s0 * (1.f / DM) + EPS), r1 = 1.0f / sqrtf(s1 * (1.f / DM) + EPS);
    f32x4* p0 = (f32x4*)o0 + lane; f32x4* p1 = (f32x4*)o1 + lane;
#pragma unroll
    for (int j = 0; j < 8; ++j) { const f32x4 gg = gv[j];
        p0[64 * j] = (f32x4){pg8::bflo(v0[j].x) * r0 * gg.x, pg8::bfhi(v0[j].x) * r0 * gg.y, pg8::bflo(v0[j].y) * r0 * gg.z, pg8::bfhi(v0[j].y) * r0 * gg.w};
        p1[64 * j] = (f32x4){pg8::bflo(v1[j].x) * r1 * gg.x, pg8::bfhi(v1[j].x) * r1 * gg.y, pg8::bflo(v1[j].y) * r1 * gg.z, pg8::bfhi(v1[j].y) * r1 * gg.w}; }
}
__device__ __forceinline__ void load_gain(const float* g, f32x4 (&gv)[8], int lane) {
#pragma unroll
    for (int j = 0; j < 8; ++j) gv[j] = *((const f32x4*)g + lane + 64 * j);
}

__device__ __forceinline__ float dot256(const bf16_t* row, const LAS float* vec) {
    float s = 0.f;
#pragma unroll 4
    for (int c = 0; c < 32; ++c) { const u32x4 w = *(const u32x4*)(row + 8 * c); const LAS f32x4* vv = (const LAS f32x4*)(vec + 8 * c); const f32x4 a = vv[0], b = vv[1];
        s += pg8::bflo(w.x) * a.x + pg8::bfhi(w.x) * a.y + pg8::bflo(w.y) * a.z + pg8::bfhi(w.y) * a.w + pg8::bflo(w.z) * b.x + pg8::bfhi(w.z) * b.y + pg8::bflo(w.w) * b.z + pg8::bfhi(w.w) * b.w; }
    return s;
}


typedef float f32x16 __attribute__((ext_vector_type(16)));
typedef short s16x4 __attribute__((ext_vector_type(4)));
#define MFMA32(a, b, c) __builtin_amdgcn_mfma_f32_32x32x16_bf16((a), (b), (c), 0, 0, 0)
__device__ __forceinline__ bf16x8 pack8(const f32x16& x, int s) {
    u32x4 p; p.x = pg8::cvt_pk_bf16(x[8 * s], x[8 * s + 1]); p.y = pg8::cvt_pk_bf16(x[8 * s + 2], x[8 * s + 3]); p.z = pg8::cvt_pk_bf16(x[8 * s + 4], x[8 * s + 5]); p.w = pg8::cvt_pk_bf16(x[8 * s + 6], x[8 * s + 7]);
    return __builtin_bit_cast(bf16x8, p);
}
__device__ __forceinline__ bf16x8 cat44(u32x2 lo, u32x2 hi) { u32x4 p; p.x = lo.x; p.y = lo.y; p.z = hi.x; p.w = hi.y; return __builtin_bit_cast(bf16x8, p); }

constexpr int CAROW = 528, CATILE = 32 * CAROW, CASTG = 2 * CATILE, CASROW = 80;
__device__ __forceinline__ void ca_unit(const bf16_t* Qu  , bf16_t* Ou  , int ldq, int ldo, const bf16_t* Kb  , const bf16_t* Vtb  , LAS unsigned char* lds, int tid) {
    const int lane = tid & 63, w = __builtin_amdgcn_readfirstlane(tid >> 6), r = lane & 31, h = lane >> 5;
    const int srow = tid >> 4, spc = tid & 15;
    bf16x8 qf[16];
#pragma unroll
    for (int ks = 0; ks < 16; ++ks) qf[ks] = *(const bf16x8*)(Qu + (size_t)(32 * w + r) * ldq + 16 * ks + 8 * h);
    u32x4 sr[2][2];
    const __amdgpu_buffer_rsrc_t krs = __builtin_amdgcn_make_buffer_rsrc((void*)Kb, 0, 0x7ffffff0, 0x00020000), vrs = __builtin_amdgcn_make_buffer_rsrc((void*)Vtb, 0, 0x7ffffff0, 0x00020000);
    const unsigned kvo = ((unsigned)srow * 2048u + 16u * spc) * 2u, vvo = ((unsigned)srow * (unsigned)MROWS + 16u * spc) * 2u;
#define CA_LOAD(t) do { if ((t) < 8) { sr[(t) & 1][0] = __builtin_bit_cast(u32x4, __builtin_amdgcn_raw_buffer_load_b128(krs, kvo, (t) * (32 * 2048 * 2), 0)); sr[(t) & 1][1] = __builtin_bit_cast(u32x4, __builtin_amdgcn_raw_buffer_load_b128(krs, kvo + 16u, (t) * (32 * 2048 * 2), 0)); } \
        else { sr[(t) & 1][0] = __builtin_bit_cast(u32x4, __builtin_amdgcn_raw_buffer_load_b128(vrs, vvo, ((t) - 8) * (32 * MROWS * 2), 0)); sr[(t) & 1][1] = __builtin_bit_cast(u32x4, __builtin_amdgcn_raw_buffer_load_b128(vrs, vvo + 16u, ((t) - 8) * (32 * MROWS * 2), 0)); } } while (0)
#define CA_WRITE(t) do { LAS unsigned char* d_ = lds + ((t) & 1) * CATILE + srow * CAROW + 32 * spc; *(LAS u32x4*)d_ = sr[(t) & 1][0]; *(LAS u32x4*)(d_ + 16) = sr[(t) & 1][1]; } while (0)
    CA_LOAD(0); CA_LOAD(1); CA_WRITE(0); CA_LOAD(2);
    __syncthreads();
    f32x16 X[8];
#pragma unroll
    for (int kt = 0; kt < 8; ++kt) {
        if (kt >= 1) CA_LOAD(kt + 2);
#pragma unroll
        for (int i = 0; i < 16; ++i) X[kt][i] = 0.f;
        const LAS unsigned char* kp = lds + (kt & 1) * CATILE + r * CAROW + h * 16;
#pragma unroll
        for (int ks = 0; ks < 16; ++ks) { const bf16x8 a = *(const LAS bf16x8*)(kp + 32 * ks); X[kt] = MFMA32(a, qf[ks], X[kt]); }
        CA_WRITE(kt + 1);
        __syncthreads();
    }
    float mx = -3.0e38f;
#pragma unroll
    for (int kt = 0; kt < 8; ++kt)
#pragma unroll
        for (int i = 0; i < 16; ++i) mx = fmaxf(mx, X[kt][i]);
    mx = pg8::xl_max32(mx);
    const float c = 0.0625f * 1.4426950408889634f; float sm = 0.f;
#pragma unroll
    for (int kt = 0; kt < 8; ++kt)
#pragma unroll
        for (int i = 0; i < 16; ++i) { X[kt][i] = __builtin_amdgcn_exp2f((X[kt][i] - mx) * c); sm += X[kt][i]; }
    sm = pg8::xl_sum32(sm);
    const float inv = 1.0f / sm;
    bf16x8 pa[8][2];
#pragma unroll
    for (int kt = 0; kt < 8; ++kt) {
#pragma unroll
        for (int i = 0; i < 16; ++i) X[kt][i] *= inv;
        pa[kt][0] = pack8(X[kt], 0); pa[kt][1] = pack8(X[kt], 1);
    }
    LAS unsigned char* stg = lds + CASTG + w * (32 * CASROW);
#define CA_PV(dt) do { f32x16 Z; if ((dt) < 6) CA_LOAD(8 + (dt) + 2); \
        _Pragma("unroll") for (int i = 0; i < 16; ++i) Z[i] = 0.f; \
        const LAS unsigned char* vp = lds + ((dt) & 1) * CATILE + r * CAROW + h * 8; \
        _Pragma("unroll") for (int kt = 0; kt < 8; ++kt) _Pragma("unroll") for (int ss = 0; ss < 2; ++ss) { const u32x2 lo = *(const LAS u32x2*)(vp + (32 * kt + 16 * ss) * 2), hi = *(const LAS u32x2*)(vp + (32 * kt + 16 * ss) * 2 + 16); Z = MFMA32(cat44(lo, hi), pa[kt][ss], Z); } \
          \
        _Pragma("unroll") for (int g = 0; g < 4; ++g) { u32x2 o; o.x = pg8::cvt_pk_bf16(Z[4 * g], Z[4 * g + 1]); o.y = pg8::cvt_pk_bf16(Z[4 * g + 2], Z[4 * g + 3]); *(LAS u32x2*)(stg + r * CASROW + (8 * g + 4 * h) * 2) = o; } \
        if ((dt) < 7) CA_WRITE(8 + (dt) + 1);        \
        LDS_WAIT(); asm volatile("" ::: "memory"); \
        { const int q = lane >> 1, hf = lane & 1; const u32x4 v0 = *(const LAS u32x4*)(stg + q * CASROW + 32 * hf), v1 = *(const LAS u32x4*)(stg + q * CASROW + 32 * hf + 16); \
          bf16_t* op = Ou + (size_t)(32 * w + q) * ldo + 32 * (dt) + 16 * hf; *(u32x4*)op = v0; *(u32x4*)(op + 8) = v1; } \
        __syncthreads(); } while (0)
#pragma unroll 1
    for (int d2 = 0; d2 < 8; d2 += 2) { CA_PV(d2); CA_PV(d2 + 1); }
#undef CA_PV
#undef CA_LOAD
#undef CA_WRITE
}

constexpr int HROW = 272, HKROW = 256, HVROW = 320, HQD = 0, HKI = 17408, HV = HKI + 64 * HKROW, HDEC = HV + 64 * HVROW, HSET = HDEC + 512, HOUT = 2 * HSET, HOROW = 272, HOUTB = 64 * HOROW, HNG = HOUT + 2 * HOUTB;
static_assert(HNG + 512 <= LDSCTL_OFF, "hgrn LDS map");
#define RAW_BAR() do { asm volatile("s_waitcnt lgkmcnt(0)" ::: "memory"); __builtin_amdgcn_s_barrier(); asm volatile("" ::: "memory"); } while (0)
typedef short v4i16_t __attribute__((ext_vector_type(4)));
__device__ __forceinline__ u32x2 tr_read(const LAS unsigned char* p) { return __builtin_bit_cast(u32x2, __builtin_amdgcn_ds_read_tr16_b64_v4i16((LAS v4i16_t*)p)); }
__device__ __forceinline__ void hgrn_unit(bf16_t* P1, const float* DECG, const float* hgrn_norm_g, int b, int hh, LAS unsigned char* lds, int tid, bf16_t* Ob, int ldo, int rowmask) {
    const int lane = tid & 63, w = __builtin_amdgcn_readfirstlane(tid >> 6);
    constexpr int NCH = SEQ / 64;
    if (w < 4) {
        const int vt = w, r = lane & 31, h = lane >> 5;
        const int trq = (lane & 15) >> 2, trg = (lane >> 4) & 1, trp = lane & 3;
        const int trlv = trq * HVROW + (16 * trg + 4 * trp) * 2;
        const int kxb = r * HKROW + (((4 * (r & 3) + ((r >> 2) & 3)) ^ h) << 4);
        const int pp = ((trp & 1) << 1) | (trp >> 1);
        int knb[2];
#pragma unroll
        for (int d = 0; d < 2; ++d) knb[d] = (8 * h + 4 * d + trq) * HKROW + (((2 * trg + (pp >> 1)) ^ (4 * trq + 2 * h + d)) << 4) + 8 * (pp & 1);
        f32x16 S[4];
#pragma unroll
        for (int kt = 0; kt < 4; ++kt)
#pragma unroll
            for (int i = 0; i < 16; ++i) S[kt][i] = 0.f;
        RAW_BAR();
#define SB() __builtin_amdgcn_sched_barrier(0)
#define LDX(ks, A0, A1, B0, B1) do { A0 = *(const LAS bf16x8*)(lds + ((pKx) ^ (32 * (ks)))); A1 = *(const LAS bf16x8*)(lds + ((pKx + 32 * HKROW) ^ (32 * (ks)))); B0 = *(const LAS bf16x8*)(pQD + 32 * (ks)); B1 = *(const LAS bf16x8*)(pQD + 32 * HROW + 32 * (ks)); } while (0)
#define MMX(A0, A1, B0, B1) do { X00 = MFMA32(A0, B0, X00); X01 = MFMA32(A0, B1, X01); X11 = MFMA32(A1, B1, X11); } while (0)
#define LDV(ss, st) cat44(tr_read(pVp + (32 * (st) + 16 * (ss)) * HVROW), tr_read(pVp + (32 * (st) + 16 * (ss) + 8) * HVROW))
#define LDQ(j, tt) (*(const LAS bf16x8*)(pQD + 32 * (tt) * HROW + 32 * (j)))
#pragma unroll 1
        for (int n = 0; n < NCH; ++n) {
            const LAS unsigned char* sb = lds + (n & 1) * HSET;
            const int sbo = (n & 1) * HSET, pKx = sbo + HKI + kxb, pKn0 = sbo + HKI + knb[0], pKn1 = sbo + HKI + knb[1];
            const LAS unsigned char* pQD = sb + HQD + r * HROW + h * 16;
            const LAS unsigned char* pVp = sb + HV + trlv + 64 * vt + 4 * h * HVROW;
            const LAS unsigned char* pVn = sb + HV + trlv + 64 * vt + 8 * h * HVROW;
            f32x16 X00, X01, X11;
#pragma unroll
            for (int i = 0; i < 16; ++i) { X00[i] = 0.f; X01[i] = 0.f; X11[i] = 0.f; }
            bf16x8 fa0, fa1, fb0, fb1, ga0, ga1, gb0, gb1;
            LDX(0, fa0, fa1, fb0, fb1); LDX(1, ga0, ga1, gb0, gb1); SB();
            MMX(fa0, fa1, fb0, fb1); SB(); LDX(2, fa0, fa1, fb0, fb1); SB();
            MMX(ga0, ga1, gb0, gb1); SB(); LDX(3, ga0, ga1, gb0, gb1); SB();
            MMX(fa0, fa1, fb0, fb1); SB(); LDX(4, fa0, fa1, fb0, fb1); SB();
            MMX(ga0, ga1, gb0, gb1); SB(); LDX(5, ga0, ga1, gb0, gb1); SB();
            MMX(fa0, fa1, fb0, fb1); SB(); LDX(6, fa0, fa1, fb0, fb1); SB();
            MMX(ga0, ga1, gb0, gb1); SB(); LDX(7, ga0, ga1, gb0, gb1); SB();
            const bf16x8 av00 = LDV(0, 0), av01 = LDV(0, 1), av10 = LDV(1, 0), av11 = LDV(1, 1); SB();
            MMX(fa0, fa1, fb0, fb1); SB();
            bf16x8 q00 = LDQ(0, 0), q01 = LDQ(0, 1), q10 = LDQ(1, 0), q11 = LDQ(1, 1); SB();
            MMX(ga0, ga1, gb0, gb1); SB();
#pragma unroll
            for (int i = 0; i < 16; ++i) { const int sl = (i & 3) + 8 * (i >> 2) + 4 * h; if (sl > r) { X00[i] = 0.f; X11[i] = 0.f; } }
            f32x16 OT0, OT1;
#pragma unroll
            for (int i = 0; i < 16; ++i) { OT0[i] = 0.f; OT1[i] = 0.f; }
            OT0 = MFMA32(av00, pack8(X00, 0), OT0); OT1 = MFMA32(av00, pack8(X01, 0), OT1); OT1 = MFMA32(av01, pack8(X11, 0), OT1);
            OT0 = MFMA32(av10, pack8(X00, 1), OT0); OT1 = MFMA32(av10, pack8(X01, 1), OT1); OT1 = MFMA32(av11, pack8(X11, 1), OT1); SB();
#define INTER(j, QA, QB) do { const bf16x8 sa = pack8(S[(j) >> 1], (j) & 1); OT0 = MFMA32(sa, QA, OT0); OT1 = MFMA32(sa, QB, OT1); } while (0)
            INTER(0, q00, q01); SB(); q00 = LDQ(2, 0); q01 = LDQ(2, 1); SB();
            INTER(1, q10, q11); SB(); q10 = LDQ(3, 0); q11 = LDQ(3, 1); SB();
            INTER(2, q00, q01); SB(); q00 = LDQ(4, 0); q01 = LDQ(4, 1); SB();
            INTER(3, q10, q11); SB(); q10 = LDQ(5, 0); q11 = LDQ(5, 1); SB();
            INTER(4, q00, q01); SB(); q00 = LDQ(6, 0); q01 = LDQ(6, 1); SB();
            INTER(5, q10, q11); SB(); q10 = LDQ(7, 0); q11 = LDQ(7, 1); SB();
            INTER(6, q00, q01); SB();
            bf16x8 bv[4];
#pragma unroll
            for (int ts = 0; ts < 4; ++ts) bv[ts] = cat44(tr_read(pVn + 16 * ts * HVROW), tr_read(pVn + (16 * ts + 4) * HVROW));
            SB(); INTER(7, q10, q11); SB();
            bf16x8 ka[4], kb[4]; f32x4 da[4], db[4];
            const LAS unsigned char* pDC = sb + HDEC + h * 32;
#define LDK(kt, KF, DF) do { _Pragma("unroll") for (int ts = 0; ts < 4; ++ts) KF[ts] = cat44(tr_read(lds + ((pKn0 ^ (64 * (kt))) + 16 * ts * HKROW)), tr_read(lds + ((pKn1 ^ (64 * (kt))) + 16 * ts * HKROW))); _Pragma("unroll") for (int g = 0; g < 4; ++g) DF[g] = *(const LAS f32x4*)(pDC + (32 * (kt) + 16 * (g >> 1) + 4 * (g & 1)) * 4); } while (0)
#define UPD(kt, KF, DF) do { _Pragma("unroll") for (int ts = 0; ts < 4; ++ts) S[kt] = MFMA32(KF[ts], bv[ts], S[kt]); \
                _Pragma("unroll") for (int g = 0; g < 4; ++g) { S[kt][4 * g] *= DF[g].x; S[kt][4 * g + 1] *= DF[g].y; S[kt][4 * g + 2] *= DF[g].z; S[kt][4 * g + 3] *= DF[g].w; } } while (0)
            LDK(0, ka, da); SB();
            { LAS unsigned char* ob = lds + HOUT + (n & 1) * HOUTB;
#pragma unroll
              for (int g = 0; g < 4; ++g) {
                u32x2 o0, o1; o0.x = pg8::cvt_pk_bf16(OT0[4 * g], OT0[4 * g + 1]); o0.y = pg8::cvt_pk_bf16(OT0[4 * g + 2], OT0[4 * g + 3]); o1.x = pg8::cvt_pk_bf16(OT1[4 * g], OT1[4 * g + 1]); o1.y = pg8::cvt_pk_bf16(OT1[4 * g + 2], OT1[4 * g + 3]);
                *(LAS u32x2*)(ob + r * HOROW + (32 * vt + 8 * g + 4 * h) * 2) = o0; *(LAS u32x2*)(ob + (32 + r) * HOROW + (32 * vt + 8 * g + 4 * h) * 2) = o1; } }
            SB();
            LDK(1, kb, db); SB(); UPD(0, ka, da); SB();
            LDK(2, ka, da); SB(); UPD(1, kb, db); SB();
            LDK(3, kb, db); SB(); UPD(2, ka, da); SB();
            UPD(3, kb, db); SB();
            RAW_BAR();
        }
#undef LDX
#undef MMX
#undef LDV
#undef LDQ
#undef INTER
#undef LDK
#undef UPD
#undef SB
    } else {
        const int pw = w - 4;
        const int nt = pw * 64 + lane, nrow = nt >> 2, nq = nt & 3;
        if (pw == 0) { *(LAS f32x2*)(lds + HNG + 8 * lane) = *(const f32x2*)(hgrn_norm_g + hh * 128 + 2 * lane); }
        const __amdgpu_buffer_rsrc_t rs = __builtin_amdgcn_make_buffer_rsrc((void*)P1, 0, (int)((size_t)T * LDP * 2), 0x00020000);
        const int crow = 16 * pw + (lane >> 4), cch = lane & 15;
        const int voff0 = (int)(((size_t)(b * SEQ + crow) * LDP + 256 * hh + 8 * cch) * 2);
        const int vso = (6144 + 128 * hh - 256 * hh) * 2;
        const int lq = crow * HROW + 16 * cch, lv = crow * HVROW + 16 * cch;
        const float* decg = DECG + (size_t)(b * (SEQ / 64)) * 3072 + hh * 128 + 32 * pw + 4 * (lane & 7);
        u32x4 qA[4], fA[4], vA[4], qB[4], fB[4], vB[4]; f32x4 dA, dB;
#define HG_LOAD(c_, QW, FW, VW, DW) do { const int c = ((c_) < NCH) ? (c_) : (NCH - 1); const int so_ = c * (64 * LDP * 2);       \
            DW = *(const f32x4*)(decg + (size_t)c * 3072); _Pragma("unroll") for (int j = 0; j < 4; ++j) { \
            QW[j] = __builtin_bit_cast(u32x4, __builtin_amdgcn_raw_buffer_load_b128(rs, voff0, so_ + 4 * j * (LDP * 2), 0)); FW[j] = __builtin_bit_cast(u32x4, __builtin_amdgcn_raw_buffer_load_b128(rs, voff0, so_ + 4 * j * (LDP * 2) + 256, 0)); \
            VW[j] = __builtin_bit_cast(u32x4, __builtin_amdgcn_raw_buffer_load_b128(rs, voff0, so_ + 4 * j * (LDP * 2) + vso, 0)); } } while (0)
#define HG_NORM(n_) do { u32x4 ov[4]; float ss = 0.f; const LAS unsigned char* ob = lds + HOUT + (((n_) - 1) & 1) * HOUTB; \
            _Pragma("unroll") for (int j = 0; j < 4; ++j) ov[j] = *(const LAS u32x4*)(ob + nrow * HOROW + nq * 64 + 16 * j); \
            _Pragma("unroll") for (int j = 0; j < 4; ++j) { const float x0 = pg8::bflo(ov[j].x), x1 = pg8::bfhi(ov[j].x), x2 = pg8::bflo(ov[j].y), x3 = pg8::bfhi(ov[j].y), x4 = pg8::bflo(ov[j].z), x5 = pg8::bfhi(ov[j].z), x6 = pg8::bflo(ov[j].w), x7 = pg8::bfhi(ov[j].w); \
                ss += (x0 * x0 + x1 * x1) + (x2 * x2 + x3 * x3) + (x4 * x4 + x5 * x5) + (x6 * x6 + x7 * x7); } \
            ss += DPPF(ss, 0xB1); ss += DPPF(ss, 0x4E); \
            const float rn = 1.0f / sqrtf(ss * (1.f / 128.f) + EPS); \
            bf16_t* op = Ob + (size_t)((b * SEQ + ((n_) - 1) * 64 + nrow) & rowmask) * ldo + hh * 128 + 32 * nq; \
            _Pragma("unroll") for (int j = 0; j < 4; ++j) { const f32x4 g0 = *(const LAS f32x4*)(lds + HNG + (32 * nq + 8 * j) * 4), g1 = *(const LAS f32x4*)(lds + HNG + (32 * nq + 8 * j + 4) * 4); u32x4 o; \
                o.x = pg8::cvt_pk_bf16(pg8::bflo(ov[j].x) * rn * g0.x, pg8::bfhi(ov[j].x) * rn * g0.y); o.y = pg8::cvt_pk_bf16(pg8::bflo(ov[j].y) * rn * g0.z, pg8::bfhi(ov[j].y) * rn * g0.w); \
                o.z = pg8::cvt_pk_bf16(pg8::bflo(ov[j].z) * rn * g1.x, pg8::bfhi(ov[j].z) * rn * g1.y); o.w = pg8::cvt_pk_bf16(pg8::bflo(ov[j].w) * rn * g1.z, pg8::bfhi(ov[j].w) * rn * g1.w); *(u32x4*)(op + 8 * j) = o; } } while (0)
#define HG_STEP(n_, QC, FC, VC, DC, QN, FN, VN, DN, DO_NORM) do { const int n = (n_); \
            HG_LOAD(n + 2, QN, FN, VN, DN); \
            if (DO_NORM) HG_NORM(n); \
            LAS unsigned char* sb = lds + ((n + 1) & 1) * HSET; \
            _Pragma("unroll") for (int j = 0; j < 4; ++j) { *(LAS u32x4*)(sb + HQD + lq + 4 * j * HROW) = QC[j]; *(LAS u32x4*)(sb + HKI + (crow + 4 * j) * HKROW + ((cch ^ (4 * (lane >> 4) + j)) << 4)) = FC[j]; *(LAS u32x4*)(sb + HV + lv + 4 * j * HVROW) = VC[j]; } \
            if (lane < 8) *(LAS f32x4*)(lds + ((n + 1) & 1) * HSET + HDEC + (32 * pw + 4 * lane) * 4) = DC; \
            RAW_BAR();                                                          \
        } while (0)
        HG_LOAD(0, qA, fA, vA, dA);
        HG_STEP(-1, qA, fA, vA, dA, qB, fB, vB, dB, false);
        HG_STEP(0, qB, fB, vB, dB, qA, fA, vA, dA, false);
#pragma unroll 1
        for (int n2 = 1; n2 < NCH - 1; n2 += 2) {
            HG_STEP(n2, qA, fA, vA, dA, qB, fB, vB, dB, true);
            HG_STEP(n2 + 1, qB, fB, vB, dB, qA, fA, vA, dA, true);
        }
        HG_STEP(NCH - 1, qA, fA, vA, dA, qB, fB, vB, dB, true);
        HG_NORM(NCH);
#undef HG_LOAD
#undef HG_NORM
#undef HG_STEP
    }
    __syncthreads();
}

template <int W, int RWS> __device__ __forceinline__ void pool_task(const bf16_t* up, bf16_t* op, const float* scp, int tl0) {
    constexpr int NH = W - 1;
    u32x4 R[NH + RWS];
    const f32x4 sc0 = *(const f32x4*)scp, sc1 = *(const f32x4*)(scp + 4);
#pragma unroll
    for (int i = 0; i < NH; ++i) { const int d = NH - i; const bool ok = (tl0 - d >= 0); const u32x4 v = *(const u32x4*)(up - (long)(ok ? d : 0) * LDU); R[i] = ok ? v : (u32x4){0u, 0u, 0u, 0u}; }
#pragma unroll
    for (int r = 0; r < RWS; ++r) R[NH + r] = *(const u32x4*)(up + (size_t)r * LDU);
    float s[8];
#pragma unroll
    for (int e = 0; e < 8; ++e) s[e] = 0.f;
#pragma unroll
    for (int i = 0; i < NH; ++i) { s[0] += pg8::bflo(R[i].x); s[1] += pg8::bfhi(R[i].x); s[2] += pg8::bflo(R[i].y); s[3] += pg8::bfhi(R[i].y); s[4] += pg8::bflo(R[i].z); s[5] += pg8::bfhi(R[i].z); s[6] += pg8::bflo(R[i].w); s[7] += pg8::bfhi(R[i].w); }
#pragma unroll
    for (int r = 0; r < RWS; ++r) {
        const u32x4 v = R[NH + r];
        const float c[8] = {pg8::bflo(v.x), pg8::bfhi(v.x), pg8::bflo(v.y), pg8::bfhi(v.y), pg8::bflo(v.z), pg8::bfhi(v.z), pg8::bflo(v.w), pg8::bfhi(v.w)};
#pragma unroll
        for (int e = 0; e < 8; ++e) s[e] += c[e];
        if (r >= 1) { const u32x4 o = R[r - 1]; s[0] -= pg8::bflo(o.x); s[1] -= pg8::bfhi(o.x); s[2] -= pg8::bflo(o.y); s[3] -= pg8::bfhi(o.y); s[4] -= pg8::bflo(o.z); s[5] -= pg8::bfhi(o.z); s[6] -= pg8::bflo(o.w); s[7] -= pg8::bfhi(o.w); }
        const int tl = tl0 + r; const float inv = 1.0f / (float)((tl + 1 < W) ? (tl + 1) : W);
        u32x4 o4; o4.x = pk2((s[0] * inv - c[0]) * sc0.x, (s[1] * inv - c[1]) * sc0.y); o4.y = pk2((s[2] * inv - c[2]) * sc0.z, (s[3] * inv - c[3]) * sc0.w);
        o4.z = pk2((s[4] * inv - c[4]) * sc1.x, (s[5] * inv - c[5]) * sc1.y); o4.w = pk2((s[6] * inv - c[6]) * sc1.z, (s[7] * inv - c[7]) * sc1.w);
        *(u32x4*)(op + (size_t)r * LDU) = o4;
    }
}

__global__ void __launch_bounds__(NWAVES * 64, 2) fwd_kernel(Args a) {
    extern __shared__ __attribute__((aligned(16))) unsigned char lds_raw[];
    LAS unsigned char* lds = (LAS unsigned char*)lds_raw;
    volatile LAS unsigned* MISC = (volatile LAS unsigned*)(lds + MISC_OFF);
    const int tid0 = threadIdx.x;
    const int wave_s = __builtin_amdgcn_readfirstlane(tid0 >> 6);
    const int G = gridDim.x, bx = blockIdx.x;
    const int vcu = (G % 8 == 0) ? (bx % 8) * (G / 8) + bx / 8 : bx;
    unsigned char* ws = a.ws;
    unsigned* ctl = (unsigned*)(ws + WS_CTL);
    for (int u = tid0; u < (LDS_BYTES - LDSCTL_OFF) / 4; u += NWAVES * 64) ((LAS unsigned*)(lds + LDSCTL_OFF))[u] = 0u;
    __syncthreads();
    XcdBarrier bar; bar.bar = ctl + CW_BAR; bar.x = 0; bar.st = nullptr;
    const bool multi = (a.ph_hi - a.ph_lo) > 1;
    if (multi) bar = xcd_barrier_post(ctl + CW_BAR, MISC + 8);
#ifdef PROBE_A
    unsigned long long* tsb = (unsigned long long*)(ws + WS_CTL + 65536);
    if (bx == 0 && tid0 == 0) tsb[0] = __builtin_amdgcn_s_memrealtime();
#endif

    bf16_t* Wt_in0 = (bf16_t*)(ws + WS_WIN0); bf16_t* Wt_in1 = (bf16_t*)(ws + WS_WIN1);
    bf16_t* Wt_out0 = (bf16_t*)(ws + WS_WOUT0); bf16_t* Wt_out1 = (bf16_t*)(ws + WS_WOUT1);
    bf16_t* Wt_kv = (bf16_t*)(ws + WS_WKV); bf16_t* Wt_grp = (bf16_t*)(ws + WS_WGRP);
    bf16_t* MEMN = (bf16_t*)(ws + WS_MEMN); bf16_t* KMAT = (bf16_t*)(ws + WS_KMAT); bf16_t* VT = (bf16_t*)(ws + WS_VT);
    bf16_t* H = (bf16_t*)(ws + WS_H); bf16_t* U = (bf16_t*)(ws + WS_U); bf16_t* BR0 = (bf16_t*)(ws + WS_BR0); bf16_t* WUBF = (bf16_t*)(ws + WS_WUBF); bf16_t* P1 = (bf16_t*)(ws + WS_P1);
    float* SSQ1 = (float*)(ws + WS_CTL + 262144);
    float* OMLB = (float*)(ws + WS_CTL + 393216);
    float* SSQ2 = (float*)(ws + WS_CTL + 458752);
    const int NGW = G * NWAVES;

    for (int p = a.ph_lo, sub = 0; p < a.ph_hi; ) {
        if (p == 6 || p == 11) { ++p; continue; }
#ifdef REPEAT_MASK
        const int nrep = ((REPEAT_MASK >> p) & 1) ? 2 : 1;
        for (int rep = 0; rep < nrep; ++rep) {
        const bool dummy = (rep + 1 < nrep);
#else
        constexpr bool dummy = false;
#endif
        int tid = (wave_s << 6) | lane_id_now(); asm volatile("" : "+v"(tid));
        const int lane = tid & 63, wave = __builtin_amdgcn_readfirstlane(tid >> 6), gw = vcu * NWAVES + wave;
        pg8::Job J; J.kind = -1; J.grp_tiles = 1 << 20; J.grp_stride = 0; J.bgrp_tiles = 1 << 20; J.bgrp_stride = 0; J.colscale = nullptr; J.base = nullptr; J.out = nullptr; J.O = nullptr; J.ldc = 0; J.G = G; J.c = bx;
        J.A = nullptr; J.Bt = nullptr; J.lda = 0; J.ldb = 0; J.K = 0; J.M = 0; J.N = 0; J.wgm = 8; J.lbp = OMLB; J.decp = (float*)(ws + WS_DEC); J.rowss = nullptr; J.ssq = nullptr; J.pcnt = nullptr;
        switch (p) {
            case 1: if (bx < 32) { J.kind = 0; J.A = MEMN; J.lda = LDH; J.Bt = Wt_kv; J.ldb = LDH; J.K = DM; J.M = MROWS; J.N = 2048; J.O = KMAT; J.ldc = 2048; J.G = 32; J.c = bx; }
                    else if (bx < 64) { J.kind = 0; J.A = Wt_kv + (size_t)2048 * LDH; J.lda = LDH; J.Bt = MEMN; J.ldb = LDH; J.K = DM; J.M = 2048; J.N = MROWS; J.O = VT; J.ldc = MROWS; J.G = 32; J.c = bx - 32; }
                    else if (bx < 160) { J.kind = 0; J.A = Wt_grp; J.lda = PGRP; J.Bt = WUBF; J.ldb = E_MIX; J.bgrp_tiles = 3; J.bgrp_stride = PGRP; J.K = PGRP; J.M = E_MIX; J.N = DM; J.O = Wt_in0; J.ldc = LDH; J.G = 96; J.c = bx - 64; }
                    break;
            case 2: J.kind = 0; J.A = H; J.lda = LDH; J.Bt = Wt_in0; J.ldb = LDH; J.K = DM; J.M = T; J.N = N0A; J.O = U; J.ldc = LDU; break;
            case 4: J.kind = 2; J.A = H; J.lda = LDH; J.Bt = Wt_in0 + (size_t)N0A * LDH; J.ldb = LDH; J.K = DM; J.M = T; J.N = E_BR; J.O = BR0; J.ldc = LDU; break;
            case 5: J.kind = 5; J.A = BR0; J.lda = LDU; J.Bt = Wt_out0; J.ldb = LDWO; J.K = E_BR; J.M = T; J.N = DM; J.base = a.x; J.O = H; J.ldc = LDH; J.ssq = SSQ1; J.wgm = 4; break;
            case 7: J.kind = 4; J.rowss = SSQ1; J.A = H; J.lda = LDH; J.Bt = Wt_in1; J.ldb = LDH; J.K = DM; J.M = T; J.N = N1A; J.O = P1; J.ldc = LDP; break;
            case 9: J.kind = 2; J.rowss = SSQ1; J.A = H; J.lda = LDH; J.Bt = Wt_in1 + (size_t)N1A * LDH; J.ldb = LDH; J.K = DM; J.M = T; J.N = E_MIX; J.O = P1 + 6144; J.ldc = LDP; break;
            case 10: J.kind = 7; J.A = P1 + 6144; J.lda = LDP; J.Bt = Wt_out1; J.ldb = LDWO; J.K = E_BR; J.M = T; J.N = DM; J.O = H; J.ldc = LDH; J.wgm = 4;
                     J.ssq = SSQ2; J.pcnt = (unsigned*)(ws + WS_CTL + 589824); J.colscale = a.final_g; J.out = a.out; break;
            default: break;
        }
        if (J.kind >= 0) pg8::gemm_phase(lds + RING_OFF, J, tid);

        if (p == 0 || p == 1) {
            LAS float* scr = (LAS float*)(lds + RING_OFF + wave * 16640);
            constexpr int I_IN0 = (DM / 64) * (N0 / 64), I_IN1 = (DM / 64) * (N1 / 64), I_OUT = (E_BR / 64) * (DM / 64), I_KV = (DM / 64) * (2048 / 64), I_GRP = (PGRP / 64) * (PGRP / 64);
            constexpr int NITEMS = I_IN0 + I_IN1 + 2 * I_OUT + 2 * I_KV + 4 * I_GRP;
            const bool listA = (p == 0);
            if (listA) for (int i = bx * (NWAVES * 64) + tid; i < 3072; i += G * NWAVES * 64) OMLB[i] = 1.0f - 1.0f / (1.0f + __expf(a.hgrn_lb[i] - a.hgrn_lb[3072 + i]));
            f32x4 gv[8];
            if (listA) load_gain(a.mem_norm_g, gv, lane); else load_gain(a.norm_g, gv, lane);
            const int nidx = NITEMS + (listA ? MROWS : T);
            int vfirst, vcount, vstride;
            if (listA || G != 256) { vfirst = gw; vcount = 1; vstride = NGW; }
            else { constexpr int SA = 4, SB = 10, SC = 13, TOT = NWAVES * (64 * SA + 96 * SB + 96 * SC);
                vstride = TOT;
                if (bx < 64) { vfirst = (bx * NWAVES + wave) * SA; vcount = SA; }
                else if (bx < 160) { vfirst = 64 * NWAVES * SA + ((bx - 64) * NWAVES + wave) * SB; vcount = SB; }
                else { vfirst = 64 * NWAVES * SA + 96 * NWAVES * SB + ((bx - 160) * NWAVES + wave) * SC; vcount = SC; } }
            for (int vi = 0; vi < vcount; ++vi)
            for (int it = vfirst + vi; it < nidx; it += vstride) {
                if (it >= NITEMS) { const int m = it - NITEMS;
                    if (listA) rms_row_to_bf16(a.mem + (size_t)m * DM, gv, MEMN + (size_t)m * LDH, lane); else rms_row_to_bf16(a.x + (size_t)m * DM, gv, H + (size_t)m * LDH, lane);
                    continue; }
                int r = it;
                if (r < I_IN0) { const int nb = N0 / 64, kb = r / nb, n0 = 64 * (r % nb);
                    if (n0 >= E_MIX) { if (!listA) transpose_item(a.pool_w_in, N0, 64 * kb, n0, Wt_in0, LDH, n0, scr, lane); }
                    else if (listA) {
#pragma unroll
                        for (int j = 0; j < 8; ++j) { const int k = 64 * kb + 8 * j + (lane >> 3); const float* src = a.pool_w_in + (size_t)k * N0 + n0 + 8 * (lane & 7);
                            const f32x4 v0 = *(const f32x4*)src, v1 = *(const f32x4*)(src + 4); u32x4 o; o.x = pk2(v0.x, v0.y); o.y = pk2(v0.z, v0.w); o.z = pk2(v1.x, v1.y); o.w = pk2(v1.z, v1.w);
                            *(u32x4*)(WUBF + (size_t)k * E_MIX + n0 + 8 * (lane & 7)) = o; } }
                    continue; } r -= I_IN0;
                if (r < I_IN1) { if (!listA) { const int nb = N1 / 64, kb = r / nb, n0 = 64 * (r % nb);
                    if (G == 256 && n0 >= N1A && n0 < N1A + E_MIX) continue;
                    const int orow0 = (n0 < 3072) ? (256 * (n0 >> 7) + (n0 & 127)) : (n0 < 6144) ? (256 * ((n0 - 3072) >> 7) + 128 + (n0 & 127)) : n0;
                    transpose_item<true>(a.hgrn_w_in, N1, 64 * kb, n0, Wt_in1, LDH, orow0, scr, lane, a.norm_g + DM); } continue; } r -= I_IN1;
                if (r < 2 * I_OUT) { if (!listA) { const int l = r / I_OUT; r -= l * I_OUT; const int nb = DM / 64, kb = r / nb, n0 = 64 * (r % nb);
                    if (!(l == 1 && G == 256)) transpose_item(a.w_out + (size_t)l * E_BR * DM, DM, 64 * kb, n0, l ? Wt_out1 : Wt_out0, LDWO, n0, scr, lane); } continue; } r -= 2 * I_OUT;
                if (!listA) continue;
                if (r < 2 * I_KV) { const int l = r / I_KV; r -= l * I_KV; const int nb = 2048 / 64, kb = r / nb, n0 = 64 * (r % nb);
                    const int orow0 = (n0 < 1024) ? (l * 1024 + n0) : (2048 + l * 1024 + (n0 - 1024));
                    transpose_item(a.w_kv + (size_t)l * DM * 2048, 2048, 64 * kb, n0, Wt_kv, LDH, orow0, scr, lane); continue; } r -= 2 * I_KV;
                { const int g = r / I_GRP; r -= g * I_GRP; const int nb = PGRP / 64, kb = r / nb, n0 = 64 * (r % nb);
                    transpose_item(a.pool_w_grp + (size_t)g * PGRP * PGRP, PGRP, 64 * kb, n0, Wt_grp, PGRP, g * PGRP + n0, scr, lane); }
            }
        } else if (p == 3 || p == 8) {
            if (p == 3 && sub == (bx & 1)) {
                const int NP = G * NWAVES * 64, me = bx * (NWAVES * 64) + tid;
                constexpr int NCH = PGRP / 8, NT16 = NCH * (T / 16), NT8 = NCH * (T / 8);
                for (int task = me; task < 3 * NT16 + NT8; task += NP) {
                    int grp, rem, rws; if (task < 3 * NT16) { grp = task / NT16; rem = task - grp * NT16; rws = 16; } else { grp = 3; rem = task - 3 * NT16; rws = 8; }
                    const int chl = rem % NCH, rb = rem / NCH, ch = grp * NCH + chl;
                    const int t0 = rb * rws, tl0 = t0 % SEQ;
                    const bf16_t* up = U + (size_t)t0 * LDU + ch * 8; bf16_t* op = BR0 + (size_t)t0 * LDU + ch * 8; const float* scp = a.pool_scale + ch * 8;
                    if (grp == 0) pool_task<2, 16>(up, op, scp, tl0); else if (grp == 1) pool_task<4, 16>(up, op, scp, tl0); else if (grp == 2) pool_task<8, 16>(up, op, scp, tl0); else pool_task<16, 8>(up, op, scp, tl0);
                }
            } else {
            const int layer = (p == 3) ? 0 : 1;
            bf16_t* Q = layer ? (P1 + 9216) : (U + 3072); const int ldq = layer ? LDP : LDU;
#ifndef DBG_MODE
#define DBG_MODE 0
#endif
            if (p == 8 && bx < 96) {
                if (!(dummy && (DBG_MODE & 64))) {
#if defined(REPEAT_MASK) && !(DBG_MODE & 64)
                if (dummy) hgrn_unit(P1, (const float*)(ws + WS_DEC), a.hgrn_norm_g, bx / HG_H, bx % HG_H, lds + RING_OFF, tid, (bf16_t*)(ws + WS_END), E_MIX, 4095);
                else
#endif
                hgrn_unit(P1, (const float*)(ws + WS_DEC), a.hgrn_norm_g, bx / HG_H, bx % HG_H, lds + RING_OFF, tid, P1 + 6144, LDP, -1);
                }
            } else if (!(dummy && (DBG_MODE & 32))) {
                const int u0 = (p == 8) ? (bx - 96) : bx, nu = (p == 8) ? (G - 96) : G;
                bf16_t* Oq = dummy ? (bf16_t*)(ws + WS_END) : (layer ? Q : (BR0 + 3072)); const int ldoq = dummy ? 1024 : ldq;
                for (int unit = u0; unit < (T / 256) * 4; unit += nu) {
                    const int hd = unit & 3, rb = unit >> 2, t0 = rb * 256, b = t0 / SEQ;
                    ca_unit(Q + (size_t)t0 * ldq + hd * 256, Oq + (size_t)t0 * ldoq + hd * 256, ldq, ldoq, KMAT + (size_t)(b * NMEM) * 2048 + layer * 1024 + hd * 256, VT + (size_t)(layer * 1024 + hd * 256) * MROWS + b * NMEM, lds + RING_OFF, tid);
                }
                if (p == 8 && (!dummy || (DBG_MODE & 128))) {
                    asm volatile("s_waitcnt vmcnt(0)" ::: "memory");
                    __syncthreads();
                    pg8::Job J2 = J; J2.kind = 2; J2.rowss = SSQ1; J2.A = H; J2.lda = LDH; J2.Bt = Wt_in1 + (size_t)(N1A + E_MIX) * LDH; J2.ldb = LDH; J2.K = DM; J2.M = T; J2.N = E_CA; J2.O = P1 + 6144 + E_MIX; J2.ldc = LDP; J2.G = G - 96; J2.c = bx - 96; J2.wgm = 0;
                    if (dummy) { J2.O = (bf16_t*)(ws + WS_END); J2.ldc = 1024; }
                    pg8::gemm_phase(lds + RING_OFF, J2, tid);
                    if (G == 256 && bx >= 192 && !dummy) {
                        LAS float* scr = (LAS float*)(lds + RING_OFF + wave * 16640);
                        constexpr int I_OUT1 = (E_BR / 64) * (DM / 64);
                        constexpr int I_GM = (DM / 64) * (E_MIX / 64);
                        for (int r = (bx - 192) * NWAVES + wave; r < I_GM; r += 64 * NWAVES) { const int nb = E_MIX / 64, kb = r / nb, n0 = N1A + 64 * (r % nb);
                            transpose_item<true>(a.hgrn_w_in, N1, 64 * kb, n0, Wt_in1, LDH, n0, scr, lane, a.norm_g + DM); }
                        for (int r = (bx - 192) * NWAVES + wave; r < I_OUT1; r += 64 * NWAVES) { const int nb = DM / 64, kb = r / nb, n0 = 64 * (r % nb);
                            transpose_item(a.w_out + (size_t)E_BR * DM, DM, 64 * kb, n0, Wt_out1, LDWO, n0, scr, lane); }
                    }
                }
            }
            }
        }
#ifdef REPEAT_MASK
        if (rep + 1 < nrep) xcd_barrier(bar, wave_s);
        }
#endif
        if (p == 3 && sub == 0) { sub = 1; continue; }
        sub = 0;
        if (p + 1 < a.ph_hi && p != 10) xcd_barrier(bar, wave_s);
#ifdef PROBE_A
        if (bx == 0 && tid0 == 0) tsb[p + 1] = __builtin_amdgcn_s_memrealtime();
#endif
        ++p;
    }
#ifdef PROBE_A
    if (bx == 0 && tid0 == 0) { float* pv = (float*)(ws + WS_CTL + 131072);
        pv[0] = (float)(tsb[PROBE_A + 1] - tsb[PROBE_A]) * 0.1f; pv[1] = (float)(tsb[PROBE_B + 1] - tsb[PROBE_B]) * 0.1f; }
    xcd_barrier(bar, wave_s);
    { const float* pv = (const float*)(ws + WS_CTL + 131072); const float av = pv[0], bv = pv[1];
      for (size_t i = (size_t)bx * 512 + tid0; i < (size_t)T * DM; i += (size_t)G * 512) a.out[i] = (i == 0) ? av : bv; }
#endif
}

constexpr int N_PHASES = 12;

extern "C" void kernel_launch(void* const* d_in, const int* in_sizes, int n_in, void* d_out, int out_size, void* d_ws, size_t ws_size, hipStream_t stream) {
    static int grid = 0;
    if (grid == 0) {
        if (n_in != 13 || in_sizes[0] != T * DM || out_size != T * DM || ws_size < WS_WUBF + 12 * MiB) {
            fprintf(stderr, "kernel_launch: unexpected shapes / workspace (n_in %d, in0 %d, out %d, ws %zu < %zu); nothing launched\n", n_in, n_in > 0 ? in_sizes[0] : -1, out_size, ws_size, (size_t)WS_END); grid = -1; return; }
        int dev = 0, cus = 0, per_cu = 0;
        if (hipGetDevice(&dev) != hipSuccess || hipDeviceGetAttribute(&cus, hipDeviceAttributeMultiprocessorCount, dev) != hipSuccess) { grid = -1; return; }
        if (hipFuncSetAttribute((const void*)fwd_kernel, hipFuncAttributeMaxDynamicSharedMemorySize, LDS_BYTES) != hipSuccess) { fprintf(stderr, "kernel_launch: hipFuncSetAttribute failed\n"); grid = -1; return; }
        if (hipOccupancyMaxActiveBlocksPerMultiprocessor(&per_cu, (const void*)fwd_kernel, NWAVES * 64, LDS_BYTES) != hipSuccess || per_cu < 1) {
            fprintf(stderr, "kernel_launch: occupancy query reports %d workgroups per CU; nothing launched\n", per_cu); (void)hipGetLastError(); grid = -1; return; }
        grid = cus;
        if (grid != 256) { fprintf(stderr, "kernel_launch: built for 256 CUs (tile orders / panel exchange), found %d\n", grid); grid = -1; return; }
    }
    if (grid < 0) return;
    if (hipMemsetAsync((char*)d_ws + WS_CTL, 0, CTL_ZERO_BYTES, stream) != hipSuccess) return;
    Args a{};
    a.x = (const float*)d_in[0]; a.mem = (const float*)d_in[1]; a.norm_g = (const float*)d_in[2]; a.mem_norm_g = (const float*)d_in[3]; a.w_kv = (const float*)d_in[4]; a.w_out = (const float*)d_in[5];
    a.pool_w_in = (const float*)d_in[6]; a.pool_w_grp = (const float*)d_in[7]; a.pool_scale = (const float*)d_in[8]; a.hgrn_w_in = (const float*)d_in[9]; a.hgrn_lb = (const float*)d_in[10];
    a.hgrn_norm_g = (const float*)d_in[11]; a.final_g = (const float*)d_in[12]; a.out = (float*)d_out; a.ws = (unsigned char*)d_ws;
#if MK_N_LAUNCHES == 1
    a.ph_lo = 0; a.ph_hi = N_PHASES;
    hipLaunchKernelGGL(fwd_kernel, dim3(grid), dim3(NWAVES * 64), LDS_BYTES, stream, a);
#else
    for (int p = 0; p < N_PHASES; ++p) { a.ph_lo = p; a.ph_hi = p + 1; hipLaunchKernelGGL(fwd_kernel, dim3(grid), dim3(NWAVES * 64), LDS_BYTES, stream, a); }
#endif
}
```

```cpp
#include <hip/hip_runtime.h>
#include <cstdio>
#include <cstdint>

#ifndef MK_N_LAUNCHES
#define MK_N_LAUNCHES 1
#endif

#define LAS __attribute__((address_space(3)))
typedef unsigned short bf16_t;
typedef short bf16x8 __attribute__((ext_vector_type(8)));
typedef float f32x4 __attribute__((ext_vector_type(4)));
typedef float f32x2 __attribute__((ext_vector_type(2)));
typedef unsigned u32x4 __attribute__((ext_vector_type(4)));
typedef unsigned u32x2 __attribute__((ext_vector_type(2)));

constexpr int BATCH = 4, SEQ = 4096, DM = 2048, T = BATCH * SEQ;
constexpr int NMEM = 256, MROWS = BATCH * NMEM;
constexpr int E_MIX = 3072, E_CA = 1024, E_BR = 4096;
constexpr int N0 = 8192, N1 = 14336, N0A = 4096, N1A = 10240;
constexpr int LPAD = 64;
constexpr int LDU = N0A + LPAD, LDP = N1A + LPAD, LDWO = E_BR + LPAD, LDH = DM + LPAD;
constexpr int PGRP = 768;
constexpr int HG_H = 24, HG_D = 128;
constexpr float EPS = 1e-6f;

constexpr size_t MiB = 1u << 20;
constexpr size_t WS_CTL = 0, CTL_ZERO_BYTES = 1 * MiB;
constexpr size_t WS_WIN1 = 1 * MiB;
constexpr size_t WS_WOUT1 = 59 * MiB;
constexpr size_t WS_KMAT = 76 * MiB;
constexpr size_t WS_VT = 80 * MiB;
constexpr size_t WS_H = 84 * MiB;
constexpr size_t WS_BIG = 150 * MiB;
constexpr size_t WS_WIN0 = WS_BIG;
constexpr size_t WS_WOUT0 = WS_BIG + 33 * MiB;
constexpr size_t WS_WKV = WS_BIG + 50 * MiB;
constexpr size_t WS_WGRP = WS_BIG + 67 * MiB;
constexpr size_t WS_MEMN = WS_BIG + 72 * MiB;
constexpr size_t WS_U = WS_BIG + 77 * MiB;
constexpr size_t WS_BR0 = WS_BIG + 207 * MiB;
constexpr size_t WS_WUBF = WS_BIG + 337 * MiB;
constexpr size_t WS_P1 = WS_BIG;
constexpr size_t WS_DEC = WS_BIG + 322 * MiB;
constexpr size_t WS_END = WS_DEC + 3 * MiB;
static_assert((size_t)T * LDU * 2 <= 130 * MiB && (size_t)T * LDP * 2 <= 322 * MiB && (size_t)DM * LDWO * 2 <= 17 * MiB && (size_t)N1 * LDH * 2 <= 58 * MiB && (size_t)T * LDH * 2 <= 66 * MiB && (size_t)N0 * LDH * 2 <= 33 * MiB && (size_t)4096 * LDH * 2 <= 17 * MiB && (size_t)MROWS * LDH * 2 <= 5 * MiB, "ws map");

namespace pg8 {
constexpr int BM = 256, BK = 64, HALF = 128, HTB = HALF * BK * 2, STAGE_BYTES = 8 * HTB, NXCD = 8, WGM = 8;
__host__ __device__ __forceinline__ int lds_byte(int r, int c) { const int st = (r >> 4) * 2 + (c >> 5), rr = r & 15, cc = c & 31, ob = rr * 64 + cc * 2; return st * 1024 + (ob ^ (((ob >> 9) & 1) << 5)); }
__host__ __device__ __forceinline__ void stage_rc(int b, int& R, int& C) { const int st = b / 1024, sb = b % 1024, swz = sb ^ (((sb >> 9) & 1) << 5); R = (st >> 1) * 16 + swz / 64; C = (st & 1) * 32 + (swz % 64) / 2; }
__host__ __device__ __forceinline__ int perm32(int rho) { const int n = rho >> 4, i = rho & 15; return 8 * (i >> 2) + 4 * n + (i & 3); }

struct Unit { int pm, pn; };
struct Job {
    const bf16_t* A; const bf16_t* Bt; int lda, ldb, K, M, N, G, c, grp_tiles, grp_stride, bgrp_tiles, bgrp_stride;
    int kind; bf16_t* O; int ldc; const float* colscale; const float* base; float* out;
    int wgm;
    const float* lbp;
    float* decp;
    const float* rowss;
    float* ssq;
    unsigned* pcnt;
};
struct StaticOrder {
    int nM, nN, nwg, G, c, wgm;
    __device__ void init(int M, int N, int G_, int c_, int wgm_) { nM = M / BM; nN = N / BM; nwg = nM * nN; G = G_; c = c_; wgm = wgm_; }
    __device__ bool next(int i, Unit& u) const {
        const long L = (long)i * G + c; if (L >= nwg) return false;
        if (wgm == 0) { u.pm = (int)L / nN; u.pn = (int)L % nN; return true; }
        int wgid = (int)L; { const int q = nwg / NXCD, r = nwg % NXCD, xcd = wgid % NXCD, off = wgid / NXCD; wgid = (xcd < r ? xcd * (q + 1) : r * (q + 1) + (xcd - r) * q) + off; }
        const int nig = wgm * nN, gid = wgid / nig, fm = gid * wgm, gsz = (nM - fm) < wgm ? (nM - fm) : wgm;
        u.pm = fm + ((wgid % nig) % gsz); u.pn = (wgid % nig) / gsz; return true;
    }
};
typedef __bf16 bf16x2_t __attribute__((ext_vector_type(2)));
__device__ __forceinline__ unsigned cvt_pk_bf16(float lo, float hi) { f32x2 v = {lo, hi}; bf16x2_t b = __builtin_convertvector(v, bf16x2_t); return __builtin_bit_cast(unsigned, b); }
__device__ __forceinline__ float bflo(unsigned w) { return __uint_as_float(w << 16); }
__device__ __forceinline__ float bfhi(unsigned w) { return __uint_as_float(w & 0xffff0000u); }
__device__ __forceinline__ float silu_f(float v) { return v * __builtin_amdgcn_rcpf(1.0f + __builtin_amdgcn_exp2f(-1.4426950408889634f * v)); }

#define DPPF(x, ctrl) __builtin_bit_cast(float, __builtin_amdgcn_update_dpp(0, __builtin_bit_cast(int, (x)), (ctrl), 0xF, 0xF, true))
#define DPPF1(x, ctrl) __builtin_bit_cast(float, __builtin_amdgcn_update_dpp(0x3f800000, __builtin_bit_cast(int, (x)), (ctrl), 0xF, 0xF, false))
__device__ __forceinline__ float xl_sum16(float v) { const auto r = __builtin_amdgcn_permlane16_swap(__builtin_bit_cast(unsigned, v), __builtin_bit_cast(unsigned, v), false, false); return __builtin_bit_cast(float, (unsigned)r[0]) + __builtin_bit_cast(float, (unsigned)r[1]); }
__device__ __forceinline__ float xl_sum32(float v) { const auto r = __builtin_amdgcn_permlane32_swap(__builtin_bit_cast(unsigned, v), __builtin_bit_cast(unsigned, v), false, false); return __builtin_bit_cast(float, (unsigned)r[0]) + __builtin_bit_cast(float, (unsigned)r[1]); }
__device__ __forceinline__ float xl_max16(float v) { const auto r = __builtin_amdgcn_permlane16_swap(__builtin_bit_cast(unsigned, v), __builtin_bit_cast(unsigned, v), false, false); return fmaxf(__builtin_bit_cast(float, (unsigned)r[0]), __builtin_bit_cast(float, (unsigned)r[1])); }
__device__ __forceinline__ float xl_max32(float v) { const auto r = __builtin_amdgcn_permlane32_swap(__builtin_bit_cast(unsigned, v), __builtin_bit_cast(unsigned, v), false, false); return fmaxf(__builtin_bit_cast(float, (unsigned)r[0]), __builtin_bit_cast(float, (unsigned)r[1])); }
__device__ __forceinline__ float xl_row_sum(float v) { v += DPPF(v, 0xB1); v += DPPF(v, 0x4E); v += DPPF(v, 0x141); v += DPPF(v, 0x140); return v; }
__device__ __forceinline__ float xl_row_max(float v) { v = fmaxf(v, DPPF(v, 0xB1)); v = fmaxf(v, DPPF(v, 0x4E)); v = fmaxf(v, DPPF(v, 0x141)); v = fmaxf(v, DPPF(v, 0x140)); return v; }
__device__ __forceinline__ void epilogue_hgrn(const Job& J, const f32x4 (&acc)[2][2][4][2], const float (&rs)[2][4], const Unit& u, int wr, int wc, int fr, int fq) {
    const int row0 = u.pm * BM + wr * 64 + fr, colh = wc * 32 + 8 * fq;
    f32x4 omlbv[2];
#pragma unroll
    for (int n = 0; n < 2; ++n) omlbv[n] = *(const f32x4*)(J.lbp + u.pn * 128 + colh + 4 * n);
#pragma unroll
    for (int ai = 0; ai < 2; ++ai) {
#pragma unroll
        for (int n = 0; n < 2; ++n) {
            float kk[4][4], P[4][4]; f32x4 dec;
#pragma unroll
            for (int e = 0; e < 4; ++e) { const float omlb = omlbv[n][e]; float carry = 1.0f;
#pragma unroll
                for (int m = 0; m < 4; ++m) {
                    kk[m][e] = omlb * __builtin_amdgcn_rcpf(1.0f + __builtin_amdgcn_exp2f((1.4426950408889634f * rs[ai][m]) * acc[ai][1][m][n][e]));
                    const float f = 1.0f - kk[m][e];
                    float p = f;
                    p *= DPPF1(p, 0x111); p *= DPPF1(p, 0x112); p *= DPPF1(p, 0x114); p *= DPPF1(p, 0x118);
                    const float tot = __builtin_bit_cast(float, __builtin_amdgcn_ds_swizzle(__builtin_bit_cast(int, p), 0x1F0));
                    P[m][e] = p * carry; carry *= tot; }
                dec[e] = carry; }
            if (fr == 0) *(f32x4*)(J.decp + (size_t)((u.pm * BM + ai * HALF + wr * 64) >> 6) * 3072 + u.pn * 128 + colh + 4 * n) = dec;
#pragma unroll
            for (int m = 0; m < 4; ++m) { float qd[4], ki[4];
#pragma unroll
                for (int e = 0; e < 4; ++e) { qd[e] = silu_f(acc[ai][0][m][n][e] * rs[ai][m]) * 0.08838834764831845f * P[m][e]; ki[e] = kk[m][e] * __builtin_amdgcn_rcpf(P[m][e]); }
                bf16_t* rowp = J.O + (size_t)(row0 + ai * HALF + m * 16) * J.ldc + u.pn * BM + colh + 4 * n;
                u32x2 w; w.x = cvt_pk_bf16(qd[0], qd[1]); w.y = cvt_pk_bf16(qd[2], qd[3]); *(u32x2*)rowp = w;
                w.x = cvt_pk_bf16(ki[0], ki[1]); w.y = cvt_pk_bf16(ki[2], ki[3]); *(u32x2*)(rowp + HALF) = w; }
        }
    }
}
__device__ __forceinline__ void epilogue(const Job& J, const f32x4 (&acc)[2][2][4][2], const float (&rs)[2][4], const Unit& u, int wr, int wc, int fr, int fq) {
    if (J.kind == 4 && u.pn < 24) { epilogue_hgrn(J, acc, rs, u, wr, wc, fr, fq); return; }
    if (J.kind == 3) {
        const int row0 = u.pm * BM + wr * 64 + fr, col0 = u.pn * BM + wc * 32 + 4 * fq;
#pragma unroll
        for (int ai = 0; ai < 2; ++ai) {
            f32x4 bs[4][2][2];
#pragma unroll
            for (int m = 0; m < 4; ++m)
#pragma unroll
                for (int bj = 0; bj < 2; ++bj)
#pragma unroll
                    for (int n = 0; n < 2; ++n) bs[m][bj][n] = *(const f32x4*)(J.base + (size_t)(row0 + ai * HALF + m * 16) * J.ldc + col0 + bj * HALF + n * 16);
#pragma unroll
            for (int m = 0; m < 4; ++m)
#pragma unroll
                for (int bj = 0; bj < 2; ++bj)
#pragma unroll
                    for (int n = 0; n < 2; ++n) *(f32x4*)(J.out + (size_t)(row0 + ai * HALF + m * 16) * J.ldc + col0 + bj * HALF + n * 16) = bs[m][bj][n] + acc[ai][bj][m][n];
        }
        return;
    }
    const int row0 = u.pm * BM + wr * 64 + fr, col0 = u.pn * BM + wc * 32 + 8 * fq;
    const __amdgpu_buffer_rsrc_t orsrc = __builtin_amdgcn_make_buffer_rsrc((void*)J.O, 0, 0x7ffffff0, 0x00020000);
    if (J.kind == 5) {
#pragma unroll
        for (int ai = 0; ai < 2; ++ai) {
            f32x4 bs[4][2][2];
#pragma unroll
            for (int m = 0; m < 4; ++m)
#pragma unroll
                for (int bj = 0; bj < 2; ++bj)
#pragma unroll
                    for (int n = 0; n < 2; ++n) bs[m][bj][n] = *(const f32x4*)(J.base + (size_t)(row0 + ai * HALF + m * 16) * 2048 + col0 + bj * HALF + 4 * n);
            float ss[4];
#pragma unroll
            for (int m = 0; m < 4; ++m) { ss[m] = 0.f;
#pragma unroll
                for (int bj = 0; bj < 2; ++bj) { const f32x4 v0 = bs[m][bj][0] + acc[ai][bj][m][0], v1 = bs[m][bj][1] + acc[ai][bj][m][1];
                    ss[m] += (v0[0] * v0[0] + v0[1] * v0[1]) + (v0[2] * v0[2] + v0[3] * v0[3]) + (v1[0] * v1[0] + v1[1] * v1[1]) + (v1[2] * v1[2] + v1[3] * v1[3]);
                    u32x4 w; w.x = cvt_pk_bf16(v0[0], v0[1]); w.y = cvt_pk_bf16(v0[2], v0[3]); w.z = cvt_pk_bf16(v1[0], v1[1]); w.w = cvt_pk_bf16(v1[2], v1[3]);
                    __builtin_amdgcn_raw_buffer_store_b128(w, orsrc, ((unsigned)(row0 + ai * HALF + m * 16) * (unsigned)J.ldc + (unsigned)(col0 + bj * HALF)) * 2u, 0, 16); } }
#pragma unroll
            for (int m = 0; m < 4; ++m) { float t = ss[m]; t = xl_sum16(t); t = xl_sum32(t);
                if (fq == 0) (void)__hip_atomic_fetch_add(J.ssq + row0 + ai * HALF + m * 16, t, __ATOMIC_RELAXED, __HIP_MEMORY_SCOPE_AGENT); }
        }
        return;
    }
    if (J.kind == 6) {
#pragma unroll
        for (int ai = 0; ai < 2; ++ai) {
            u32x4 p[4][2];
#pragma unroll
            for (int m = 0; m < 4; ++m)
#pragma unroll
                for (int bj = 0; bj < 2; ++bj) p[m][bj] = *(const u32x4*)(J.O + (size_t)(row0 + ai * HALF + m * 16) * J.ldc + col0 + bj * HALF);
#pragma unroll
            for (int m = 0; m < 4; ++m)
#pragma unroll
                for (int bj = 0; bj < 2; ++bj) { const f32x4 v0 = acc[ai][bj][m][0], v1 = acc[ai][bj][m][1]; const u32x4 q = p[m][bj]; u32x4 w;
                    w.x = cvt_pk_bf16(bflo(q.x) + v0[0], bfhi(q.x) + v0[1]); w.y = cvt_pk_bf16(bflo(q.y) + v0[2], bfhi(q.y) + v0[3]);
                    w.z = cvt_pk_bf16(bflo(q.z) + v1[0], bfhi(q.z) + v1[1]); w.w = cvt_pk_bf16(bflo(q.w) + v1[2], bfhi(q.w) + v1[3]);
                    *(u32x4*)(J.O + (size_t)(row0 + ai * HALF + m * 16) * J.ldc + col0 + bj * HALF) = w; }
        }
        return;
    }
    if (J.kind == 2) {
#pragma unroll
        for (int ai = 0; ai < 2; ++ai) {
            u32x4 p[4][2];
#pragma unroll
            for (int m = 0; m < 4; ++m)
#pragma unroll
                for (int bj = 0; bj < 2; ++bj) p[m][bj] = *(const u32x4*)(J.O + (size_t)(row0 + ai * HALF + m * 16) * J.ldc + col0 + bj * HALF);
#pragma unroll
            for (int m = 0; m < 4; ++m)
#pragma unroll
                for (int bj = 0; bj < 2; ++bj) { const f32x4 v0 = acc[ai][bj][m][0] * rs[ai][m], v1 = acc[ai][bj][m][1] * rs[ai][m]; const u32x4 q = p[m][bj]; u32x4 w;
                    w.x = cvt_pk_bf16(bflo(q.x) * silu_f(v0[0]), bfhi(q.x) * silu_f(v0[1])); w.y = cvt_pk_bf16(bflo(q.y) * silu_f(v0[2]), bfhi(q.y) * silu_f(v0[3]));
                    w.z = cvt_pk_bf16(bflo(q.z) * silu_f(v1[0]), bfhi(q.z) * silu_f(v1[1])); w.w = cvt_pk_bf16(bflo(q.w) * silu_f(v1[2]), bfhi(q.w) * silu_f(v1[3]));
                    *(u32x4*)(J.O + (size_t)(row0 + ai * HALF + m * 16) * J.ldc + col0 + bj * HALF) = w; }
        }
        return;
    }
    if (J.kind == 1) {
        f32x4 sc[2][2];
#pragma unroll
        for (int bj = 0; bj < 2; ++bj)
#pragma unroll
            for (int n = 0; n < 2; ++n) sc[bj][n] = *(const f32x4*)(J.colscale + col0 + bj * HALF + 4 * n);
#pragma unroll
        for (int ai = 0; ai < 2; ++ai)
#pragma unroll
            for (int m = 0; m < 4; ++m) { bf16_t* rowp = J.O + (size_t)(row0 + ai * HALF + m * 16) * J.ldc + col0;
#pragma unroll
                for (int bj = 0; bj < 2; ++bj) { const f32x4 v0 = acc[ai][bj][m][0] * sc[bj][0], v1 = acc[ai][bj][m][1] * sc[bj][1];
                    u32x4 w; w.x = cvt_pk_bf16(v0[0], v0[1]); w.y = cvt_pk_bf16(v0[2], v0[3]); w.z = cvt_pk_bf16(v1[0], v1[1]); w.w = cvt_pk_bf16(v1[2], v1[3]);
                    *(u32x4*)(rowp + bj * HALF) = w; } }
        return;
    }
#pragma unroll
    for (int ai = 0; ai < 2; ++ai)
#pragma unroll
        for (int m = 0; m < 4; ++m) { const unsigned rowoff = ((unsigned)(row0 + ai * HALF + m * 16) * (unsigned)J.ldc + (unsigned)col0) * 2u;
#pragma unroll
            for (int bj = 0; bj < 2; ++bj) { const f32x4 v0 = acc[ai][bj][m][0] * rs[ai][m], v1 = acc[ai][bj][m][1] * rs[ai][m];
                u32x4 w; w.x = cvt_pk_bf16(v0[0], v0[1]); w.y = cvt_pk_bf16(v0[2], v0[3]); w.z = cvt_pk_bf16(v1[0], v1[1]); w.w = cvt_pk_bf16(v1[2], v1[3]);
                __builtin_amdgcn_raw_buffer_store_b128(w, orsrc, rowoff + bj * (HALF * 2), 0, 16); } }
}

__device__ __forceinline__ void epilogue_final(const Job& J, f32x4 (&acc)[2][2][4][2], const Unit& u, int wid, int wr, int wc, int fr, int fq) {
    const int row0 = u.pm * BM + wr * 64 + fr, col0 = u.pn * BM + wc * 32 + 8 * fq;
    float ss[2][4];
#pragma unroll
    for (int ai = 0; ai < 2; ++ai) {
        u32x4 p[4][2];
#pragma unroll
        for (int m = 0; m < 4; ++m)
#pragma unroll
            for (int bj = 0; bj < 2; ++bj) p[m][bj] = *(const u32x4*)(J.O + (size_t)(row0 + ai * HALF + m * 16) * J.ldc + col0 + bj * HALF);
#pragma unroll
        for (int m = 0; m < 4; ++m) { float t = 0.f;
#pragma unroll
            for (int bj = 0; bj < 2; ++bj) { const u32x4 q = p[m][bj];
                f32x4 v0 = acc[ai][bj][m][0], v1 = acc[ai][bj][m][1];
                v0[0] += bflo(q.x); v0[1] += bfhi(q.x); v0[2] += bflo(q.y); v0[3] += bfhi(q.y); v1[0] += bflo(q.z); v1[1] += bfhi(q.z); v1[2] += bflo(q.w); v1[3] += bfhi(q.w);
                t += (v0[0] * v0[0] + v0[1] * v0[1]) + (v0[2] * v0[2] + v0[3] * v0[3]) + (v1[0] * v1[0] + v1[1] * v1[1]) + (v1[2] * v1[2] + v1[3] * v1[3]);
                acc[ai][bj][m][0] = v0; acc[ai][bj][m][1] = v1; }
            ss[ai][m] = t; }
    }
#pragma unroll
    for (int ai = 0; ai < 2; ++ai)
#pragma unroll
        for (int m = 0; m < 4; ++m) { const float t = xl_sum32(xl_sum16(ss[ai][m]));
            if (fq == 0) (void)__hip_atomic_fetch_add(J.ssq + row0 + ai * HALF + m * 16, t, __ATOMIC_RELAXED, __HIP_MEMORY_SCOPE_AGENT); }
    asm volatile("s_waitcnt vmcnt(0)" ::: "memory");
    __builtin_amdgcn_s_barrier();
    if (wid == 0 && fr == 0 && fq == 0) {
        unsigned* pc = J.pcnt + u.pm;
        (void)__hip_atomic_fetch_add(pc, 1u, __ATOMIC_RELAXED, __HIP_MEMORY_SCOPE_AGENT);
        unsigned sp = 0u;
        while (__hip_atomic_load(pc, __ATOMIC_RELAXED, __HIP_MEMORY_SCOPE_AGENT) < 8u) { __builtin_amdgcn_s_sleep(1); if (++sp > (1u << 22)) break; }
    }
    __builtin_amdgcn_s_barrier();
    f32x4 gn[2][2];
#pragma unroll
    for (int bj = 0; bj < 2; ++bj)
#pragma unroll
        for (int n = 0; n < 2; ++n) gn[bj][n] = *(const f32x4*)(J.colscale + col0 + bj * HALF + 4 * n);
#pragma unroll
    for (int ai = 0; ai < 2; ++ai)
#pragma unroll
        for (int m = 0; m < 4; ++m) ss[ai][m] = __hip_atomic_load(J.ssq + row0 + ai * HALF + m * 16, __ATOMIC_RELAXED, __HIP_MEMORY_SCOPE_AGENT);
#pragma unroll
    for (int ai = 0; ai < 2; ++ai)
#pragma unroll
        for (int m = 0; m < 4; ++m) { const float r = 1.0f / sqrtf(ss[ai][m] * (1.f / 2048.f) + 1e-6f);
            float* orow = J.out + (size_t)(row0 + ai * HALF + m * 16) * 2048 + col0;
#pragma unroll
            for (int bj = 0; bj < 2; ++bj) { *(f32x4*)(orow + bj * HALF) = acc[ai][bj][m][0] * r * gn[bj][0]; *(f32x4*)(orow + bj * HALF + 4) = acc[ai][bj][m][1] * r * gn[bj][1]; } }
}

__device__ __forceinline__ void gemm_phase(LAS unsigned char* lds, const Job& J, const int tid) {
    constexpr bool ALIGN_EPI = true;
    const int wid = __builtin_amdgcn_readfirstlane(tid >> 6), lane = tid & 63, wr = wid >> 2, wc = wid & 3, fr = lane & 15, fq = lane >> 4;
    const int K = J.K, nt = K / BK;
    const bool perm = (J.kind != 3);
    StaticOrder S; S.init(J.M, J.N, J.G, J.c, J.wgm);
    unsigned voffA[2], voffB[2];
#pragma unroll
    for (int i = 0; i < 2; ++i) { int R, C; stage_rc(tid * 16 + i * 8192, R, C); const int Rb = perm ? ((R & ~31) + perm32(R & 31)) : R;
        voffA[i] = (unsigned)(R * J.lda + C) * 2u; voffB[i] = (unsigned)(Rb * J.ldb + C) * 2u; }
    const size_t kstep = (size_t)(BK * 2);
    const size_t hstepA = (size_t)HALF * J.lda * 2, hstepB = (size_t)HALF * J.ldb * 2;
    const size_t tstepA = 2 * hstepA, tstepB = 2 * hstepB;
    const unsigned ldsw = (unsigned)wid * 1024u;
    const int aoff = lds_byte(wr * 64 + fr, fq * 8), boff = lds_byte(wc * 32 + fr, fq * 8);
#define PG8_SA(b, h) (((b) * 2 + (h)) * HTB)
#define PG8_SB(b, h) ((4 + (b) * 2 + (h)) * HTB)
#define PG8_STAGE(bufoff, gbase, voff) do { _Pragma("unroll") for (int _i = 0; _i < 2; ++_i) \
        __builtin_amdgcn_global_load_lds((const unsigned*)((const char*)(gbase) + (voff)[_i]), (LAS unsigned*)(lds + (bufoff) + ldsw + _i * 8192), 16, 0, 0); } while (0)
#define PG8_LDA(dst, b, h) do { _Pragma("unroll") for (int m = 0; m < 4; ++m) _Pragma("unroll") for (int k = 0; k < 2; ++k) dst[m][k] = *(const LAS bf16x8*)(lds + PG8_SA(b, h) + aoff + m * 2048 + k * 1024); } while (0)
#define PG8_LDB(dst, b, h) do { _Pragma("unroll") for (int n = 0; n < 2; ++n) _Pragma("unroll") for (int k = 0; k < 2; ++k) dst[n][k] = *(const LAS bf16x8*)(lds + PG8_SB(b, h) + boff + n * 2048 + k * 1024); } while (0)
#define PG8_MMA(ai, bj, At, Bt) do { __builtin_amdgcn_s_setprio(1); _Pragma("unroll") for (int m = 0; m < 4; ++m) _Pragma("unroll") for (int n = 0; n < 2; ++n) _Pragma("unroll") for (int k = 0; k < 2; ++k) \
        acc[ai][bj][m][n] = __builtin_amdgcn_mfma_f32_16x16x32_bf16(Bt[n][k], At[m][k], acc[ai][bj][m][n], 0, 0, 0); __builtin_amdgcn_s_setprio(0); } while (0)
#define PG8_WAIT_V(n) asm volatile("s_waitcnt vmcnt(" #n ")" ::: "memory")
#define PG8_WAIT_L(n) asm volatile("s_waitcnt lgkmcnt(" #n ")" ::: "memory")
#define PG8_BAR __builtin_amdgcn_s_barrier()
#define PG8_SCHED __builtin_amdgcn_sched_barrier(0)
#define PG8_APTR(u) ((const char*)J.A + (size_t)(u).pm * tstepA + (size_t)((u).pn / J.grp_tiles) * (size_t)J.grp_stride * 2)
#define PG8_BPTR(u) ((const char*)J.Bt + (size_t)(u).pn * tstepB + (size_t)((u).pm / J.bgrp_tiles) * (size_t)J.bgrp_stride * 2)
    Unit cur, nxt; int ui = 0;
    if (!S.next(0, cur)) return;
    f32x4 acc[2][2][4][2];
#pragma unroll
    for (int a = 0; a < 2; ++a)
#pragma unroll
        for (int b = 0; b < 2; ++b)
#pragma unroll
            for (int m = 0; m < 4; ++m)
#pragma unroll
                for (int n = 0; n < 2; ++n) acc[a][b][m][n] = (f32x4){0.f, 0.f, 0.f, 0.f};
    bf16x8 At[4][2], B0[2][2], B1[2][2];
    const char* cA = PG8_APTR(cur); const char* cB = PG8_BPTR(cur);
    PG8_STAGE(PG8_SB(0, 0), cB, voffB); PG8_STAGE(PG8_SB(0, 1), cB + hstepB, voffB); PG8_STAGE(PG8_SA(0, 0), cA, voffA); PG8_STAGE(PG8_SA(0, 1), cA + hstepA, voffA);
    if (wr == 1) PG8_BAR;
    PG8_WAIT_V(2); PG8_BAR;
    PG8_STAGE(PG8_SB(1, 0), cB + kstep, voffB); PG8_STAGE(PG8_SA(1, 0), cA + kstep, voffA); PG8_STAGE(PG8_SB(1, 1), cB + hstepB + kstep, voffB);
    PG8_WAIT_V(6); PG8_BAR;
    for (;;) {
        const bool has_next = S.next(ui + 1, nxt);
        const char* nA = has_next ? PG8_APTR(nxt) : cA; const char* nB = has_next ? PG8_BPTR(nxt) : cB;
        for (int t = 0; t < nt; t += 2) {
            const bool last = (t == nt - 2);
            const char* a1 = cA + (size_t)(t + 1) * kstep;
            const char* a2 = last ? nA : cA + (size_t)(t + 2) * kstep; const char* b2 = last ? nB : cB + (size_t)(t + 2) * kstep;
            const char* a3 = a2 + kstep; const char* b3 = b2 + kstep;
            PG8_LDB(B0, 0, 0); PG8_LDB(B1, 0, 1); PG8_SCHED; PG8_LDA(At, 0, 0); PG8_STAGE(PG8_SA(1, 1), a1 + hstepA, voffA);
            PG8_WAIT_V(8); PG8_WAIT_L(0); PG8_BAR; PG8_MMA(0, 0, At, B0); PG8_MMA(0, 1, At, B1); PG8_BAR; PG8_SCHED;
            PG8_LDA(At, 0, 1); PG8_STAGE(PG8_SB(0, 0), b2, voffB); PG8_STAGE(PG8_SB(0, 1), b2 + hstepB, voffB); PG8_STAGE(PG8_SA(0, 0), a2, voffA);
            PG8_WAIT_V(8); PG8_WAIT_L(0); PG8_BAR; PG8_MMA(1, 0, At, B0); PG8_MMA(1, 1, At, B1); PG8_BAR; PG8_SCHED;
            PG8_LDB(B0, 1, 0); PG8_LDB(B1, 1, 1); PG8_SCHED; PG8_LDA(At, 1, 0); PG8_STAGE(PG8_SA(0, 1), a2 + hstepA, voffA);
            PG8_WAIT_V(8); PG8_WAIT_L(0); PG8_BAR; PG8_MMA(0, 0, At, B0); PG8_MMA(0, 1, At, B1); PG8_BAR; PG8_SCHED;
            PG8_LDA(At, 1, 1); PG8_STAGE(PG8_SB(1, 0), b3, voffB); PG8_STAGE(PG8_SB(1, 1), b3 + hstepB, voffB); PG8_STAGE(PG8_SA(1, 0), a3, voffA);
            PG8_WAIT_V(8); PG8_WAIT_L(0); PG8_BAR; PG8_MMA(1, 0, At, B0); PG8_MMA(1, 1, At, B1); PG8_BAR; PG8_SCHED;
        }
        if constexpr (ALIGN_EPI) { if (wr == 0) PG8_BAR; }
        int fr_e = fr, fq_e = fq; asm volatile("" : "+v"(fr_e), "+v"(fq_e));
        float rs[2][4];
#pragma unroll
        for (int a = 0; a < 2; ++a)
#pragma unroll
            for (int m = 0; m < 4; ++m) rs[a][m] = 0.f;
        if (J.rowss != nullptr) {
#pragma unroll
            for (int a = 0; a < 2; ++a)
#pragma unroll
                for (int m = 0; m < 4; ++m) rs[a][m] = J.rowss[cur.pm * BM + wr * 64 + fr_e + a * HALF + m * 16];
        }
#pragma unroll
        for (int a = 0; a < 2; ++a)
#pragma unroll
            for (int m = 0; m < 4; ++m) rs[a][m] = (J.rowss != nullptr) ? 1.0f / sqrtf(rs[a][m] * (1.f / 2048.f) + 1e-6f) : 1.0f;
        if (J.kind == 7) epilogue_final(J, acc, cur, wid, wr, wc, fr_e, fq_e); else epilogue(J, acc, rs, cur, wr, wc, fr_e, fq_e);
        if (!has_next) break;
#pragma unroll
        for (int a = 0; a < 2; ++a)
#pragma unroll
            for (int b = 0; b < 2; ++b)
#pragma unroll
                for (int m = 0; m < 4; ++m)
#pragma unroll
                    for (int n = 0; n < 2; ++n) acc[a][b][m][n] = (f32x4){0.f, 0.f, 0.f, 0.f};
        cur = nxt; cA = nA; cB = nB; ++ui;
        if constexpr (ALIGN_EPI) { if (wr == 1) PG8_BAR; }
    }
    PG8_WAIT_V(0);
    if constexpr (!ALIGN_EPI) { if (wr == 0) PG8_BAR; }
    PG8_BAR;
#undef PG8_SA
#undef PG8_SB
#undef PG8_STAGE
#undef PG8_LDA
#undef PG8_LDB
#undef PG8_MMA
#undef PG8_WAIT_V
#undef PG8_WAIT_L
#undef PG8_BAR
#undef PG8_SCHED
#undef PG8_APTR
#undef PG8_BPTR
}
}

constexpr int RING_OFF = 0, RING_BYTES = 131072;
constexpr int LDS_BYTES = 163840;
constexpr int LDSCTL_OFF = LDS_BYTES - 1024, MISC_OFF = LDSCTL_OFF + 320;
constexpr int NWAVES = 8;

constexpr int CW_BAR = 4096, CW_SUB = 8192;

#define RLX_AGENT __ATOMIC_RELAXED, __HIP_MEMORY_SCOPE_AGENT
#define LDS_WAIT() asm volatile("s_waitcnt lgkmcnt(0)" ::: "memory")
#define VM_WAIT() asm volatile("s_waitcnt vmcnt(0)" ::: "memory")
__device__ __forceinline__ unsigned f2bf(float f) { unsigned u = __builtin_bit_cast(unsigned, f); return (u + 0x7fffu + ((u >> 16) & 1u)) >> 16; }
__device__ __forceinline__ unsigned pk2(float lo, float hi) { return f2bf(lo) | (f2bf(hi) << 16); }
__device__ __forceinline__ float bf2f(bf16_t b) { return __uint_as_float((unsigned)b << 16); }

#define XB_TMO      128
#define XB_XCNT(j)  (256  + 64 * (j))
#define XB_XSUB(j)  (1280 + 64 * (j))
#define XB_XGEN(j)  (2304 + 64 * (j))
#define XB_TOP      3328
#define XB_TOPGEN   3392
#define XCD_BAR_WORDS 3456
#define XB_SPIN_CAP (1u << 20)

__device__ __forceinline__ unsigned xb_ld(unsigned* p)              { return __hip_atomic_load(p, __ATOMIC_RELAXED, __HIP_MEMORY_SCOPE_AGENT); }
__device__ __forceinline__ unsigned xb_add(unsigned* p, unsigned v) { return __hip_atomic_fetch_add(p, v, __ATOMIC_RELAXED, __HIP_MEMORY_SCOPE_AGENT); }
__device__ __forceinline__ unsigned xb_xcc_id() { return (unsigned)__builtin_amdgcn_s_getreg((3 << 11) | 20) & 0xFu; }
#define XB_SPIN(cond, bar) do { unsigned _sp = 0; while (cond) { __builtin_amdgcn_s_sleep(1); \
    if ((++_sp & 255u) == 0u) { if (xb_ld(&(bar)[XB_TMO])) break; if (_sp > XB_SPIN_CAP) { atomicAdd(&(bar)[XB_TMO], 1u); break; } } } } while (0)

__device__ __forceinline__ int lane_id_now() { int l; asm volatile("v_mbcnt_lo_u32_b32 %0, -1, 0\n\tv_mbcnt_hi_u32_b32 %0, -1, %0" : "=v"(l)); return l; }

struct XcdBarrier { unsigned* bar; unsigned x; volatile LAS unsigned* st; };

__device__ __forceinline__ XcdBarrier xcd_barrier_post(unsigned* bar, volatile LAS unsigned* st) {
    XcdBarrier b; b.bar = bar; b.x = xb_xcc_id(); b.st = st;
    if (threadIdx.x == 0) (void)xb_add(&bar[XB_XCNT(b.x)], 1u);
    return b;
}
__device__ __forceinline__ void xcd_barrier_complete(unsigned* bar, unsigned x, unsigned& nloc, unsigned& nx) {
    const unsigned G = gridDim.x * gridDim.y * gridDim.z;
    unsigned sum, cnt, mine, sp = 0u;
    for (;;) {
        sum = 0u; cnt = 0u; mine = 0u;
#pragma unroll
        for (unsigned j = 0; j < 16; ++j) { const unsigned c = xb_ld(&bar[XB_XCNT(j)]); sum += c; cnt += (c > 0u) ? 1u : 0u; mine = (j == x) ? c : mine; }
        if (sum == G) break;
        __builtin_amdgcn_s_sleep(1);
        if ((++sp & 255u) == 0u) { if (xb_ld(&bar[XB_TMO])) break; if (sp > XB_SPIN_CAP) { atomicAdd(&bar[XB_TMO], 1u); break; } }
    }
    nloc = mine > 0u ? mine : 1u; nx = cnt > 0u ? cnt : 1u;
}
__device__ __forceinline__ void xcd_barrier(const XcdBarrier& b, int wave_s) {
    asm volatile("s_waitcnt vmcnt(0)" ::: "memory");
    __syncthreads();
    if (wave_s == 0 && lane_id_now() == 0) {
        unsigned* bar = b.bar;
        __builtin_amdgcn_s_waitcnt(0);
        unsigned nloc = b.st[0], nx = b.st[1];
        if (nloc == 0u) { xcd_barrier_complete(bar, b.x, nloc, nx); b.st[0] = nloc; b.st[1] = nx; }
        const unsigned old = xb_add(&bar[XB_XSUB(b.x)], 1u);
        const unsigned gen = old / nloc;
        if (old + 1u == (gen + 1u) * nloc) {
            __builtin_amdgcn_fence(__ATOMIC_RELEASE, "agent");
            asm volatile("s_waitcnt vmcnt(0)" ::: "memory");
            const unsigned og = xb_add(&bar[XB_TOP], 1u);
            const unsigned tg = og / nx;
            if (og + 1u == (tg + 1u) * nx) xb_add(&bar[XB_TOPGEN], 1u);
            else XB_SPIN(xb_ld(&bar[XB_TOPGEN]) == tg, bar);
            __builtin_amdgcn_fence(__ATOMIC_ACQUIRE, "agent");
            xb_add(&bar[XB_XGEN(b.x)], 1u);
            asm volatile("s_waitcnt vmcnt(0)" ::: "memory");
        } else {
            __builtin_amdgcn_fence(__ATOMIC_ACQUIRE, "agent");
            XB_SPIN(xb_ld(&bar[XB_XGEN(b.x)]) == gen, bar);
            asm volatile("s_waitcnt vmcnt(0)" ::: "memory");
        }
    }
    __syncthreads();
}

struct Args {
    const float* x; const float* mem; const float* norm_g; const float* mem_norm_g; const float* w_kv; const float* w_out;
    const float* pool_w_in; const float* pool_w_grp; const float* pool_scale; const float* hgrn_w_in; const float* hgrn_lb;
    const float* hgrn_norm_g; const float* final_g; float* out; unsigned char* ws; int ph_lo, ph_hi;
};

__device__ __forceinline__ float wave_sum(float v) { return pg8::xl_sum32(pg8::xl_sum16(pg8::xl_row_sum(v))); }
__device__ __forceinline__ float wave_max(float v) { return pg8::xl_max32(pg8::xl_max16(pg8::xl_row_max(v))); }

template <bool GAIN = false>
__device__ __forceinline__ void transpose_item(const float* W, int N, int k0, int n0, bf16_t* WT, int ldt, int orow0, LAS float* scr, int lane, const float* gk = nullptr) {
    f32x4 v[16]; float gs[16];
    const float* src = W + (size_t)(k0 + (lane >> 4)) * N + n0 + 4 * (lane & 15);
#pragma unroll
    for (int j = 0; j < 16; ++j) v[j] = *(const f32x4*)(src + (size_t)(4 * j) * N);
    if constexpr (GAIN) {
#pragma unroll
        for (int j = 0; j < 16; ++j) gs[j] = gk[k0 + 4 * j + (lane >> 4)];
#pragma unroll
        for (int j = 0; j < 16; ++j) v[j] = v[j] * gs[j];
    }
#pragma unroll
    for (int j = 0; j < 16; ++j) { LAS float* d = scr + (4 * j + (lane >> 4)) * 65 + 4 * (lane & 15); d[0] = v[j].x; d[1] = v[j].y; d[2] = v[j].z; d[3] = v[j].w; }
    LDS_WAIT(); asm volatile("" ::: "memory");
    const int c = lane & 7;
#pragma unroll
    for (int j = 0; j < 8; ++j) { const int n = (lane >> 3) + 8 * j; const LAS float* s = scr + (8 * c) * 65 + n;
        u32x4 o; o.x = pk2(s[0 * 65], s[1 * 65]); o.y = pk2(s[2 * 65], s[3 * 65]); o.z = pk2(s[4 * 65], s[5 * 65]); o.w = pk2(s[6 * 65], s[7 * 65]);
        *(u32x4*)(WT + (size_t)(orow0 + n) * ldt + k0 + 8 * c) = o; }
    LDS_WAIT(); asm volatile("" ::: "memory");
}

__device__ __forceinline__ void rms_row_to_bf16(const float* xrow, const f32x4 (&gv)[8], bf16_t* orow, int lane) {
    const f32x4* xr = (const f32x4*)xrow + lane;
    f32x4 v[8]; float s = 0.f;
#pragma unroll
    for (int j = 0; j < 8; ++j) v[j] = xr[64 * j];
    asm volatile("" ::: "memory");
#pragma unroll
    for (int j = 0; j < 8; ++j) s += (v[j].x * v[j].x + v[j].y * v[j].y) + (v[j].z * v[j].z + v[j].w * v[j].w);
    const float r = 1.0f / sqrtf(wave_sum(s) * (1.f / DM) + EPS);
    unsigned long long* o8 = (unsigned long long*)orow + lane;
#pragma unroll
    for (int j = 0; j < 8; ++j) { const f32x4 gg = gv[j];
        o8[64 * j] = (unsigned long long)pk2(v[j].x * r * gg.x, v[j].y * r * gg.y) | ((unsigned long long)pk2(v[j].z * r * gg.z, v[j].w * r * gg.w) << 32); }
}
__device__ __forceinline__ void rms_row2_to_bf16(const float* x0, const float* x1, const f32x4 (&gv)[8], bf16_t* o0, bf16_t* o1, int lane) {
    const f32x4* xr0 = (const f32x4*)x0 + lane; const f32x4* xr1 = (const f32x4*)x1 + lane;
    f32x4 v0[8], v1[8]; float s0 = 0.f, s1 = 0.f;
#pragma unroll
    for (int j = 0; j < 8; ++j) { v0[j] = xr0[64 * j]; v1[j] = xr1[64 * j]; }
    asm volatile("" ::: "memory");
#pragma unroll
    for (int j = 0; j < 8; ++j) { s0 += (v0[j].x * v0[j].x + v0[j].y * v0[j].y) + (v0[j].z * v0[j].z + v0[j].w * v0[j].w); s1 += (v1[j].x * v1[j].x + v1[j].y * v1[j].y) + (v1[j].z * v1[j].z + v1[j].w * v1[j].w); }
    s0 = wave_sum(s0); s1 = wave_sum(s1);
    const float r0 = 1.0f / sqrtf(s0 * (1.f / DM) + EPS), r1 = 1.0f / sqrtf(s1 * (1.f / DM) + EPS);
    unsigned long long* p0 = (unsigned long long*)o0 + lane; unsigned long long* p1 = (unsigned long long*)o1 + lane;
#pragma unroll
    for (int j = 0; j < 8; ++j) { const f32x4 gg = gv[j];
        p0[64 * j] = (unsigned long long)pk2(v0[j].x * r0 * gg.x, v0[j].y * r0 * gg.y) | ((unsigned long long)pk2(v0[j].z * r0 * gg.z, v0[j].w * r0 * gg.w) << 32);
        p1[64 * j] = (unsigned long long)pk2(v1[j].x * r1 * gg.x, v1[j].y * r1 * gg.y) | ((unsigned long long)pk2(v1[j].z * r1 * gg.z, v1[j].w * r1 * gg.w) << 32); }
}
__device__ __forceinline__ void rms_row_f32(float* xrow, const f32x4 (&gv)[8], int lane) {
    f32x4* xr = (f32x4*)xrow + lane;
    f32x4 v[8]; float s = 0.f;
#pragma unroll
    for (int j = 0; j < 8; ++j) v[j] = xr[64 * j];
    asm volatile("" ::: "memory");
#pragma unroll
    for (int j = 0; j < 8; ++j) s += (v[j].x * v[j].x + v[j].y * v[j].y) + (v[j].z * v[j].z + v[j].w * v[j].w);
    const float r = 1.0f / sqrtf(wave_sum(s) * (1.f / DM) + EPS);
#pragma unroll
    for (int j = 0; j < 8; ++j) { const f32x4 gg = gv[j]; xr[64 * j] = (f32x4){v[j].x * r * gg.x, v[j].y * r * gg.y, v[j].z * r * gg.z, v[j].w * r * gg.w}; }
}
__device__ __forceinline__ void rms_row_bf16_to_f32(const bf16_t* hrow, const f32x4 (&gv)[8], float* orow, int lane) {
    const u32x2* hr = (const u32x2*)hrow + lane;
    u32x2 v[8]; float s = 0.f;
#pragma unroll
    for (int j = 0; j < 8; ++j) v[j] = hr[64 * j];
    asm volatile("" ::: "memory");
    f32x4 f[8];
#pragma unroll
    for (int j = 0; j < 8; ++j) { f[j] = (f32x4){pg8::bflo(v[j].x), pg8::bfhi(v[j].x), pg8::bflo(v[j].y), pg8::bfhi(v[j].y)}; s += (f[j].x * f[j].x + f[j].y * f[j].y) + (f[j].z * f[j].z + f[j].w * f[j].w); }
    const float r = 1.0f / sqrtf(wave_sum(s) * (1.f / DM) + EPS);
    f32x4* o = (f32x4*)orow + lane;
#pragma unroll
    for (int j = 0; j < 8; ++j) { const f32x4 gg = gv[j]; o[64 * j] = (f32x4){f[j].x * r * gg.x, f[j].y * r * gg.y, f[j].z * r * gg.z, f[j].w * r * gg.w}; }
}
__device__ __forceinline__ void rms_row2_bf16_to_f32(const bf16_t* h0, const bf16_t* h1, const f32x4 (&gv)[8], float* o0, float* o1, int lane) {
    const u32x2* hr0 = (const u32x2*)h0 + lane; const u32x2* hr1 = (const u32x2*)h1 + lane;
    u32x2 v0[8], v1[8]; float s0 = 0.f, s1 = 0.f;
#pragma unroll
    for (int j = 0; j < 8; ++j) { v0[j] = hr0[64 * j]; v1[j] = hr1[64 * j]; }
    asm volatile("" ::: "memory");
#pragma unroll
    for (int j = 0; j < 8; ++j) { const float a = pg8::bflo(v0[j].x), b = pg8::bfhi(v0[j].x), c = pg8::bflo(v0[j].y), d = pg8::bfhi(v0[j].y); s0 += (a * a + b * b) + (c * c + d * d);
        const float e = pg8::bflo(v1[j].x), f = pg8::bfhi(v1[j].x), g = pg8::bflo(v1[j].y), h = pg8::bfhi(v1[j].y); s1 += (e * e + f * f) + (g * g + h * h); }
    s0 = wave_sum(s0); s1 = wave_sum(s1);
    const float r0 = 1.0f / sqrtf(s0 * (1.f / DM) + EPS), r1 = 1.0f / sqrtf(s1 * (1.f / DM) + EPS);
    f32x4* p0 = (f32x4*)o0 + lane; f32x4* p1 = (f32x4*)o1 + lane;
#pragma unroll
    for (int j = 0; j < 8; ++j) { const f32x4 gg = gv[j];
        p0[64 * j] = (f32x4){pg8::bflo(v0[j].x) * r0 * gg.x, pg8::bfhi(v0[j].x) * r0 * gg.y, pg8::bflo(v0[j].y) * r0 * gg.z, pg8::bfhi(v0[j].y) * r0 * gg.w};
        p1[64 * j] = (f32x4){pg8::bflo(v1[j].x) * r1 * gg.x, pg8::bfhi(v1[j].x) * r1 * gg.y, pg8::bflo(v1[j].y) * r1 * gg.z, pg8::bfhi(v1[j].y) * r1 * gg.w}; }
}
__device__ __forceinline__ void load_gain(const float* g, f32x4 (&gv)[8], int lane) {
#pragma unroll
    for (int j = 0; j < 8; ++j) gv[j] = *((const f32x4*)g + lane + 64 * j);
}

__device__ __forceinline__ float dot256(const bf16_t* row, const LAS float* vec) {
    float s = 0.f;
#pragma unroll 4
    for (int c = 0; c < 32; ++c) { const u32x4 w = *(const u32x4*)(row + 8 * c); const LAS f32x4* vv = (const LAS f32x4*)(vec + 8 * c); const f32x4 a = vv[0], b = vv[1];
        s += pg8::bflo(w.x) * a.x + pg8::bfhi(w.x) * a.y + pg8::bflo(w.y) * a.z + pg8::bfhi(w.y) * a.w + pg8::bflo(w.z) * b.x + pg8::bfhi(w.z) * b.y + pg8::bflo(w.w) * b.z + pg8::bfhi(w.w) * b.w; }
    return s;
}


typedef float f32x16 __attribute__((ext_vector_type(16)));
typedef short s16x4 __attribute__((ext_vector_type(4)));
#define MFMA32(a, b, c) __builtin_amdgcn_mfma_f32_32x32x16_bf16((a), (b), (c), 0, 0, 0)
__device__ __forceinline__ bf16x8 pack8(const f32x16& x, int s) {
    u32x4 p; p.x = pg8::cvt_pk_bf16(x[8 * s], x[8 * s + 1]); p.y = pg8::cvt_pk_bf16(x[8 * s + 2], x[8 * s + 3]); p.z = pg8::cvt_pk_bf16(x[8 * s + 4], x[8 * s + 5]); p.w = pg8::cvt_pk_bf16(x[8 * s + 6], x[8 * s + 7]);
    return __builtin_bit_cast(bf16x8, p);
}
__device__ __forceinline__ bf16x8 cat44(u32x2 lo, u32x2 hi) { u32x4 p; p.x = lo.x; p.y = lo.y; p.z = hi.x; p.w = hi.y; return __builtin_bit_cast(bf16x8, p); }

constexpr int CAROW = 528, CATILE = 32 * CAROW, CASTG = 2 * CATILE, CASROW = 80;
__device__ __forceinline__ void ca_unit(const bf16_t* Qu  , bf16_t* Ou  , int ldq, int ldo, const bf16_t* Kb  , const bf16_t* Vtb  , LAS unsigned char* lds, int tid) {
    const int lane = tid & 63, w = __builtin_amdgcn_readfirstlane(tid >> 6), r = lane & 31, h = lane >> 5;
    const int srow = tid >> 4, spc = tid & 15;
    bf16x8 qf[16];
#pragma unroll
    for (int ks = 0; ks < 16; ++ks) qf[ks] = *(const bf16x8*)(Qu + (size_t)(32 * w + r) * ldq + 16 * ks + 8 * h);
    u32x4 sr[2][2];
    const __amdgpu_buffer_rsrc_t krs = __builtin_amdgcn_make_buffer_rsrc((void*)Kb, 0, 0x7ffffff0, 0x00020000), vrs = __builtin_amdgcn_make_buffer_rsrc((void*)Vtb, 0, 0x7ffffff0, 0x00020000);
    const unsigned kvo = ((unsigned)srow * 2048u + 16u * spc) * 2u, vvo = ((unsigned)srow * (unsigned)MROWS + 16u * spc) * 2u;
#define CA_LOAD(t) do { if ((t) < 8) { sr[(t) & 1][0] = __builtin_bit_cast(u32x4, __builtin_amdgcn_raw_buffer_load_b128(krs, kvo, (t) * (32 * 2048 * 2), 0)); sr[(t) & 1][1] = __builtin_bit_cast(u32x4, __builtin_amdgcn_raw_buffer_load_b128(krs, kvo + 16u, (t) * (32 * 2048 * 2), 0)); } \
        else { sr[(t) & 1][0] = __builtin_bit_cast(u32x4, __builtin_amdgcn_raw_buffer_load_b128(vrs, vvo, ((t) - 8) * (32 * MROWS * 2), 0)); sr[(t) & 1][1] = __builtin_bit_cast(u32x4, __builtin_amdgcn_raw_buffer_load_b128(vrs, vvo + 16u, ((t) - 8) * (32 * MROWS * 2), 0)); } } while (0)
#define CA_WRITE(t) do { LAS unsigned char* d_ = lds + ((t) & 1) * CATILE + srow * CAROW + 32 * spc; *(LAS u32x4*)d_ = sr[(t) & 1][0]; *(LAS u32x4*)(d_ + 16) = sr[(t) & 1][1]; } while (0)
    CA_LOAD(0); CA_LOAD(1); CA_WRITE(0); CA_LOAD(2);
    __syncthreads();
    f32x16 X[8];
#pragma unroll
    for (int kt = 0; kt < 8; ++kt) {
        if (kt >= 1) CA_LOAD(kt + 2);
#pragma unroll
        for (int i = 0; i < 16; ++i) X[kt][i] = 0.f;
        const LAS unsigned char* kp = lds + (kt & 1) * CATILE + r * CAROW + h * 16;
#pragma unroll
        for (int ks = 0; ks < 16; ++ks) { const bf16x8 a = *(const LAS bf16x8*)(kp + 32 * ks); X[kt] = MFMA32(a, qf[ks], X[kt]); }
        CA_WRITE(kt + 1);
        __syncthreads();
    }
    float mx = -3.0e38f;
#pragma unroll
    for (int kt = 0; kt < 8; ++kt)
#pragma unroll
        for (int i = 0; i < 16; ++i) mx = fmaxf(mx, X[kt][i]);
    mx = pg8::xl_max32(mx);
    const float c = 0.0625f * 1.4426950408889634f; float sm = 0.f;
#pragma unroll
    for (int kt = 0; kt < 8; ++kt)
#pragma unroll
        for (int i = 0; i < 16; ++i) { X[kt][i] = __builtin_amdgcn_exp2f((X[kt][i] - mx) * c); sm += X[kt][i]; }
    sm = pg8::xl_sum32(sm);
    const float inv = 1.0f / sm;
    bf16x8 pa[8][2];
#pragma unroll
    for (int kt = 0; kt < 8; ++kt) {
#pragma unroll
        for (int i = 0; i < 16; ++i) X[kt][i] *= inv;
        pa[kt][0] = pack8(X[kt], 0); pa[kt][1] = pack8(X[kt], 1);
    }
    LAS unsigned char* stg = lds + CASTG + w * (32 * CASROW);
#define CA_PV(dt) do { f32x16 Z; if ((dt) < 6) CA_LOAD(8 + (dt) + 2); \
        _Pragma("unroll") for (int i = 0; i < 16; ++i) Z[i] = 0.f; \
        const LAS unsigned char* vp = lds + ((dt) & 1) * CATILE + r * CAROW + h * 8; \
        _Pragma("unroll") for (int kt = 0; kt < 8; ++kt) _Pragma("unroll") for (int ss = 0; ss < 2; ++ss) { const u32x2 lo = *(const LAS u32x2*)(vp + (32 * kt + 16 * ss) * 2), hi = *(const LAS u32x2*)(vp + (32 * kt + 16 * ss) * 2 + 16); Z = MFMA32(cat44(lo, hi), pa[kt][ss], Z); } \
          \
        _Pragma("unroll") for (int g = 0; g < 4; ++g) { u32x2 o; o.x = pg8::cvt_pk_bf16(Z[4 * g], Z[4 * g + 1]); o.y = pg8::cvt_pk_bf16(Z[4 * g + 2], Z[4 * g + 3]); *(LAS u32x2*)(stg + r * CASROW + (8 * g + 4 * h) * 2) = o; } \
        if ((dt) < 7) CA_WRITE(8 + (dt) + 1);        \
        LDS_WAIT(); asm volatile("" ::: "memory"); \
        { const int q = lane >> 1, hf = lane & 1; const u32x4 v0 = *(const LAS u32x4*)(stg + q * CASROW + 32 * hf), v1 = *(const LAS u32x4*)(stg + q * CASROW + 32 * hf + 16); \
          bf16_t* op = Ou + (size_t)(32 * w + q) * ldo + 32 * (dt) + 16 * hf; *(u32x4*)op = v0; *(u32x4*)(op + 8) = v1; } \
        __syncthreads(); } while (0)
#pragma unroll 1
    for (int d2 = 0; d2 < 8; d2 += 2) { CA_PV(d2); CA_PV(d2 + 1); }
#undef CA_PV
#undef CA_LOAD
#undef CA_WRITE
}

constexpr int HROW = 272, HKROW = 256, HVROW = 320, HQD = 0, HKI = 17408, HV = HKI + 64 * HKROW, HDEC = HV + 64 * HVROW, HSET = HDEC + 512, HOUT = 2 * HSET, HOROW = 272, HOUTB = 64 * HOROW, HNG = HOUT + 2 * HOUTB;
static_assert(HNG + 512 <= LDSCTL_OFF, "hgrn LDS map");
#define RAW_BAR() do { asm volatile("s_waitcnt lgkmcnt(0)" ::: "memory"); __builtin_amdgcn_s_barrier(); asm volatile("" ::: "memory"); } while (0)
typedef short v4i16_t __attribute__((ext_vector_type(4)));
__device__ __forceinline__ u32x2 tr_read(const LAS unsigned char* p) { return __builtin_bit_cast(u32x2, __builtin_amdgcn_ds_read_tr16_b64_v4i16((LAS v4i16_t*)p)); }
__device__ __forceinline__ void hgrn_unit(bf16_t* P1, const float* DECG, const float* hgrn_norm_g, int b, int hh, LAS unsigned char* lds, int tid, bf16_t* Ob, int ldo, int rowmask) {
    const int lane = tid & 63, w = __builtin_amdgcn_readfirstlane(tid >> 6);
    constexpr int NCH = SEQ / 64;
    if (w < 4) {
        const int vt = w, r = lane & 31, h = lane >> 5;
        const int trq = (lane & 15) >> 2, trg = (lane >> 4) & 1, trp = lane & 3;
        const int trlv = trq * HVROW + (16 * trg + 4 * trp) * 2;
        const int kxb = r * HKROW + (((4 * (r & 3) + ((r >> 2) & 3)) ^ h) << 4);
        const int pp = ((trp & 1) << 1) | (trp >> 1);
        int knb[2];
#pragma unroll
        for (int d = 0; d < 2; ++d) knb[d] = (8 * h + 4 * d + trq) * HKROW + (((2 * trg + (pp >> 1)) ^ (4 * trq + 2 * h + d)) << 4) + 8 * (pp & 1);
        f32x16 S[4];
#pragma unroll
        for (int kt = 0; kt < 4; ++kt)
#pragma unroll
            for (int i = 0; i < 16; ++i) S[kt][i] = 0.f;
        RAW_BAR();
#define SB() __builtin_amdgcn_sched_barrier(0)
#define LDX(ks, A0, A1, B0, B1) do { A0 = *(const LAS bf16x8*)(lds + ((pKx) ^ (32 * (ks)))); A1 = *(const LAS bf16x8*)(lds + ((pKx + 32 * HKROW) ^ (32 * (ks)))); B0 = *(const LAS bf16x8*)(pQD + 32 * (ks)); B1 = *(const LAS bf16x8*)(pQD + 32 * HROW + 32 * (ks)); } while (0)
#define MMX(A0, A1, B0, B1) do { X00 = MFMA32(A0, B0, X00); X01 = MFMA32(A0, B1, X01); X11 = MFMA32(A1, B1, X11); } while (0)
#define LDV(ss, st) cat44(tr_read(pVp + (32 * (st) + 16 * (ss)) * HVROW), tr_read(pVp + (32 * (st) + 16 * (ss) + 8) * HVROW))
#define LDQ(j, tt) (*(const LAS bf16x8*)(pQD + 32 * (tt) * HROW + 32 * (j)))
#pragma unroll 1
        for (int n = 0; n < NCH; ++n) {
            const LAS unsigned char* sb = lds + (n & 1) * HSET;
            const int sbo = (n & 1) * HSET, pKx = sbo + HKI + kxb, pKn0 = sbo + HKI + knb[0], pKn1 = sbo + HKI + knb[1];
            const LAS unsigned char* pQD = sb + HQD + r * HROW + h * 16;
            const LAS unsigned char* pVp = sb + HV + trlv + 64 * vt + 4 * h * HVROW;
            const LAS unsigned char* pVn = sb + HV + trlv + 64 * vt + 8 * h * HVROW;
            f32x16 X00, X01, X11;
#pragma unroll
            for (int i = 0; i < 16; ++i) { X00[i] = 0.f; X01[i] = 0.f; X11[i] = 0.f; }
            bf16x8 fa0, fa1, fb0, fb1, ga0, ga1, gb0, gb1;
            LDX(0, fa0, fa1, fb0, fb1); LDX(1, ga0, ga1, gb0, gb1); SB();
            MMX(fa0, fa1, fb0, fb1); SB(); LDX(2, fa0, fa1, fb0, fb1); SB();
            MMX(ga0, ga1, gb0, gb1); SB(); LDX(3, ga0, ga1, gb0, gb1); SB();
            MMX(fa0, fa1, fb0, fb1); SB(); LDX(4, fa0, fa1, fb0, fb1); SB();
            MMX(ga0, ga1, gb0, gb1); SB(); LDX(5, ga0, ga1, gb0, gb1); SB();
            MMX(fa0, fa1, fb0, fb1); SB(); LDX(6, fa0, fa1, fb0, fb1); SB();
            MMX(ga0, ga1, gb0, gb1); SB(); LDX(7, ga0, ga1, gb0, gb1); SB();
            const bf16x8 av00 = LDV(0, 0), av01 = LDV(0, 1), av10 = LDV(1, 0), av11 = LDV(1, 1); SB();
            MMX(fa0, fa1, fb0, fb1); SB();
            bf16x8 q00 = LDQ(0, 0), q01 = LDQ(0, 1), q10 = LDQ(1, 0), q11 = LDQ(1, 1); SB();
            MMX(ga0, ga1, gb0, gb1); SB();
#pragma unroll
            for (int i = 0; i < 16; ++i) { const int sl = (i & 3) + 8 * (i >> 2) + 4 * h; if (sl > r) { X00[i] = 0.f; X11[i] = 0.f; } }
            f32x16 OT0, OT1;
#pragma unroll
            for (int i = 0; i < 16; ++i) { OT0[i] = 0.f; OT1[i] = 0.f; }
            OT0 = MFMA32(av00, pack8(X00, 0), OT0); OT1 = MFMA32(av00, pack8(X01, 0), OT1); OT1 = MFMA32(av01, pack8(X11, 0), OT1);
            OT0 = MFMA32(av10, pack8(X00, 1), OT0); OT1 = MFMA32(av10, pack8(X01, 1), OT1); OT1 = MFMA32(av11, pack8(X11, 1), OT1); SB();
#define INTER(j, QA, QB) do { const bf16x8 sa = pack8(S[(j) >> 1], (j) & 1); OT0 = MFMA32(sa, QA, OT0); OT1 = MFMA32(sa, QB, OT1); } while (0)
            INTER(0, q00, q01); SB(); q00 = LDQ(2, 0); q01 = LDQ(2, 1); SB();
            INTER(1, q10, q11); SB(); q10 = LDQ(3, 0); q11 = LDQ(3, 1); SB();
            INTER(2, q00, q01); SB(); q00 = LDQ(4, 0); q01 = LDQ(4, 1); SB();
            INTER(3, q10, q11); SB(); q10 = LDQ(5, 0); q11 = LDQ(5, 1); SB();
            INTER(4, q00, q01); SB(); q00 = LDQ(6, 0); q01 = LDQ(6, 1); SB();
            INTER(5, q10, q11); SB(); q10 = LDQ(7, 0); q11 = LDQ(7, 1); SB();
            INTER(6, q00, q01); SB();
            bf16x8 bv[4];
#pragma unroll
            for (int ts = 0; ts < 4; ++ts) bv[ts] = cat44(tr_read(pVn + 16 * ts * HVROW), tr_read(pVn + (16 * ts + 4) * HVROW));
            SB(); INTER(7, q10, q11); SB();
            bf16x8 ka[4], kb[4]; f32x4 da[4], db[4];
            const LAS unsigned char* pDC = sb + HDEC + h * 32;
#define LDK(kt, KF, DF) do { _Pragma("unroll") for (int ts = 0; ts < 4; ++ts) KF[ts] = cat44(tr_read(lds + ((pKn0 ^ (64 * (kt))) + 16 * ts * HKROW)), tr_read(lds + ((pKn1 ^ (64 * (kt))) + 16 * ts * HKROW))); _Pragma("unroll") for (int g = 0; g < 4; ++g) DF[g] = *(const LAS f32x4*)(pDC + (32 * (kt) + 16 * (g >> 1) + 4 * (g & 1)) * 4); } while (0)
#define UPD(kt, KF, DF) do { _Pragma("unroll") for (int ts = 0; ts < 4; ++ts) S[kt] = MFMA32(KF[ts], bv[ts], S[kt]); \
                _Pragma("unroll") for (int g = 0; g < 4; ++g) { S[kt][4 * g] *= DF[g].x; S[kt][4 * g + 1] *= DF[g].y; S[kt][4 * g + 2] *= DF[g].z; S[kt][4 * g + 3] *= DF[g].w; } } while (0)
            LDK(0, ka, da); SB();
            { LAS unsigned char* ob = lds + HOUT + (n & 1) * HOUTB;
#pragma unroll
              for (int g = 0; g < 4; ++g) {
                u32x2 o0, o1; o0.x = pg8::cvt_pk_bf16(OT0[4 * g], OT0[4 * g + 1]); o0.y = pg8::cvt_pk_bf16(OT0[4 * g + 2], OT0[4 * g + 3]); o1.x = pg8::cvt_pk_bf16(OT1[4 * g], OT1[4 * g + 1]); o1.y = pg8::cvt_pk_bf16(OT1[4 * g + 2], OT1[4 * g + 3]);
                *(LAS u32x2*)(ob + r * HOROW + (32 * vt + 8 * g + 4 * h) * 2) = o0; *(LAS u32x2*)(ob + (32 + r) * HOROW + (32 * vt + 8 * g + 4 * h) * 2) = o1; } }
            SB();
            LDK(1, kb, db); SB(); UPD(0, ka, da); SB();
            LDK(2, ka, da); SB(); UPD(1, kb, db); SB();
            LDK(3, kb, db); SB(); UPD(2, ka, da); SB();
            UPD(3, kb, db); SB();
            RAW_BAR();
        }
#undef LDX
#undef MMX
#undef LDV
#undef LDQ
#undef INTER
#undef LDK
#undef UPD
#undef SB
    } else {
        const int pw = w - 4;
        const int nt = pw * 64 + lane, nrow = nt >> 2, nq = nt & 3;
        if (pw == 0) { *(LAS f32x2*)(lds + HNG + 8 * lane) = *(const f32x2*)(hgrn_norm_g + hh * 128 + 2 * lane); }
        const __amdgpu_buffer_rsrc_t rs = __builtin_amdgcn_make_buffer_rsrc((void*)P1, 0, (int)((size_t)T * LDP * 2), 0x00020000);
        const int crow = 16 * pw + (lane >> 4), cch = lane & 15;
        const int voff0 = (int)(((size_t)(b * SEQ + crow) * LDP + 256 * hh + 8 * cch) * 2);
        const int vso = (6144 + 128 * hh - 256 * hh) * 2;
        const int lq = crow * HROW + 16 * cch, lv = crow * HVROW + 16 * cch;
        const float* decg = DECG + (size_t)(b * (SEQ / 64)) * 3072 + hh * 128 + 32 * pw + 4 * (lane & 7);
        u32x4 qA[4], fA[4], vA[4], qB[4], fB[4], vB[4]; f32x4 dA, dB;
#define HG_LOAD(c_, QW, FW, VW, DW) do { const int c = ((c_) < NCH) ? (c_) : (NCH - 1); const int so_ = c * (64 * LDP * 2);       \
            DW = *(const f32x4*)(decg + (size_t)c * 3072); _Pragma("unroll") for (int j = 0; j < 4; ++j) { \
            QW[j] = __builtin_bit_cast(u32x4, __builtin_amdgcn_raw_buffer_load_b128(rs, voff0, so_ + 4 * j * (LDP * 2), 0)); FW[j] = __builtin_bit_cast(u32x4, __builtin_amdgcn_raw_buffer_load_b128(rs, voff0, so_ + 4 * j * (LDP * 2) + 256, 0)); \
            VW[j] = __builtin_bit_cast(u32x4, __builtin_amdgcn_raw_buffer_load_b128(rs, voff0, so_ + 4 * j * (LDP * 2) + vso, 0)); } } while (0)
#define HG_NORM(n_) do { u32x4 ov[4]; float ss = 0.f; const LAS unsigned char* ob = lds + HOUT + (((n_) - 1) & 1) * HOUTB; \
            _Pragma("unroll") for (int j = 0; j < 4; ++j) ov[j] = *(const LAS u32x4*)(ob + nrow * HOROW + nq * 64 + 16 * j); \
            _Pragma("unroll") for (int j = 0; j < 4; ++j) { const float x0 = pg8::bflo(ov[j].x), x1 = pg8::bfhi(ov[j].x), x2 = pg8::bflo(ov[j].y), x3 = pg8::bfhi(ov[j].y), x4 = pg8::bflo(ov[j].z), x5 = pg8::bfhi(ov[j].z), x6 = pg8::bflo(ov[j].w), x7 = pg8::bfhi(ov[j].w); \
                ss += (x0 * x0 + x1 * x1) + (x2 * x2 + x3 * x3) + (x4 * x4 + x5 * x5) + (x6 * x6 + x7 * x7); } \
            ss += DPPF(ss, 0xB1); ss += DPPF(ss, 0x4E); \
            const float rn = 1.0f / sqrtf(ss * (1.f / 128.f) + EPS); \
            bf16_t* op = Ob + (size_t)((b * SEQ + ((n_) - 1) * 64 + nrow) & rowmask) * ldo + hh * 128 + 32 * nq; \
            _Pragma("unroll") for (int j = 0; j < 4; ++j) { const f32x4 g0 = *(const LAS f32x4*)(lds + HNG + (32 * nq + 8 * j) * 4), g1 = *(const LAS f32x4*)(lds + HNG + (32 * nq + 8 * j + 4) * 4); u32x4 o; \
                o.x = pg8::cvt_pk_bf16(pg8::bflo(ov[j].x) * rn * g0.x, pg8::bfhi(ov[j].x) * rn * g0.y); o.y = pg8::cvt_pk_bf16(pg8::bflo(ov[j].y) * rn * g0.z, pg8::bfhi(ov[j].y) * rn * g0.w); \
                o.z = pg8::cvt_pk_bf16(pg8::bflo(ov[j].z) * rn * g1.x, pg8::bfhi(ov[j].z) * rn * g1.y); o.w = pg8::cvt_pk_bf16(pg8::bflo(ov[j].w) * rn * g1.z, pg8::bfhi(ov[j].w) * rn * g1.w); *(u32x4*)(op + 8 * j) = o; } } while (0)
#define HG_STEP(n_, QC, FC, VC, DC, QN, FN, VN, DN, DO_NORM) do { const int n = (n_); \
            HG_LOAD(n + 2, QN, FN, VN, DN); \
            if (DO_NORM) HG_NORM(n); \
            LAS unsigned char* sb = lds + ((n + 1) & 1) * HSET; \
            _Pragma("unroll") for (int j = 0; j < 4; ++j) { *(LAS u32x4*)(sb + HQD + lq + 4 * j * HROW) = QC[j]; *(LAS u32x4*)(sb + HKI + (crow + 4 * j) * HKROW + ((cch ^ (4 * (lane >> 4) + j)) << 4)) = FC[j]; *(LAS u32x4*)(sb + HV + lv + 4 * j * HVROW) = VC[j]; } \
            if (lane < 8) *(LAS f32x4*)(lds + ((n + 1) & 1) * HSET + HDEC + (32 * pw + 4 * lane) * 4) = DC; \
            RAW_BAR();                                                          \
        } while (0)
        HG_LOAD(0, qA, fA, vA, dA);
        HG_STEP(-1, qA, fA, vA, dA, qB, fB, vB, dB, false);
        HG_STEP(0, qB, fB, vB, dB, qA, fA, vA, dA, false);
#pragma unroll 1
        for (int n2 = 1; n2 < NCH - 1; n2 += 2) {
            HG_STEP(n2, qA, fA, vA, dA, qB, fB, vB, dB, true);
            HG_STEP(n2 + 1, qB, fB, vB, dB, qA, fA, vA, dA, true);
        }
        HG_STEP(NCH - 1, qA, fA, vA, dA, qB, fB, vB, dB, true);
        HG_NORM(NCH);
#undef HG_LOAD
#undef HG_NORM
#undef HG_STEP
    }
    __syncthreads();
}

template <int W, int RWS> __device__ __forceinline__ void pool_task(const bf16_t* up, bf16_t* op, const float* scp, int tl0) {
    constexpr int NH = W - 1;
    u32x4 R[NH + RWS];
    const f32x4 sc0 = *(const f32x4*)scp, sc1 = *(const f32x4*)(scp + 4);
#pragma unroll
    for (int i = 0; i < NH; ++i) { const int d = NH - i; const bool ok = (tl0 - d >= 0); const u32x4 v = *(const u32x4*)(up - (long)(ok ? d : 0) * LDU); R[i] = ok ? v : (u32x4){0u, 0u, 0u, 0u}; }
#pragma unroll
    for (int r = 0; r < RWS; ++r) R[NH + r] = *(const u32x4*)(up + (size_t)r * LDU);
    float s[8];
#pragma unroll
    for (int e = 0; e < 8; ++e) s[e] = 0.f;
#pragma unroll
    for (int i = 0; i < NH; ++i) { s[0] += pg8::bflo(R[i].x); s[1] += pg8::bfhi(R[i].x); s[2] += pg8::bflo(R[i].y); s[3] += pg8::bfhi(R[i].y); s[4] += pg8::bflo(R[i].z); s[5] += pg8::bfhi(R[i].z); s[6] += pg8::bflo(R[i].w); s[7] += pg8::bfhi(R[i].w); }
#pragma unroll
    for (int r = 0; r < RWS; ++r) {
        const u32x4 v = R[NH + r];
        const float c[8] = {pg8::bflo(v.x), pg8::bfhi(v.x), pg8::bflo(v.y), pg8::bfhi(v.y), pg8::bflo(v.z), pg8::bfhi(v.z), pg8::bflo(v.w), pg8::bfhi(v.w)};
#pragma unroll
        for (int e = 0; e < 8; ++e) s[e] += c[e];
        if (r >= 1) { const u32x4 o = R[r - 1]; s[0] -= pg8::bflo(o.x); s[1] -= pg8::bfhi(o.x); s[2] -= pg8::bflo(o.y); s[3] -= pg8::bfhi(o.y); s[4] -= pg8::bflo(o.z); s[5] -= pg8::bfhi(o.z); s[6] -= pg8::bflo(o.w); s[7] -= pg8::bfhi(o.w); }
        const int tl = tl0 + r; const float inv = 1.0f / (float)((tl + 1 < W) ? (tl + 1) : W);
        u32x4 o4; o4.x = pk2((s[0] * inv - c[0]) * sc0.x, (s[1] * inv - c[1]) * sc0.y); o4.y = pk2((s[2] * inv - c[2]) * sc0.z, (s[3] * inv - c[3]) * sc0.w);
        o4.z = pk2((s[4] * inv - c[4]) * sc1.x, (s[5] * inv - c[5]) * sc1.y); o4.w = pk2((s[6] * inv - c[6]) * sc1.z, (s[7] * inv - c[7]) * sc1.w);
        *(u32x4*)(op + (size_t)r * LDU) = o4;
    }
}

__global__ void __launch_bounds__(NWAVES * 64, 2) fwd_kernel(Args a) {
    extern __shared__ __attribute__((aligned(16))) unsigned char lds_raw[];
    LAS unsigned char* lds = (LAS unsigned char*)lds_raw;
    volatile LAS unsigned* MISC = (volatile LAS unsigned*)(lds + MISC_OFF);
    const int tid0 = threadIdx.x;
    const int wave_s = __builtin_amdgcn_readfirstlane(tid0 >> 6);
    const int G = gridDim.x, bx = blockIdx.x;
    const int vcu = (G % 8 == 0) ? (bx % 8) * (G / 8) + bx / 8 : bx;
    unsigned char* ws = a.ws;
    unsigned* ctl = (unsigned*)(ws + WS_CTL);
    for (int u = tid0; u < (LDS_BYTES - LDSCTL_OFF) / 4; u += NWAVES * 64) ((LAS unsigned*)(lds + LDSCTL_OFF))[u] = 0u;
    __syncthreads();
    XcdBarrier bar; bar.bar = ctl + CW_BAR; bar.x = 0; bar.st = nullptr;
    const bool multi = (a.ph_hi - a.ph_lo) > 1;
    if (multi) bar = xcd_barrier_post(ctl + CW_BAR, MISC + 8);
#ifdef PROBE_A
    unsigned long long* tsb = (unsigned long long*)(ws + WS_CTL + 65536);
    if (bx == 0 && tid0 == 0) tsb[0] = __builtin_amdgcn_s_memrealtime();
#endif

    bf16_t* Wt_in0 = (bf16_t*)(ws + WS_WIN0); bf16_t* Wt_in1 = (bf16_t*)(ws + WS_WIN1);
    bf16_t* Wt_out0 = (bf16_t*)(ws + WS_WOUT0); bf16_t* Wt_out1 = (bf16_t*)(ws + WS_WOUT1);
    bf16_t* Wt_kv = (bf16_t*)(ws + WS_WKV); bf16_t* Wt_grp = (bf16_t*)(ws + WS_WGRP);
    bf16_t* MEMN = (bf16_t*)(ws + WS_MEMN); bf16_t* KMAT = (bf16_t*)(ws + WS_KMAT); bf16_t* VT = (bf16_t*)(ws + WS_VT);
    bf16_t* H = (bf16_t*)(ws + WS_H); bf16_t* U = (bf16_t*)(ws + WS_U); bf16_t* BR0 = (bf16_t*)(ws + WS_BR0); bf16_t* WUBF = (bf16_t*)(ws + WS_WUBF); bf16_t* P1 = (bf16_t*)(ws + WS_P1);
    float* SSQ1 = (float*)(ws + WS_CTL + 262144);
    float* OMLB = (float*)(ws + WS_CTL + 393216);
    float* SSQ2 = (float*)(ws + WS_CTL + 458752);
    const int NGW = G * NWAVES;

    for (int p = a.ph_lo, sub = 0; p < a.ph_hi; ) {
        if (p == 6 || p == 11) { ++p; continue; }
#ifdef REPEAT_MASK
        const int nrep = ((REPEAT_MASK >> p) & 1) ? 2 : 1;
        for (int rep = 0; rep < nrep; ++rep) {
        const bool dummy = (rep + 1 < nrep);
#else
        constexpr bool dummy = false;
#endif
        int tid = (wave_s << 6) | lane_id_now(); asm volatile("" : "+v"(tid));
        const int lane = tid & 63, wave = __builtin_amdgcn_readfirstlane(tid >> 6), gw = vcu * NWAVES + wave;
        pg8::Job J; J.kind = -1; J.grp_tiles = 1 << 20; J.grp_stride = 0; J.bgrp_tiles = 1 << 20; J.bgrp_stride = 0; J.colscale = nullptr; J.base = nullptr; J.out = nullptr; J.O = nullptr; J.ldc = 0; J.G = G; J.c = bx;
        J.A = nullptr; J.Bt = nullptr; J.lda = 0; J.ldb = 0; J.K = 0; J.M = 0; J.N = 0; J.wgm = 8; J.lbp = OMLB; J.decp = (float*)(ws + WS_DEC); J.rowss = nullptr; J.ssq = nullptr; J.pcnt = nullptr;
        switch (p) {
            case 1: if (bx < 32) { J.kind = 0; J.A = MEMN; J.lda = LDH; J.Bt = Wt_kv; J.ldb = LDH; J.K = DM; J.M = MROWS; J.N = 2048; J.O = KMAT; J.ldc = 2048; J.G = 32; J.c = bx; }
                    else if (bx < 64) { J.kind = 0; J.A = Wt_kv + (size_t)2048 * LDH; J.lda = LDH; J.Bt = MEMN; J.ldb = LDH; J.K = DM; J.M = 2048; J.N = MROWS; J.O = VT; J.ldc = MROWS; J.G = 32; J.c = bx - 32; }
                    else if (bx < 160) { J.kind = 0; J.A = Wt_grp; J.lda = PGRP; J.Bt = WUBF; J.ldb = E_MIX; J.bgrp_tiles = 3; J.bgrp_stride = PGRP; J.K = PGRP; J.M = E_MIX; J.N = DM; J.O = Wt_in0; J.ldc = LDH; J.G = 96; J.c = bx - 64; }
                    break;
            case 2: J.kind = 0; J.A = H; J.lda = LDH; J.Bt = Wt_in0; J.ldb = LDH; J.K = DM; J.M = T; J.N = N0A; J.O = U; J.ldc = LDU; break;
            case 4: J.kind = 2; J.A = H; J.lda = LDH; J.Bt = Wt_in0 + (size_t)N0A * LDH; J.ldb = LDH; J.K = DM; J.M = T; J.N = E_BR; J.O = BR0; J.ldc = LDU; break;
            case 5: J.kind = 5; J.A = BR0; J.lda = LDU; J.Bt = Wt_out0; J.ldb = LDWO; J.K = E_BR; J.M = T; J.N = DM; J.base = a.x; J.O = H; J.ldc = LDH; J.ssq = SSQ1; J.wgm = 4; break;
            case 7: J.kind = 4; J.rowss = SSQ1; J.A = H; J.lda = LDH; J.Bt = Wt_in1; J.ldb = LDH; J.K = DM; J.M = T; J.N = N1A; J.O = P1; J.ldc = LDP; break;
            case 9: J.kind = 2; J.rowss = SSQ1; J.A = H; J.lda = LDH; J.Bt = Wt_in1 + (size_t)N1A * LDH; J.ldb = LDH; J.K = DM; J.M = T; J.N = E_MIX; J.O = P1 + 6144; J.ldc = LDP; break;
            case 10: J.kind = 7; J.A = P1 + 6144; J.lda = LDP; J.Bt = Wt_out1; J.ldb = LDWO; J.K = E_BR; J.M = T; J.N = DM; J.O = H; J.ldc = LDH; J.wgm = 4;
                     J.ssq = SSQ2; J.pcnt = (unsigned*)(ws + WS_CTL + 589824); J.colscale = a.final_g; J.out = a.out; break;
            default: break;
        }
        if (J.kind >= 0) pg8::gemm_phase(lds + RING_OFF, J, tid);

        if (p == 0 || p == 1) {
            LAS float* scr = (LAS float*)(lds + RING_OFF + wave * 16640);
            constexpr int I_IN0 = (DM / 64) * (N0 / 64), I_IN1 = (DM / 64) * (N1 / 64), I_OUT = (E_BR / 64) * (DM / 64), I_KV = (DM / 64) * (2048 / 64), I_GRP = (PGRP / 64) * (PGRP / 64);
            constexpr int NITEMS = I_IN0 + I_IN1 + 2 * I_OUT + 2 * I_KV + 4 * I_GRP;
            const bool listA = (p == 0);
            if (listA) for (int i = bx * (NWAVES * 64) + tid; i < 3072; i += G * NWAVES * 64) OMLB[i] = 1.0f - 1.0f / (1.0f + __expf(a.hgrn_lb[i] - a.hgrn_lb[3072 + i]));
            f32x4 gv[8];
            if (listA) load_gain(a.mem_norm_g, gv, lane); else load_gain(a.norm_g, gv, lane);
            const int nidx = NITEMS + (listA ? MROWS : T);
            int vfirst, vcount, vstride;
            if (listA || G != 256) { vfirst = gw; vcount = 1; vstride = NGW; }
            else { constexpr int SA = 4, SB = 10, SC = 13, TOT = NWAVES * (64 * SA + 96 * SB + 96 * SC);
                vstride = TOT;
                if (bx < 64) { vfirst = (bx * NWAVES + wave) * SA; vcount = SA; }
                else if (bx < 160) { vfirst = 64 * NWAVES * SA + ((bx - 64) * NWAVES + wave) * SB; vcount = SB; }
                else { vfirst = 64 * NWAVES * SA + 96 * NWAVES * SB + ((bx - 160) * NWAVES + wave) * SC; vcount = SC; } }
            for (int vi = 0; vi < vcount; ++vi)
            for (int it = vfirst + vi; it < nidx; it += vstride) {
                if (it >= NITEMS) { const int m = it - NITEMS;
                    if (listA) rms_row_to_bf16(a.mem + (size_t)m * DM, gv, MEMN + (size_t)m * LDH, lane); else rms_row_to_bf16(a.x + (size_t)m * DM, gv, H + (size_t)m * LDH, lane);
                    continue; }
                int r = it;
                if (r < I_IN0) { const int nb = N0 / 64, kb = r / nb, n0 = 64 * (r % nb);
                    if (n0 >= E_MIX) { if (!listA) transpose_item(a.pool_w_in, N0, 64 * kb, n0, Wt_in0, LDH, n0, scr, lane); }
                    else if (listA) {
#pragma unroll
                        for (int j = 0; j < 8; ++j) { const int k = 64 * kb + 8 * j + (lane >> 3); const float* src = a.pool_w_in + (size_t)k * N0 + n0 + 8 * (lane & 7);
                            const f32x4 v0 = *(const f32x4*)src, v1 = *(const f32x4*)(src + 4); u32x4 o; o.x = pk2(v0.x, v0.y); o.y = pk2(v0.z, v0.w); o.z = pk2(v1.x, v1.y); o.w = pk2(v1.z, v1.w);
                            *(u32x4*)(WUBF + (size_t)k * E_MIX + n0 + 8 * (lane & 7)) = o; } }
                    continue; } r -= I_IN0;
                if (r < I_IN1) { if (!listA) { const int nb = N1 / 64, kb = r / nb, n0 = 64 * (r % nb);
                    if (G == 256 && n0 >= N1A && n0 < N1A + E_MIX) continue;
                    const int orow0 = (n0 < 3072) ? (256 * (n0 >> 7) + (n0 & 127)) : (n0 < 6144) ? (256 * ((n0 - 3072) >> 7) + 128 + (n0 & 127)) : n0;
                    transpose_item<true>(a.hgrn_w_in, N1, 64 * kb, n0, Wt_in1, LDH, orow0, scr, lane, a.norm_g + DM); } continue; } r -= I_IN1;
                if (r < 2 * I_OUT) { if (!listA) { const int l = r / I_OUT; r -= l * I_OUT; const int nb = DM / 64, kb = r / nb, n0 = 64 * (r % nb);
                    if (!(l == 1 && G == 256)) transpose_item(a.w_out + (size_t)l * E_BR * DM, DM, 64 * kb, n0, l ? Wt_out1 : Wt_out0, LDWO, n0, scr, lane); } continue; } r -= 2 * I_OUT;
                if (!listA) continue;
                if (r < 2 * I_KV) { const int l = r / I_KV; r -= l * I_KV; const int nb = 2048 / 64, kb = r / nb, n0 = 64 * (r % nb);
                    const int orow0 = (n0 < 1024) ? (l * 1024 + n0) : (2048 + l * 1024 + (n0 - 1024));
                    transpose_item(a.w_kv + (size_t)l * DM * 2048, 2048, 64 * kb, n0, Wt_kv, LDH, orow0, scr, lane); continue; } r -= 2 * I_KV;
                { const int g = r / I_GRP; r -= g * I_GRP; const int nb = PGRP / 64, kb = r / nb, n0 = 64 * (r % nb);
                    transpose_item(a.pool_w_grp + (size_t)g * PGRP * PGRP, PGRP, 64 * kb, n0, Wt_grp, PGRP, g * PGRP + n0, scr, lane); }
            }
        } else if (p == 3 || p == 8) {
            if (p == 3 && sub == (bx & 1)) {
                const int NP = G * NWAVES * 64, me = bx * (NWAVES * 64) + tid;
                constexpr int NCH = PGRP / 8, NT16 = NCH * (T / 16), NT8 = NCH * (T / 8);
                for (int task = me; task < 3 * NT16 + NT8; task += NP) {
                    int grp, rem, rws; if (task < 3 * NT16) { grp = task / NT16; rem = task - grp * NT16; rws = 16; } else { grp = 3; rem = task - 3 * NT16; rws = 8; }
                    const int chl = rem % NCH, rb = rem / NCH, ch = grp * NCH + chl;
                    const int t0 = rb * rws, tl0 = t0 % SEQ;
                    const bf16_t* up = U + (size_t)t0 * LDU + ch * 8; bf16_t* op = BR0 + (size_t)t0 * LDU + ch * 8; const float* scp = a.pool_scale + ch * 8;
                    if (grp == 0) pool_task<2, 16>(up, op, scp, tl0); else if (grp == 1) pool_task<4, 16>(up, op, scp, tl0); else if (grp == 2) pool_task<8, 16>(up, op, scp, tl0); else pool_task<16, 8>(up, op, scp, tl0);
                }
            } else {
            const int layer = (p == 3) ? 0 : 1;
            bf16_t* Q = layer ? (P1 + 9216) : (U + 3072); const int ldq = layer ? LDP : LDU;
#ifndef DBG_MODE
#define DBG_MODE 0
#endif
            if (p == 8 && bx < 96) {
                if (!(dummy && (DBG_MODE & 64))) {
#if defined(REPEAT_MASK) && !(DBG_MODE & 64)
                if (dummy) hgrn_unit(P1, (const float*)(ws + WS_DEC), a.hgrn_norm_g, bx / HG_H, bx % HG_H, lds + RING_OFF, tid, (bf16_t*)(ws + WS_END), E_MIX, 4095);
                else
#endif
                hgrn_unit(P1, (const float*)(ws + WS_DEC), a.hgrn_norm_g, bx / HG_H, bx % HG_H, lds + RING_OFF, tid, P1 + 6144, LDP, -1);
                }
            } else if (!(dummy && (DBG_MODE & 32))) {
                const int u0 = (p == 8) ? (bx - 96) : bx, nu = (p == 8) ? (G - 96) : G;
                bf16_t* Oq = dummy ? (bf16_t*)(ws + WS_END) : (layer ? Q : (BR0 + 3072)); const int ldoq = dummy ? 1024 : ldq;
                for (int unit = u0; unit < (T / 256) * 4; unit += nu) {
                    const int hd = unit & 3, rb = unit >> 2, t0 = rb * 256, b = t0 / SEQ;
                    ca_unit(Q + (size_t)t0 * ldq + hd * 256, Oq + (size_t)t0 * ldoq + hd * 256, ldq, ldoq, KMAT + (size_t)(b * NMEM) * 2048 + layer * 1024 + hd * 256, VT + (size_t)(layer * 1024 + hd * 256) * MROWS + b * NMEM, lds + RING_OFF, tid);
                }
                if (p == 8 && (!dummy || (DBG_MODE & 128))) {
                    asm volatile("s_waitcnt vmcnt(0)" ::: "memory");
                    __syncthreads();
                    pg8::Job J2 = J; J2.kind = 2; J2.rowss = SSQ1; J2.A = H; J2.lda = LDH; J2.Bt = Wt_in1 + (size_t)(N1A + E_MIX) * LDH; J2.ldb = LDH; J2.K = DM; J2.M = T; J2.N = E_CA; J2.O = P1 + 6144 + E_MIX; J2.ldc = LDP; J2.G = G - 96; J2.c = bx - 96; J2.wgm = 0;
                    if (dummy) { J2.O = (bf16_t*)(ws + WS_END); J2.ldc = 1024; }
                    pg8::gemm_phase(lds + RING_OFF, J2, tid);
                    if (G == 256 && bx >= 192 && !dummy) {
                        LAS float* scr = (LAS float*)(lds + RING_OFF + wave * 16640);
                        constexpr int I_OUT1 = (E_BR / 64) * (DM / 64);
                        constexpr int I_GM = (DM / 64) * (E_MIX / 64);
                        for (int r = (bx - 192) * NWAVES + wave; r < I_GM; r += 64 * NWAVES) { const int nb = E_MIX / 64, kb = r / nb, n0 = N1A + 64 * (r % nb);
                            transpose_item<true>(a.hgrn_w_in, N1, 64 * kb, n0, Wt_in1, LDH, n0, scr, lane, a.norm_g + DM); }
                        for (int r = (bx - 192) * NWAVES + wave; r < I_OUT1; r += 64 * NWAVES) { const int nb = DM / 64, kb = r / nb, n0 = 64 * (r % nb);
                            transpose_item(a.w_out + (size_t)E_BR * DM, DM, 64 * kb, n0, Wt_out1, LDWO, n0, scr, lane); }
                    }
                }
            }
            }
        }
#ifdef REPEAT_MASK
        if (rep + 1 < nrep) xcd_barrier(bar, wave_s);
        }
#endif
        if (p == 3 && sub == 0) { sub = 1; continue; }
        sub = 0;
        if (p + 1 < a.ph_hi && p != 10) xcd_barrier(bar, wave_s);
#ifdef PROBE_A
        if (bx == 0 && tid0 == 0) tsb[p + 1] = __builtin_amdgcn_s_memrealtime();
#endif
        ++p;
    }
#ifdef PROBE_A
    if (bx == 0 && tid0 == 0) { float* pv = (float*)(ws + WS_CTL + 131072);
        pv[0] = (float)(tsb[PROBE_A + 1] - tsb[PROBE_A]) * 0.1f; pv[1] = (float)(tsb[PROBE_B + 1] - tsb[PROBE_B]) * 0.1f; }
    xcd_barrier(bar, wave_s);
    { const float* pv = (const float*)(ws + WS_CTL + 131072); const float av = pv[0], bv = pv[1];
      for (size_t i = (size_t)bx * 512 + tid0; i < (size_t)T * DM; i += (size_t)G * 512) a.out[i] = (i == 0) ? av : bv; }
#endif
}

constexpr int N_PHASES = 12;

extern "C" void kernel_launch(void* const* d_in, const int* in_sizes, int n_in, void* d_out, int out_size, void* d_ws, size_t ws_size, hipStream_t stream) {
    static int grid = 0;
    if (grid == 0) {
        if (n_in != 13 || in_sizes[0] != T * DM || out_size != T * DM || ws_size < WS_WUBF + 12 * MiB) {
            fprintf(stderr, "kernel_launch: unexpected shapes / workspace (n_in %d, in0 %d, out %d, ws %zu < %zu); nothing launched\n", n_in, n_in > 0 ? in_sizes[0] : -1, out_size, ws_size, (size_t)WS_END); grid = -1; return; }
        int dev = 0, cus = 0, per_cu = 0;
        if (hipGetDevice(&dev) != hipSuccess || hipDeviceGetAttribute(&cus, hipDeviceAttributeMultiprocessorCount, dev) != hipSuccess) { grid = -1; return; }
        if (hipFuncSetAttribute((const void*)fwd_kernel, hipFuncAttributeMaxDynamicSharedMemorySize, LDS_BYTES) != hipSuccess) { fprintf(stderr, "kernel_launch: hipFuncSetAttribute failed\n"); grid = -1; return; }
        if (hipOccupancyMaxActiveBlocksPerMultiprocessor(&per_cu, (const void*)fwd_kernel, NWAVES * 64, LDS_BYTES) != hipSuccess || per_cu < 1) {
            fprintf(stderr, "kernel_launch: occupancy query reports %d workgroups per CU; nothing launched\n", per_cu); (void)hipGetLastError(); grid = -1; return; }
        grid = cus;
        if (grid != 256) { fprintf(stderr, "kernel_launch: built for 256 CUs (tile orders / panel exchange), found %d\n", grid); grid = -1; return; }
    }
    if (grid < 0) return;
    if (hipMemsetAsync((char*)d_ws + WS_CTL, 0, CTL_ZERO_BYTES, stream) != hipSuccess) return;
    Args a{};
    a.x = (const float*)d_in[0]; a.mem = (const float*)d_in[1]; a.norm_g = (const float*)d_in[2]; a.mem_norm_g = (const float*)d_in[3]; a.w_kv = (const float*)d_in[4]; a.w_out = (const float*)d_in[5];
    a.pool_w_in = (const float*)d_in[6]; a.pool_w_grp = (const float*)d_in[7]; a.pool_scale = (const float*)d_in[8]; a.hgrn_w_in = (const float*)d_in[9]; a.hgrn_lb = (const float*)d_in[10];
    a.hgrn_norm_g = (const float*)d_in[11]; a.final_g = (const float*)d_in[12]; a.out = (float*)d_out; a.ws = (unsigned char*)d_ws;
#if MK_N_LAUNCHES == 1
    a.ph_lo = 0; a.ph_hi = N_PHASES;
    hipLaunchKernelGGL(fwd_kernel, dim3(grid), dim3(NWAVES * 64), LDS_BYTES, stream, a);
#else
    for (int p = 0; p < N_PHASES; ++p) { a.ph_lo = p; a.ph_hi = p + 1; hipLaunchKernelGGL(fwd_kernel, dim3(grid), dim3(NWAVES * 64), LDS_BYTES, stream, a); }
#endif
}
```

```cpp
#include <hip/hip_runtime.h>
#include <cstdio>
#include <cstdint>

#ifndef MK_N_LAUNCHES
#define MK_N_LAUNCHES 1
#endif

#define LAS __attribute__((address_space(3)))
typedef unsigned short bf16_t;
typedef short bf16x8 __attribute__((ext_vector_type(8)));
typedef float f32x4 __attribute__((ext_vector_type(4)));
typedef float f32x2 __attribute__((ext_vector_type(2)));
typedef unsigned u32x4 __attribute__((ext_vector_type(4)));
typedef unsigned u32x2 __attribute__((ext_vector_type(2)));

constexpr int BATCH = 4, SEQ = 4096, DM = 2048, T = BATCH * SEQ;
constexpr int NMEM = 256, MROWS = BATCH * NMEM;
constexpr int E_MIX = 3072, E_CA = 1024, E_BR = 4096;
constexpr int N0 = 8192, N1 = 14336, N0A = 4096, N1A = 10240;
constexpr int LPAD = 64;
constexpr int LDU = N0A + LPAD, LDP = N1A + LPAD, LDWO = E_BR + LPAD, LDH = DM + LPAD;
constexpr int PGRP = 768;
constexpr int HG_H = 24, HG_D = 128;
constexpr float EPS = 1e-6f;

constexpr size_t MiB = 1u << 20;
constexpr size_t WS_CTL = 0, CTL_ZERO_BYTES = 1 * MiB;
constexpr size_t WS_WIN1 = 1 * MiB;
constexpr size_t WS_WOUT1 = 59 * MiB;
constexpr size_t WS_KMAT = 76 * MiB;
constexpr size_t WS_VT = 80 * MiB;
constexpr size_t WS_H = 84 * MiB;
constexpr size_t WS_BIG = 150 * MiB;
constexpr size_t WS_WIN0 = WS_BIG;
constexpr size_t WS_WOUT0 = WS_BIG + 33 * MiB;
constexpr size_t WS_WKV = WS_BIG + 50 * MiB;
constexpr size_t WS_WGRP = WS_BIG + 67 * MiB;
constexpr size_t WS_MEMN = WS_BIG + 72 * MiB;
constexpr size_t WS_U = WS_BIG + 77 * MiB;
constexpr size_t WS_BR0 = WS_BIG + 207 * MiB;
constexpr size_t WS_WUBF = WS_BIG + 337 * MiB;
constexpr size_t WS_P1 = WS_BIG;
constexpr size_t WS_DEC = WS_BIG + 322 * MiB;
constexpr size_t WS_END = WS_DEC + 3 * MiB;
static_assert((size_t)T * LDU * 2 <= 130 * MiB && (size_t)T * LDP * 2 <= 322 * MiB && (size_t)DM * LDWO * 2 <= 17 * MiB && (size_t)N1 * LDH * 2 <= 58 * MiB && (size_t)T * LDH * 2 <= 66 * MiB && (size_t)N0 * LDH * 2 <= 33 * MiB && (size_t)4096 * LDH * 2 <= 17 * MiB && (size_t)MROWS * LDH * 2 <= 5 * MiB, "ws map");

namespace pg8 {
constexpr int BM = 256, BK = 64, HALF = 128, HTB = HALF * BK * 2, STAGE_BYTES = 8 * HTB, NXCD = 8, WGM = 8;
__host__ __device__ __forceinline__ int lds_byte(int r, int c) { const int st = (r >> 4) * 2 + (c >> 5), rr = r & 15, cc = c & 31, ob = rr * 64 + cc * 2; return st * 1024 + (ob ^ (((ob >> 9) & 1) << 5)); }
__host__ __device__ __forceinline__ void stage_rc(int b, int& R, int& C) { const int st = b / 1024, sb = b % 1024, swz = sb ^ (((sb >> 9) & 1) << 5); R = (st >> 1) * 16 + swz / 64; C = (st & 1) * 32 + (swz % 64) / 2; }
__host__ __device__ __forceinline__ int perm32(int rho) { const int n = rho >> 4, i = rho & 15; return 8 * (i >> 2) + 4 * n + (i & 3); }

struct Unit { int pm, pn; };
struct Job {
    const bf16_t* A; const bf16_t* Bt; int lda, ldb, K, M, N, G, c, grp_tiles, grp_stride, bgrp_tiles, bgrp_stride;
    int kind; bf16_t* O; int ldc; const float* colscale; const float* base; float* out;
    int wgm;
    const float* lbp;
    float* decp;
    const float* rowss;
    float* ssq;
    unsigned* pcnt;
};
struct StaticOrder {
    int nM, nN, nwg, G, c, wgm;
    __device__ void init(int M, int N, int G_, int c_, int wgm_) { nM = M / BM; nN = N / BM; nwg = nM * nN; G = G_; c = c_; wgm = wgm_; }
    __device__ bool next(int i, Unit& u) const {
        const long L = (long)i * G + c; if (L >= nwg) return false;
        if (wgm == 0) { u.pm = (int)L / nN; u.pn = (int)L % nN; return true; }
        int wgid = (int)L; { const int q = nwg / NXCD, r = nwg % NXCD, xcd = wgid % NXCD, off = wgid / NXCD; wgid = (xcd < r ? xcd * (q + 1) : r * (q + 1) + (xcd - r) * q) + off; }
        const int nig = wgm * nN, gid = wgid / nig, fm = gid * wgm, gsz = (nM - fm) < wgm ? (nM - fm) : wgm;
        u.pm = fm + ((wgid % nig) % gsz); u.pn = (wgid % nig) / gsz; return true;
    }
};
typedef __bf16 bf16x2_t __attribute__((ext_vector_type(2)));
__device__ __forceinline__ unsigned cvt_pk_bf16(float lo, float hi) { f32x2 v = {lo, hi}; bf16x2_t b = __builtin_convertvector(v, bf16x2_t); return __builtin_bit_cast(unsigned, b); }
__device__ __forceinline__ float bflo(unsigned w) { return __uint_as_float(w << 16); }
__device__ __forceinline__ float bfhi(unsigned w) { return __uint_as_float(w & 0xffff0000u); }
__device__ __forceinline__ float silu_f(float v) { return v * __builtin_amdgcn_rcpf(1.0f + __builtin_amdgcn_exp2f(-1.4426950408889634f * v)); }

#define DPPF(x, ctrl) __builtin_bit_cast(float, __builtin_amdgcn_update_dpp(0, __builtin_bit_cast(int, (x)), (ctrl), 0xF, 0xF, true))
#define DPPF1(x, ctrl) __builtin_bit_cast(float, __builtin_amdgcn_update_dpp(0x3f800000, __builtin_bit_cast(int, (x)), (ctrl), 0xF, 0xF, false))
__device__ __forceinline__ float xl_sum16(float v) { const auto r = __builtin_amdgcn_permlane16_swap(__builtin_bit_cast(unsigned, v), __builtin_bit_cast(unsigned, v), false, false); return __builtin_bit_cast(float, (unsigned)r[0]) + __builtin_bit_cast(float, (unsigned)r[1]); }
__device__ __forceinline__ float xl_sum32(float v) { const auto r = __builtin_amdgcn_permlane32_swap(__builtin_bit_cast(unsigned, v), __builtin_bit_cast(unsigned, v), false, false); return __builtin_bit_cast(float, (unsigned)r[0]) + __builtin_bit_cast(float, (unsigned)r[1]); }
__device__ __forceinline__ float xl_max16(float v) { const auto r = __builtin_amdgcn_permlane16_swap(__builtin_bit_cast(unsigned, v), __builtin_bit_cast(unsigned, v), false, false); return fmaxf(__builtin_bit_cast(float, (unsigned)r[0]), __builtin_bit_cast(float, (unsigned)r[1])); }
__device__ __forceinline__ float xl_max32(float v) { const auto r = __builtin_amdgcn_permlane32_swap(__builtin_bit_cast(unsigned, v), __builtin_bit_cast(unsigned, v), false, false); return fmaxf(__builtin_bit_cast(float, (unsigned)r[0]), __builtin_bit_cast(float, (unsigned)r[1])); }
__device__ __forceinline__ float xl_row_sum(float v) { v += DPPF(v, 0xB1); v += DPPF(v, 0x4E); v += DPPF(v, 0x141); v += DPPF(v, 0x140); return v; }
__device__ __forceinline__ float xl_row_max(float v) { v = fmaxf(v, DPPF(v, 0xB1)); v = fmaxf(v, DPPF(v, 0x4E)); v = fmaxf(v, DPPF(v, 0x141)); v = fmaxf(v, DPPF(v, 0x140)); return v; }
__device__ __forceinline__ void epilogue_hgrn(const Job& J, const f32x4 (&acc)[2][2][4][2], const float (&rs)[2][4], const Unit& u, int wr, int wc, int fr, int fq) {
    const int row0 = u.pm * BM + wr * 64 + fr, colh = wc * 32 + 8 * fq;
    f32x4 omlbv[2];
#pragma unroll
    for (int n = 0; n < 2; ++n) omlbv[n] = *(const f32x4*)(J.lbp + u.pn * 128 + colh + 4 * n);
#pragma unroll
    for (int ai = 0; ai < 2; ++ai) {
#pragma unroll
        for (int n = 0; n < 2; ++n) {
            float kk[4][4], P[4][4]; f32x4 dec;
#pragma unroll
            for (int e = 0; e < 4; ++e) { const float omlb = omlbv[n][e];
                float pl[4];
#pragma unroll
                for (int m = 0; m < 4; ++m) { kk[m][e] = omlb * __builtin_amdgcn_rcpf(1.0f + __builtin_amdgcn_exp2f((1.4426950408889634f * rs[ai][m]) * acc[ai][1][m][n][e]));
                    const float f = 1.0f - kk[m][e]; pl[m] = (m == 0) ? f : pl[m - 1] * f; }
                float t = pl[3];
                t *= DPPF1(t, 0x111); t *= DPPF1(t, 0x112); t *= DPPF1(t, 0x114); t *= DPPF1(t, 0x118);
                const float ex = DPPF1(t, 0x111);
#pragma unroll
                for (int m = 0; m < 4; ++m) P[m][e] = ex * pl[m];
                dec[e] = __builtin_bit_cast(float, __builtin_amdgcn_ds_swizzle(__builtin_bit_cast(int, t), 0x1F0)); }
            if (fr == 0) *(f32x4*)(J.decp + (size_t)((u.pm * BM + ai * HALF + wr * 64) >> 6) * 3072 + u.pn * 128 + colh + 4 * n) = dec;
#pragma unroll
            for (int m = 0; m < 4; ++m) { float qd[4], ki[4];
#pragma unroll
                for (int e = 0; e < 4; ++e) { qd[e] = silu_f(acc[ai][0][m][n][e] * rs[ai][m]) * 0.08838834764831845f * P[m][e]; ki[e] = kk[m][e] * __builtin_amdgcn_rcpf(P[m][e]); }
                bf16_t* rowp = J.O + (size_t)(row0 - fr + ai * HALF + 4 * fr + m) * J.ldc + u.pn * BM + colh + 4 * n;
                u32x2 w; w.x = cvt_pk_bf16(qd[0], qd[1]); w.y = cvt_pk_bf16(qd[2], qd[3]); *(u32x2*)rowp = w;
                w.x = cvt_pk_bf16(ki[0], ki[1]); w.y = cvt_pk_bf16(ki[2], ki[3]); *(u32x2*)(rowp + HALF) = w; }
        }
    }
}
__device__ __forceinline__ void epilogue(const Job& J, const f32x4 (&acc)[2][2][4][2], const float (&rs)[2][4], const Unit& u, int wr, int wc, int fr, int fq) {
    if (J.kind == 4 && u.pn < 24) { epilogue_hgrn(J, acc, rs, u, wr, wc, fr, fq); return; }
    if (J.kind == 3) {
        const int row0 = u.pm * BM + wr * 64 + fr, col0 = u.pn * BM + wc * 32 + 4 * fq;
#pragma unroll
        for (int ai = 0; ai < 2; ++ai) {
            f32x4 bs[4][2][2];
#pragma unroll
            for (int m = 0; m < 4; ++m)
#pragma unroll
                for (int bj = 0; bj < 2; ++bj)
#pragma unroll
                    for (int n = 0; n < 2; ++n) bs[m][bj][n] = *(const f32x4*)(J.base + (size_t)(row0 + ai * HALF + m * 16) * J.ldc + col0 + bj * HALF + n * 16);
#pragma unroll
            for (int m = 0; m < 4; ++m)
#pragma unroll
                for (int bj = 0; bj < 2; ++bj)
#pragma unroll
                    for (int n = 0; n < 2; ++n) *(f32x4*)(J.out + (size_t)(row0 + ai * HALF + m * 16) * J.ldc + col0 + bj * HALF + n * 16) = bs[m][bj][n] + acc[ai][bj][m][n];
        }
        return;
    }
    const int row0 = u.pm * BM + wr * 64 + fr, col0 = u.pn * BM + wc * 32 + 8 * fq;
    const __amdgpu_buffer_rsrc_t orsrc = __builtin_amdgcn_make_buffer_rsrc((void*)J.O, 0, 0x7ffffff0, 0x00020000);
    if (J.kind == 5) {
#pragma unroll
        for (int ai = 0; ai < 2; ++ai) {
            f32x4 bs[4][2][2];
#pragma unroll
            for (int m = 0; m < 4; ++m)
#pragma unroll
                for (int bj = 0; bj < 2; ++bj)
#pragma unroll
                    for (int n = 0; n < 2; ++n) bs[m][bj][n] = *(const f32x4*)(J.base + (size_t)(row0 + ai * HALF + m * 16) * 2048 + col0 + bj * HALF + 4 * n);
            float ss[4];
#pragma unroll
            for (int m = 0; m < 4; ++m) { ss[m] = 0.f;
#pragma unroll
                for (int bj = 0; bj < 2; ++bj) { const f32x4 v0 = bs[m][bj][0] + acc[ai][bj][m][0], v1 = bs[m][bj][1] + acc[ai][bj][m][1];
                    ss[m] += (v0[0] * v0[0] + v0[1] * v0[1]) + (v0[2] * v0[2] + v0[3] * v0[3]) + (v1[0] * v1[0] + v1[1] * v1[1]) + (v1[2] * v1[2] + v1[3] * v1[3]);
                    u32x4 w; w.x = cvt_pk_bf16(v0[0], v0[1]); w.y = cvt_pk_bf16(v0[2], v0[3]); w.z = cvt_pk_bf16(v1[0], v1[1]); w.w = cvt_pk_bf16(v1[2], v1[3]);
                    __builtin_amdgcn_raw_buffer_store_b128(w, orsrc, ((unsigned)(row0 + ai * HALF + m * 16) * (unsigned)J.ldc + (unsigned)(col0 + bj * HALF)) * 2u, 0, 16); } }
#pragma unroll
            for (int m = 0; m < 4; ++m) { float t = ss[m]; t = xl_sum16(t); t = xl_sum32(t);
                if (fq == 0) (void)__hip_atomic_fetch_add(J.ssq + row0 + ai * HALF + m * 16, t, __ATOMIC_RELAXED, __HIP_MEMORY_SCOPE_AGENT); }
        }
        return;
    }
    if (J.kind == 6) {
#pragma unroll
        for (int ai = 0; ai < 2; ++ai) {
            u32x4 p[4][2];
#pragma unroll
            for (int m = 0; m < 4; ++m)
#pragma unroll
                for (int bj = 0; bj < 2; ++bj) p[m][bj] = *(const u32x4*)(J.O + (size_t)(row0 + ai * HALF + m * 16) * J.ldc + col0 + bj * HALF);
#pragma unroll
            for (int m = 0; m < 4; ++m)
#pragma unroll
                for (int bj = 0; bj < 2; ++bj) { const f32x4 v0 = acc[ai][bj][m][0], v1 = acc[ai][bj][m][1]; const u32x4 q = p[m][bj]; u32x4 w;
                    w.x = cvt_pk_bf16(bflo(q.x) + v0[0], bfhi(q.x) + v0[1]); w.y = cvt_pk_bf16(bflo(q.y) + v0[2], bfhi(q.y) + v0[3]);
                    w.z = cvt_pk_bf16(bflo(q.z) + v1[0], bfhi(q.z) + v1[1]); w.w = cvt_pk_bf16(bflo(q.w) + v1[2], bfhi(q.w) + v1[3]);
                    *(u32x4*)(J.O + (size_t)(row0 + ai * HALF + m * 16) * J.ldc + col0 + bj * HALF) = w; }
        }
        return;
    }
    if (J.kind == 2) {
#pragma unroll
        for (int ai = 0; ai < 2; ++ai) {
            u32x4 p[4][2];
#pragma unroll
            for (int m = 0; m < 4; ++m)
#pragma unroll
                for (int bj = 0; bj < 2; ++bj) p[m][bj] = *(const u32x4*)(J.O + (size_t)(row0 + ai * HALF + m * 16) * J.ldc + col0 + bj * HALF);
#pragma unroll
            for (int m = 0; m < 4; ++m)
#pragma unroll
                for (int bj = 0; bj < 2; ++bj) { const f32x4 v0 = acc[ai][bj][m][0] * rs[ai][m], v1 = acc[ai][bj][m][1] * rs[ai][m]; const u32x4 q = p[m][bj]; u32x4 w;
                    w.x = cvt_pk_bf16(bflo(q.x) * silu_f(v0[0]), bfhi(q.x) * silu_f(v0[1])); w.y = cvt_pk_bf16(bflo(q.y) * silu_f(v0[2]), bfhi(q.y) * silu_f(v0[3]));
                    w.z = cvt_pk_bf16(bflo(q.z) * silu_f(v1[0]), bfhi(q.z) * silu_f(v1[1])); w.w = cvt_pk_bf16(bflo(q.w) * silu_f(v1[2]), bfhi(q.w) * silu_f(v1[3]));
                    *(u32x4*)(J.O + (size_t)(row0 + ai * HALF + m * 16) * J.ldc + col0 + bj * HALF) = w; }
        }
        return;
    }
    if (J.kind == 1) {
        f32x4 sc[2][2];
#pragma unroll
        for (int bj = 0; bj < 2; ++bj)
#pragma unroll
            for (int n = 0; n < 2; ++n) sc[bj][n] = *(const f32x4*)(J.colscale + col0 + bj * HALF + 4 * n);
#pragma unroll
        for (int ai = 0; ai < 2; ++ai)
#pragma unroll
            for (int m = 0; m < 4; ++m) { bf16_t* rowp = J.O + (size_t)(row0 + ai * HALF + m * 16) * J.ldc + col0;
#pragma unroll
                for (int bj = 0; bj < 2; ++bj) { const f32x4 v0 = acc[ai][bj][m][0] * sc[bj][0], v1 = acc[ai][bj][m][1] * sc[bj][1];
                    u32x4 w; w.x = cvt_pk_bf16(v0[0], v0[1]); w.y = cvt_pk_bf16(v0[2], v0[3]); w.z = cvt_pk_bf16(v1[0], v1[1]); w.w = cvt_pk_bf16(v1[2], v1[3]);
                    *(u32x4*)(rowp + bj * HALF) = w; } }
        return;
    }
#pragma unroll
    for (int ai = 0; ai < 2; ++ai)
#pragma unroll
        for (int m = 0; m < 4; ++m) { const int rr = (J.kind == 4) ? (row0 - fr + ai * HALF + 4 * fr + m) : (row0 + ai * HALF + m * 16);
            const unsigned rowoff = ((unsigned)rr * (unsigned)J.ldc + (unsigned)col0) * 2u;
#pragma unroll
            for (int bj = 0; bj < 2; ++bj) { const f32x4 v0 = acc[ai][bj][m][0] * rs[ai][m], v1 = acc[ai][bj][m][1] * rs[ai][m];
                u32x4 w; w.x = cvt_pk_bf16(v0[0], v0[1]); w.y = cvt_pk_bf16(v0[2], v0[3]); w.z = cvt_pk_bf16(v1[0], v1[1]); w.w = cvt_pk_bf16(v1[2], v1[3]);
                __builtin_amdgcn_raw_buffer_store_b128(w, orsrc, rowoff + bj * (HALF * 2), 0, 16); } }
}

__device__ __forceinline__ void epilogue_final(const Job& J, f32x4 (&acc)[2][2][4][2], const Unit& u, int wid, int wr, int wc, int fr, int fq) {
    const int row0 = u.pm * BM + wr * 64 + fr, col0 = u.pn * BM + wc * 32 + 8 * fq;
    float ss[2][4];
#pragma unroll
    for (int ai = 0; ai < 2; ++ai) {
        u32x4 p[4][2];
#pragma unroll
        for (int m = 0; m < 4; ++m)
#pragma unroll
            for (int bj = 0; bj < 2; ++bj) p[m][bj] = *(const u32x4*)(J.O + (size_t)(row0 + ai * HALF + m * 16) * J.ldc + col0 + bj * HALF);
#pragma unroll
        for (int m = 0; m < 4; ++m) { float t = 0.f;
#pragma unroll
            for (int bj = 0; bj < 2; ++bj) { const u32x4 q = p[m][bj];
                f32x4 v0 = acc[ai][bj][m][0], v1 = acc[ai][bj][m][1];
                v0[0] += bflo(q.x); v0[1] += bfhi(q.x); v0[2] += bflo(q.y); v0[3] += bfhi(q.y); v1[0] += bflo(q.z); v1[1] += bfhi(q.z); v1[2] += bflo(q.w); v1[3] += bfhi(q.w);
                t += (v0[0] * v0[0] + v0[1] * v0[1]) + (v0[2] * v0[2] + v0[3] * v0[3]) + (v1[0] * v1[0] + v1[1] * v1[1]) + (v1[2] * v1[2] + v1[3] * v1[3]);
                acc[ai][bj][m][0] = v0; acc[ai][bj][m][1] = v1; }
            ss[ai][m] = t; }
    }
#pragma unroll
    for (int ai = 0; ai < 2; ++ai)
#pragma unroll
        for (int m = 0; m < 4; ++m) { const float t = xl_sum32(xl_sum16(ss[ai][m]));
            if (fq == 0) (void)__hip_atomic_fetch_add(J.ssq + row0 + ai * HALF + m * 16, t, __ATOMIC_RELAXED, __HIP_MEMORY_SCOPE_AGENT); }
    asm volatile("s_waitcnt vmcnt(0)" ::: "memory");
    __builtin_amdgcn_s_barrier();
    if (wid == 0 && fr == 0 && fq == 0) {
        unsigned* pc = J.pcnt + u.pm;
        (void)__hip_atomic_fetch_add(pc, 1u, __ATOMIC_RELAXED, __HIP_MEMORY_SCOPE_AGENT);
        unsigned sp = 0u;
        while (__hip_atomic_load(pc, __ATOMIC_RELAXED, __HIP_MEMORY_SCOPE_AGENT) < 8u) { __builtin_amdgcn_s_sleep(1); if (++sp > (1u << 22)) break; }
    }
    __builtin_amdgcn_s_barrier();
    f32x4 gn[2][2];
#pragma unroll
    for (int bj = 0; bj < 2; ++bj)
#pragma unroll
        for (int n = 0; n < 2; ++n) gn[bj][n] = *(const f32x4*)(J.colscale + col0 + bj * HALF + 4 * n);
#pragma unroll
    for (int ai = 0; ai < 2; ++ai)
#pragma unroll
        for (int m = 0; m < 4; ++m) ss[ai][m] = __hip_atomic_load(J.ssq + row0 + ai * HALF + m * 16, __ATOMIC_RELAXED, __HIP_MEMORY_SCOPE_AGENT);
#pragma unroll
    for (int ai = 0; ai < 2; ++ai)
#pragma unroll
        for (int m = 0; m < 4; ++m) { const float r = 1.0f / sqrtf(ss[ai][m] * (1.f / 2048.f) + 1e-6f);
            float* orow = J.out + (size_t)(row0 + ai * HALF + m * 16) * 2048 + col0;
#pragma unroll
            for (int bj = 0; bj < 2; ++bj) { *(f32x4*)(orow + bj * HALF) = acc[ai][bj][m][0] * r * gn[bj][0]; *(f32x4*)(orow + bj * HALF + 4) = acc[ai][bj][m][1] * r * gn[bj][1]; } }
}

__device__ __forceinline__ void gemm_phase(LAS unsigned char* lds, const Job& J, const int tid) {
    constexpr bool ALIGN_EPI = true;
    const int wid = __builtin_amdgcn_readfirstlane(tid >> 6), lane = tid & 63, wr = wid >> 2, wc = wid & 3, fr = lane & 15, fq = lane >> 4;
    const int K = J.K, nt = K / BK;
    const bool perm = (J.kind != 3);
    StaticOrder S; S.init(J.M, J.N, J.G, J.c, J.wgm);
    unsigned voffA[2], voffB[2];
#pragma unroll
    for (int i = 0; i < 2; ++i) { int R, C; stage_rc(tid * 16 + i * 8192, R, C); const int Rb = perm ? ((R & ~31) + perm32(R & 31)) : R;
        const int Ra = (J.kind == 4) ? ((R & ~63) + 4 * (R & 15) + ((R >> 4) & 3)) : R;
        voffA[i] = (unsigned)(Ra * J.lda + C) * 2u; voffB[i] = (unsigned)(Rb * J.ldb + C) * 2u; }
    const size_t kstep = (size_t)(BK * 2);
    const size_t hstepA = (size_t)HALF * J.lda * 2, hstepB = (size_t)HALF * J.ldb * 2;
    const size_t tstepA = 2 * hstepA, tstepB = 2 * hstepB;
    const unsigned ldsw = (unsigned)wid * 1024u;
    const int aoff = lds_byte(wr * 64 + fr, fq * 8), boff = lds_byte(wc * 32 + fr, fq * 8);
#define PG8_SA(b, h) (((b) * 2 + (h)) * HTB)
#define PG8_SB(b, h) ((4 + (b) * 2 + (h)) * HTB)
#define PG8_STAGE(bufoff, gbase, voff) do { _Pragma("unroll") for (int _i = 0; _i < 2; ++_i) \
        __builtin_amdgcn_global_load_lds((const unsigned*)((const char*)(gbase) + (voff)[_i]), (LAS unsigned*)(lds + (bufoff) + ldsw + _i * 8192), 16, 0, 0); } while (0)
#define PG8_LDA(dst, b, h) do { _Pragma("unroll") for (int m = 0; m < 4; ++m) _Pragma("unroll") for (int k = 0; k < 2; ++k) dst[m][k] = *(const LAS bf16x8*)(lds + PG8_SA(b, h) + aoff + m * 2048 + k * 1024); } while (0)
#define PG8_LDB(dst, b, h) do { _Pragma("unroll") for (int n = 0; n < 2; ++n) _Pragma("unroll") for (int k = 0; k < 2; ++k) dst[n][k] = *(const LAS bf16x8*)(lds + PG8_SB(b, h) + boff + n * 2048 + k * 1024); } while (0)
#define PG8_MMA(ai, bj, At, Bt) do { __builtin_amdgcn_s_setprio(1); _Pragma("unroll") for (int m = 0; m < 4; ++m) _Pragma("unroll") for (int n = 0; n < 2; ++n) _Pragma("unroll") for (int k = 0; k < 2; ++k) \
        acc[ai][bj][m][n] = __builtin_amdgcn_mfma_f32_16x16x32_bf16(Bt[n][k], At[m][k], acc[ai][bj][m][n], 0, 0, 0); __builtin_amdgcn_s_setprio(0); } while (0)
#define PG8_WAIT_V(n) asm volatile("s_waitcnt vmcnt(" #n ")" ::: "memory")
#define PG8_WAIT_L(n) asm volatile("s_waitcnt lgkmcnt(" #n ")" ::: "memory")
#define PG8_BAR __builtin_amdgcn_s_barrier()
#define PG8_SCHED __builtin_amdgcn_sched_barrier(0)
#define PG8_APTR(u) ((const char*)J.A + (size_t)(u).pm * tstepA + (size_t)((u).pn / J.grp_tiles) * (size_t)J.grp_stride * 2)
#define PG8_BPTR(u) ((const char*)J.Bt + (size_t)(u).pn * tstepB + (size_t)((u).pm / J.bgrp_tiles) * (size_t)J.bgrp_stride * 2)
    Unit cur, nxt; int ui = 0;
    if (!S.next(0, cur)) return;
    f32x4 acc[2][2][4][2];
#pragma unroll
    for (int a = 0; a < 2; ++a)
#pragma unroll
        for (int b = 0; b < 2; ++b)
#pragma unroll
            for (int m = 0; m < 4; ++m)
#pragma unroll
                for (int n = 0; n < 2; ++n) acc[a][b][m][n] = (f32x4){0.f, 0.f, 0.f, 0.f};
    bf16x8 At[4][2], B0[2][2], B1[2][2];
    const char* cA = PG8_APTR(cur); const char* cB = PG8_BPTR(cur);
    PG8_STAGE(PG8_SB(0, 0), cB, voffB); PG8_STAGE(PG8_SB(0, 1), cB + hstepB, voffB); PG8_STAGE(PG8_SA(0, 0), cA, voffA); PG8_STAGE(PG8_SA(0, 1), cA + hstepA, voffA);
    if (wr == 1) PG8_BAR;
    PG8_WAIT_V(2); PG8_BAR;
    PG8_STAGE(PG8_SB(1, 0), cB + kstep, voffB); PG8_STAGE(PG8_SA(1, 0), cA + kstep, voffA); PG8_STAGE(PG8_SB(1, 1), cB + hstepB + kstep, voffB);
    PG8_WAIT_V(6); PG8_BAR;
    for (;;) {
        const bool has_next = S.next(ui + 1, nxt);
        const char* nA = has_next ? PG8_APTR(nxt) : cA; const char* nB = has_next ? PG8_BPTR(nxt) : cB;
        for (int t = 0; t < nt; t += 2) {
            const bool last = (t == nt - 2);
            const char* a1 = cA + (size_t)(t + 1) * kstep;
            const char* a2 = last ? nA : cA + (size_t)(t + 2) * kstep; const char* b2 = last ? nB : cB + (size_t)(t + 2) * kstep;
            const char* a3 = a2 + kstep; const char* b3 = b2 + kstep;
            PG8_LDB(B0, 0, 0); PG8_LDB(B1, 0, 1); PG8_SCHED; PG8_LDA(At, 0, 0); PG8_STAGE(PG8_SA(1, 1), a1 + hstepA, voffA);
            PG8_WAIT_V(8); PG8_WAIT_L(0); PG8_BAR; PG8_MMA(0, 0, At, B0); PG8_MMA(0, 1, At, B1); PG8_BAR; PG8_SCHED;
            PG8_LDA(At, 0, 1); PG8_STAGE(PG8_SB(0, 0), b2, voffB); PG8_STAGE(PG8_SB(0, 1), b2 + hstepB, voffB); PG8_STAGE(PG8_SA(0, 0), a2, voffA);
            PG8_WAIT_V(8); PG8_WAIT_L(0); PG8_BAR; PG8_MMA(1, 0, At, B0); PG8_MMA(1, 1, At, B1); PG8_BAR; PG8_SCHED;
            PG8_LDB(B0, 1, 0); PG8_LDB(B1, 1, 1); PG8_SCHED; PG8_LDA(At, 1, 0); PG8_STAGE(PG8_SA(0, 1), a2 + hstepA, voffA);
            PG8_WAIT_V(8); PG8_WAIT_L(0); PG8_BAR; PG8_MMA(0, 0, At, B0); PG8_MMA(0, 1, At, B1); PG8_BAR; PG8_SCHED;
            PG8_LDA(At, 1, 1); PG8_STAGE(PG8_SB(1, 0), b3, voffB); PG8_STAGE(PG8_SB(1, 1), b3 + hstepB, voffB); PG8_STAGE(PG8_SA(1, 0), a3, voffA);
            PG8_WAIT_V(8); PG8_WAIT_L(0); PG8_BAR; PG8_MMA(1, 0, At, B0); PG8_MMA(1, 1, At, B1); PG8_BAR; PG8_SCHED;
        }
        if constexpr (ALIGN_EPI) { if (wr == 0) PG8_BAR; }
        int fr_e = fr, fq_e = fq; asm volatile("" : "+v"(fr_e), "+v"(fq_e));
        float rs[2][4];
#pragma unroll
        for (int a = 0; a < 2; ++a)
#pragma unroll
            for (int m = 0; m < 4; ++m) rs[a][m] = 0.f;
        if (J.rowss != nullptr) {
#pragma unroll
            for (int a = 0; a < 2; ++a)
#pragma unroll
                for (int m = 0; m < 4; ++m) rs[a][m] = J.rowss[cur.pm * BM + wr * 64 + a * HALF + ((J.kind == 4) ? (4 * fr_e + m) : (fr_e + m * 16))];
        }
#pragma unroll
        for (int a = 0; a < 2; ++a)
#pragma unroll
            for (int m = 0; m < 4; ++m) rs[a][m] = (J.rowss != nullptr) ? 1.0f / sqrtf(rs[a][m] * (1.f / 2048.f) + 1e-6f) : 1.0f;
        if (J.kind == 7) epilogue_final(J, acc, cur, wid, wr, wc, fr_e, fq_e); else epilogue(J, acc, rs, cur, wr, wc, fr_e, fq_e);
        if (!has_next) break;
#pragma unroll
        for (int a = 0; a < 2; ++a)
#pragma unroll
            for (int b = 0; b < 2; ++b)
#pragma unroll
                for (int m = 0; m < 4; ++m)
#pragma unroll
                    for (int n = 0; n < 2; ++n) acc[a][b][m][n] = (f32x4){0.f, 0.f, 0.f, 0.f};
        cur = nxt; cA = nA; cB = nB; ++ui;
        if constexpr (ALIGN_EPI) { if (wr == 1) PG8_BAR; }
    }
    PG8_WAIT_V(0);
    if constexpr (!ALIGN_EPI) { if (wr == 0) PG8_BAR; }
    PG8_BAR;
#undef PG8_SA
#undef PG8_SB
#undef PG8_STAGE
#undef PG8_LDA
#undef PG8_LDB
#undef PG8_MMA
#undef PG8_WAIT_V
#undef PG8_WAIT_L
#undef PG8_BAR
#undef PG8_SCHED
#undef PG8_APTR
#undef PG8_BPTR
}
}

constexpr int RING_OFF = 0, RING_BYTES = 131072;
constexpr int LDS_BYTES = 163840;
constexpr int LDSCTL_OFF = LDS_BYTES - 1024, MISC_OFF = LDSCTL_OFF + 320;
constexpr int NWAVES = 8;

constexpr int CW_BAR = 4096, CW_SUB = 8192;

#define RLX_AGENT __ATOMIC_RELAXED, __HIP_MEMORY_SCOPE_AGENT
#define LDS_WAIT() asm volatile("s_waitcnt lgkmcnt(0)" ::: "memory")
#define VM_WAIT() asm volatile("s_waitcnt vmcnt(0)" ::: "memory")
__device__ __forceinline__ unsigned f2bf(float f) { unsigned u = __builtin_bit_cast(unsigned, f); return (u + 0x7fffu + ((u >> 16) & 1u)) >> 16; }
__device__ __forceinline__ unsigned pk2(float lo, float hi) { return f2bf(lo) | (f2bf(hi) << 16); }
__device__ __forceinline__ float bf2f(bf16_t b) { return __uint_as_float((unsigned)b << 16); }

#define XB_TMO      128
#define XB_XCNT(j)  (256  + 64 * (j))
#define XB_XSUB(j)  (1280 + 64 * (j))
#define XB_XGEN(j)  (2304 + 64 * (j))
#define XB_TOP      3328
#define XB_TOPGEN   3392
#define XCD_BAR_WORDS 3456
#define XB_SPIN_CAP (1u << 20)

__device__ __forceinline__ unsigned xb_ld(unsigned* p)              { return __hip_atomic_load(p, __ATOMIC_RELAXED, __HIP_MEMORY_SCOPE_AGENT); }
__device__ __forceinline__ unsigned xb_add(unsigned* p, unsigned v) { return __hip_atomic_fetch_add(p, v, __ATOMIC_RELAXED, __HIP_MEMORY_SCOPE_AGENT); }
__device__ __forceinline__ unsigned xb_xcc_id() { return (unsigned)__builtin_amdgcn_s_getreg((3 << 11) | 20) & 0xFu; }
#define XB_SPIN(cond, bar) do { unsigned _sp = 0; while (cond) { __builtin_amdgcn_s_sleep(1); \
    if ((++_sp & 255u) == 0u) { if (xb_ld(&(bar)[XB_TMO])) break; if (_sp > XB_SPIN_CAP) { atomicAdd(&(bar)[XB_TMO], 1u); break; } } } } while (0)

__device__ __forceinline__ int lane_id_now() { int l; asm volatile("v_mbcnt_lo_u32_b32 %0, -1, 0\n\tv_mbcnt_hi_u32_b32 %0, -1, %0" : "=v"(l)); return l; }

struct XcdBarrier { unsigned* bar; unsigned x; volatile LAS unsigned* st; };

__device__ __forceinline__ XcdBarrier xcd_barrier_post(unsigned* bar, volatile LAS unsigned* st) {
    XcdBarrier b; b.bar = bar; b.x = xb_xcc_id(); b.st = st;
    if (threadIdx.x == 0) (void)xb_add(&bar[XB_XCNT(b.x)], 1u);
    return b;
}
__device__ __forceinline__ void xcd_barrier_complete(unsigned* bar, unsigned x, unsigned& nloc, unsigned& nx) {
    const unsigned G = gridDim.x * gridDim.y * gridDim.z;
    unsigned sum, cnt, mine, sp = 0u;
    for (;;) {
        sum = 0u; cnt = 0u; mine = 0u;
#pragma unroll
        for (unsigned j = 0; j < 16; ++j) { const unsigned c = xb_ld(&bar[XB_XCNT(j)]); sum += c; cnt += (c > 0u) ? 1u : 0u; mine = (j == x) ? c : mine; }
        if (sum == G) break;
        __builtin_amdgcn_s_sleep(1);
        if ((++sp & 255u) == 0u) { if (xb_ld(&bar[XB_TMO])) break; if (sp > XB_SPIN_CAP) { atomicAdd(&bar[XB_TMO], 1u); break; } }
    }
    nloc = mine > 0u ? mine : 1u; nx = cnt > 0u ? cnt : 1u;
}
__device__ __forceinline__ void xcd_barrier(const XcdBarrier& b, int wave_s) {
    asm volatile("s_waitcnt vmcnt(0)" ::: "memory");
    __syncthreads();
    if (wave_s == 0 && lane_id_now() == 0) {
        unsigned* bar = b.bar;
        __builtin_amdgcn_s_waitcnt(0);
        unsigned nloc = b.st[0], nx = b.st[1];
        if (nloc == 0u) { xcd_barrier_complete(bar, b.x, nloc, nx); b.st[0] = nloc; b.st[1] = nx; }
        const unsigned old = xb_add(&bar[XB_XSUB(b.x)], 1u);
        const unsigned gen = old / nloc;
        if (old + 1u == (gen + 1u) * nloc) {
            __builtin_amdgcn_fence(__ATOMIC_RELEASE, "agent");
            asm volatile("s_waitcnt vmcnt(0)" ::: "memory");
            const unsigned og = xb_add(&bar[XB_TOP], 1u);
            const unsigned tg = og / nx;
            if (og + 1u == (tg + 1u) * nx) xb_add(&bar[XB_TOPGEN], 1u);
            else XB_SPIN(xb_ld(&bar[XB_TOPGEN]) == tg, bar);
            __builtin_amdgcn_fence(__ATOMIC_ACQUIRE, "agent");
            xb_add(&bar[XB_XGEN(b.x)], 1u);
            asm volatile("s_waitcnt vmcnt(0)" ::: "memory");
        } else {
            __builtin_amdgcn_fence(__ATOMIC_ACQUIRE, "agent");
            XB_SPIN(xb_ld(&bar[XB_XGEN(b.x)]) == gen, bar);
            asm volatile("s_waitcnt vmcnt(0)" ::: "memory");
        }
    }
    __syncthreads();
}

struct Args {
    const float* x; const float* mem; const float* norm_g; const float* mem_norm_g; const float* w_kv; const float* w_out;
    const float* pool_w_in; const float* pool_w_grp; const float* pool_scale; const float* hgrn_w_in; const float* hgrn_lb;
    const float* hgrn_norm_g; const float* final_g; float* out; unsigned char* ws; int ph_lo, ph_hi;
};

__device__ __forceinline__ float wave_sum(float v) { return pg8::xl_sum32(pg8::xl_sum16(pg8::xl_row_sum(v))); }
__device__ __forceinline__ float wave_max(float v) { return pg8::xl_max32(pg8::xl_max16(pg8::xl_row_max(v))); }

template <bool GAIN = false>
__device__ __forceinline__ void transpose_item(const float* W, int N, int k0, int n0, bf16_t* WT, int ldt, int orow0, LAS float* scr, int lane, const float* gk = nullptr) {
    f32x4 v[16]; float gs[16];
    const float* src = W + (size_t)(k0 + (lane >> 4)) * N + n0 + 4 * (lane & 15);
#pragma unroll
    for (int j = 0; j < 16; ++j) v[j] = *(const f32x4*)(src + (size_t)(4 * j) * N);
    if constexpr (GAIN) {
#pragma unroll
        for (int j = 0; j < 16; ++j) gs[j] = gk[k0 + 4 * j + (lane >> 4)];
#pragma unroll
        for (int j = 0; j < 16; ++j) v[j] = v[j] * gs[j];
    }
#pragma unroll
    for (int j = 0; j < 16; ++j) { LAS float* d = scr + (4 * j + (lane >> 4)) * 65 + 4 * (lane & 15); d[0] = v[j].x; d[1] = v[j].y; d[2] = v[j].z; d[3] = v[j].w; }
    LDS_WAIT(); asm volatile("" ::: "memory");
    const int c = lane & 7;
#pragma unroll
    for (int j = 0; j < 8; ++j) { const int n = (lane >> 3) + 8 * j; const LAS float* s = scr + (8 * c) * 65 + n;
        u32x4 o; o.x = pk2(s[0 * 65], s[1 * 65]); o.y = pk2(s[2 * 65], s[3 * 65]); o.z = pk2(s[4 * 65], s[5 * 65]); o.w = pk2(s[6 * 65], s[7 * 65]);
        *(u32x4*)(WT + (size_t)(orow0 + n) * ldt + k0 + 8 * c) = o; }
    LDS_WAIT(); asm volatile("" ::: "memory");
}

__device__ __forceinline__ void rms_row_to_bf16(const float* xrow, const f32x4 (&gv)[8], bf16_t* orow, int lane) {
    const f32x4* xr = (const f32x4*)xrow + lane;
    f32x4 v[8]; float s = 0.f;
#pragma unroll
    for (int j = 0; j < 8; ++j) v[j] = xr[64 * j];
    asm volatile("" ::: "memory");
#pragma unroll
    for (int j = 0; j < 8; ++j) s += (v[j].x * v[j].x + v[j].y * v[j].y) + (v[j].z * v[j].z + v[j].w * v[j].w);
    const float r = 1.0f / sqrtf(wave_sum(s) * (1.f / DM) + EPS);
    unsigned long long* o8 = (unsigned long long*)orow + lane;
#pragma unroll
    for (int j = 0; j < 8; ++j) { const f32x4 gg = gv[j];
        o8[64 * j] = (unsigned long long)pk2(v[j].x * r * gg.x, v[j].y * r * gg.y) | ((unsigned long long)pk2(v[j].z * r * gg.z, v[j].w * r * gg.w) << 32); }
}
__device__ __forceinline__ void rms_row2_to_bf16(const float* x0, const float* x1, const f32x4 (&gv)[8], bf16_t* o0, bf16_t* o1, int lane) {
    const f32x4* xr0 = (const f32x4*)x0 + lane; const f32x4* xr1 = (const f32x4*)x1 + lane;
    f32x4 v0[8], v1[8]; float s0 = 0.f, s1 = 0.f;
#pragma unroll
    for (int j = 0; j < 8; ++j) { v0[j] = xr0[64 * j]; v1[j] = xr1[64 * j]; }
    asm volatile("" ::: "memory");
#pragma unroll
    for (int j = 0; j < 8; ++j) { s0 += (v0[j].x * v0[j].x + v0[j].y * v0[j].y) + (v0[j].z * v0[j].z + v0[j].w * v0[j].w); s1 += (v1[j].x * v1[j].x + v1[j].y * v1[j].y) + (v1[j].z * v1[j].z + v1[j].w * v1[j].w); }
    s0 = wave_sum(s0); s1 = wave_sum(s1);
    const float r0 = 1.0f / sqrtf(s0 * (1.f / DM) + EPS), r1 = 1.0f / sqrtf(s1 * (1.f / DM) + EPS);
    unsigned long long* p0 = (unsigned long long*)o0 + lane; unsigned long long* p1 = (unsigned long long*)o1 + lane;
#pragma unroll
    for (int j = 0; j < 8; ++j) { const f32x4 gg = gv[j];
        p0[64 * j] = (unsigned long long)pk2(v0[j].x * r0 * gg.x, v0[j].y * r0 * gg.y) | ((unsigned long long)pk2(v0[j].z * r0 * gg.z, v0[j].w * r0 * gg.w) << 32);
        p1[64 * j] = (unsigned long long)pk2(v1[j].x * r1 * gg.x, v1[j].y * r1 * gg.y) | ((unsigned long long)pk2(v1[j].z * r1 * gg.z, v1[j].w * r1 * gg.w) << 32); }
}
__device__ __forceinline__ void rms_row_f32(float* xrow, const f32x4 (&gv)[8], int lane) {
    f32x4* xr = (f32x4*)xrow + lane;
    f32x4 v[8]; float s = 0.f;
#pragma unroll
    for (int j = 0; j < 8; ++j) v[j] = xr[64 * j];
    asm volatile("" ::: "memory");
#pragma unroll
    for (int j = 0; j < 8; ++j) s += (v[j].x * v[j].x + v[j].y * v[j].y) + (v[j].z * v[j].z + v[j].w * v[j].w);
    const float r = 1.0f / sqrtf(wave_sum(s) * (1.f / DM) + EPS);
#pragma unroll
    for (int j = 0; j < 8; ++j) { const f32x4 gg = gv[j]; xr[64 * j] = (f32x4){v[j].x * r * gg.x, v[j].y * r * gg.y, v[j].z * r * gg.z, v[j].w * r * gg.w}; }
}
__device__ __forceinline__ void rms_row_bf16_to_f32(const bf16_t* hrow, const f32x4 (&gv)[8], float* orow, int lane) {
    const u32x2* hr = (const u32x2*)hrow + lane;
    u32x2 v[8]; float s = 0.f;
#pragma unroll
    for (int j = 0; j < 8; ++j) v[j] = hr[64 * j];
    asm volatile("" ::: "memory");
    f32x4 f[8];
#pragma unroll
    for (int j = 0; j < 8; ++j) { f[j] = (f32x4){pg8::bflo(v[j].x), pg8::bfhi(v[j].x), pg8::bflo(v[j].y), pg8::bfhi(v[j].y)}; s += (f[j].x * f[j].x + f[j].y * f[j].y) + (f[j].z * f[j].z + f[j].w * f[j].w); }
    const float r = 1.0f / sqrtf(wave_sum(s) * (1.f / DM) + EPS);
    f32x4* o = (f32x4*)orow + lane;
#pragma unroll
    for (int j = 0; j < 8; ++j) { const f32x4 gg = gv[j]; o[64 * j] = (f32x4){f[j].x * r * gg.x, f[j].y * r * gg.y, f[j].z * r * gg.z, f[j].w * r * gg.w}; }
}
__device__ __forceinline__ void rms_row2_bf16_to_f32(const bf16_t* h0, const bf16_t* h1, const f32x4 (&gv)[8], float* o0, float* o1, int lane) {
    const u32x2* hr0 = (const u32x2*)h0 + lane; const u32x2* hr1 = (const u32x2*)h1 + lane;
    u32x2 v0[8], v1[8]; float s0 = 0.f, s1 = 0.f;
#pragma unroll
    for (int j = 0; j < 8; ++j) { v0[j] = hr0[64 * j]; v1[j] = hr1[64 * j]; }
    asm volatile("" ::: "memory");
#pragma unroll
    for (int j = 0; j < 8; ++j) { const float a = pg8::bflo(v0[j].x), b = pg8::bfhi(v0[j].x), c = pg8::bflo(v0[j].y), d = pg8::bfhi(v0[j].y); s0 += (a * a + b * b) + (c * c + d * d);
        const float e = pg8::bflo(v1[j].x), f = pg8::bfhi(v1[j].x), g = pg8::bflo(v1[j].y), h = pg8::bfhi(v1[j].y); s1 += (e * e + f * f) + (g * g + h * h); }
    s0 = wave_sum(s0); s1 = wave_sum(s1);
    const float r0 = 1.0f / sqrtf(s0 * (1.f / DM) + EPS), r1 = 1.0f / sqrtf(s1 * (1.f / DM) + EPS);
    f32x4* p0 = (f32x4*)o0 + lane; f32x4* p1 = (f32x4*)o1 + lane;
#pragma unroll
    for (int j = 0; j < 8; ++j) { const f32x4 gg = gv[j];
        p0[64 * j] = (f32x4){pg8::bflo(v0[j].x) * r0 * gg.x, pg8::bfhi(v0[j].x) * r0 * gg.y, pg8::bflo(v0[j].y) * r0 * gg.z, pg8::bfhi(v0[j].y) * r0 * gg.w};
        p1[64 * j] = (f32x4){pg8::bflo(v1[j].x) * r1 * gg.x, pg8::bfhi(v1[j].x) * r1 * gg.y, pg8::bflo(v1[j].y) * r1 * gg.z, pg8::bfhi(v1[j].y) * r1 * gg.w}; }
}
__device__ __forceinline__ void load_gain(const float* g, f32x4 (&gv)[8], int lane) {
#pragma unroll
    for (int j = 0; j < 8; ++j) gv[j] = *((const f32x4*)g + lane + 64 * j);
}

__device__ __forceinline__ float dot256(const bf16_t* row, const LAS float* vec) {
    float s = 0.f;
#pragma unroll 4
    for (int c = 0; c < 32; ++c) { const u32x4 w = *(const u32x4*)(row + 8 * c); const LAS f32x4* vv = (const LAS f32x4*)(vec + 8 * c); const f32x4 a = vv[0], b = vv[1];
        s += pg8::bflo(w.x) * a.x + pg8::bfhi(w.x) * a.y + pg8::bflo(w.y) * a.z + pg8::bfhi(w.y) * a.w + pg8::bflo(w.z) * b.x + pg8::bfhi(w.z) * b.y + pg8::bflo(w.w) * b.z + pg8::bfhi(w.w) * b.w; }
    return s;
}


typedef float f32x16 __attribute__((ext_vector_type(16)));
typedef short s16x4 __attribute__((ext_vector_type(4)));
#define MFMA32(a, b, c) __builtin_amdgcn_mfma_f32_32x32x16_bf16((a), (b), (c), 0, 0, 0)
__device__ __forceinline__ bf16x8 pack8(const f32x16& x, int s) {
    u32x4 p; p.x = pg8::cvt_pk_bf16(x[8 * s], x[8 * s + 1]); p.y = pg8::cvt_pk_bf16(x[8 * s + 2], x[8 * s + 3]); p.z = pg8::cvt_pk_bf16(x[8 * s + 4], x[8 * s + 5]); p.w = pg8::cvt_pk_bf16(x[8 * s + 6], x[8 * s + 7]);
    return __builtin_bit_cast(bf16x8, p);
}
__device__ __forceinline__ bf16x8 cat44(u32x2 lo, u32x2 hi) { u32x4 p; p.x = lo.x; p.y = lo.y; p.z = hi.x; p.w = hi.y; return __builtin_bit_cast(bf16x8, p); }

constexpr int CAROW = 528, CATILE = 32 * CAROW, CASTG = 2 * CATILE, CASROW = 80;
__device__ __forceinline__ void ca_unit(const bf16_t* Qu  , bf16_t* Ou  , int ldq, int ldo, const bf16_t* Kb  , const bf16_t* Vtb  , LAS unsigned char* lds, int tid) {
    const int lane = tid & 63, w = __builtin_amdgcn_readfirstlane(tid >> 6), r = lane & 31, h = lane >> 5;
    const int srow = tid >> 4, spc = tid & 15;
    bf16x8 qf[16];
#pragma unroll
    for (int ks = 0; ks < 16; ++ks) qf[ks] = *(const bf16x8*)(Qu + (size_t)(32 * w + r) * ldq + 16 * ks + 8 * h);
    u32x4 sr[2][2];
    const __amdgpu_buffer_rsrc_t krs = __builtin_amdgcn_make_buffer_rsrc((void*)Kb, 0, 0x7ffffff0, 0x00020000), vrs = __builtin_amdgcn_make_buffer_rsrc((void*)Vtb, 0, 0x7ffffff0, 0x00020000);
    const unsigned kvo = ((unsigned)srow * 2048u + 16u * spc) * 2u, vvo = ((unsigned)srow * (unsigned)MROWS + 16u * spc) * 2u;
#define CA_LOAD(t) do { if ((t) < 8) { sr[(t) & 1][0] = __builtin_bit_cast(u32x4, __builtin_amdgcn_raw_buffer_load_b128(krs, kvo, (t) * (32 * 2048 * 2), 0)); sr[(t) & 1][1] = __builtin_bit_cast(u32x4, __builtin_amdgcn_raw_buffer_load_b128(krs, kvo + 16u, (t) * (32 * 2048 * 2), 0)); } \
        else { sr[(t) & 1][0] = __builtin_bit_cast(u32x4, __builtin_amdgcn_raw_buffer_load_b128(vrs, vvo, ((t) - 8) * (32 * MROWS * 2), 0)); sr[(t) & 1][1] = __builtin_bit_cast(u32x4, __builtin_amdgcn_raw_buffer_load_b128(vrs, vvo + 16u, ((t) - 8) * (32 * MROWS * 2), 0)); } } while (0)
#define CA_WRITE(t) do { LAS unsigned char* d_ = lds + ((t) & 1) * CATILE + srow * CAROW + 32 * spc; *(LAS u32x4*)d_ = sr[(t) & 1][0]; *(LAS u32x4*)(d_ + 16) = sr[(t) & 1][1]; } while (0)
    CA_LOAD(0); CA_LOAD(1); CA_WRITE(0); CA_LOAD(2);
    __syncthreads();
    f32x16 X[8];
#pragma unroll
    for (int kt = 0; kt < 8; ++kt) {
        if (kt >= 1) CA_LOAD(kt + 2);
#pragma unroll
        for (int i = 0; i < 16; ++i) X[kt][i] = 0.f;
        const LAS unsigned char* kp = lds + (kt & 1) * CATILE + r * CAROW + h * 16;
#pragma unroll
        for (int ks = 0; ks < 16; ++ks) { const bf16x8 a = *(const LAS bf16x8*)(kp + 32 * ks); X[kt] = MFMA32(a, qf[ks], X[kt]); }
        CA_WRITE(kt + 1);
        __syncthreads();
    }
    float mx = -3.0e38f;
#pragma unroll
    for (int kt = 0; kt < 8; ++kt)
#pragma unroll
        for (int i = 0; i < 16; ++i) mx = fmaxf(mx, X[kt][i]);
    mx = pg8::xl_max32(mx);
    const float c = 0.0625f * 1.4426950408889634f; float sm = 0.f;
#pragma unroll
    for (int kt = 0; kt < 8; ++kt)
#pragma unroll
        for (int i = 0; i < 16; ++i) { X[kt][i] = __builtin_amdgcn_exp2f((X[kt][i] - mx) * c); sm += X[kt][i]; }
    sm = pg8::xl_sum32(sm);
    const float inv = 1.0f / sm;
    bf16x8 pa[8][2];
#pragma unroll
    for (int kt = 0; kt < 8; ++kt) {
#pragma unroll
        for (int i = 0; i < 16; ++i) X[kt][i] *= inv;
        pa[kt][0] = pack8(X[kt], 0); pa[kt][1] = pack8(X[kt], 1);
    }
    LAS unsigned char* stg = lds + CASTG + w * (32 * CASROW);
#define CA_PV(dt) do { f32x16 Z; if ((dt) < 6) CA_LOAD(8 + (dt) + 2); \
        _Pragma("unroll") for (int i = 0; i < 16; ++i) Z[i] = 0.f; \
        const LAS unsigned char* vp = lds + ((dt) & 1) * CATILE + r * CAROW + h * 8; \
        _Pragma("unroll") for (int kt = 0; kt < 8; ++kt) _Pragma("unroll") for (int ss = 0; ss < 2; ++ss) { const u32x2 lo = *(const LAS u32x2*)(vp + (32 * kt + 16 * ss) * 2), hi = *(const LAS u32x2*)(vp + (32 * kt + 16 * ss) * 2 + 16); Z = MFMA32(cat44(lo, hi), pa[kt][ss], Z); } \
          \
        _Pragma("unroll") for (int g = 0; g < 4; ++g) { u32x2 o; o.x = pg8::cvt_pk_bf16(Z[4 * g], Z[4 * g + 1]); o.y = pg8::cvt_pk_bf16(Z[4 * g + 2], Z[4 * g + 3]); *(LAS u32x2*)(stg + r * CASROW + (8 * g + 4 * h) * 2) = o; } \
        if ((dt) < 7) CA_WRITE(8 + (dt) + 1);        \
        LDS_WAIT(); asm volatile("" ::: "memory"); \
        { const int q = lane >> 1, hf = lane & 1; const u32x4 v0 = *(const LAS u32x4*)(stg + q * CASROW + 32 * hf), v1 = *(const LAS u32x4*)(stg + q * CASROW + 32 * hf + 16); \
          bf16_t* op = Ou + (size_t)(32 * w + q) * ldo + 32 * (dt) + 16 * hf; *(u32x4*)op = v0; *(u32x4*)(op + 8) = v1; } \
        __syncthreads(); } while (0)
#pragma unroll 1
    for (int d2 = 0; d2 < 8; d2 += 2) { CA_PV(d2); CA_PV(d2 + 1); }
#undef CA_PV
#undef CA_LOAD
#undef CA_WRITE
}

constexpr int HROW = 272, HKROW = 256, HVROW = 320, HQD = 0, HKI = 17408, HV = HKI + 64 * HKROW, HDEC = HV + 64 * HVROW, HSET = HDEC + 512, HOUT = 2 * HSET, HOROW = 272, HOUTB = 64 * HOROW, HNG = HOUT + 2 * HOUTB;
static_assert(HNG + 512 <= LDSCTL_OFF, "hgrn LDS map");
#define RAW_BAR() do { asm volatile("s_waitcnt lgkmcnt(0)" ::: "memory"); __builtin_amdgcn_s_barrier(); asm volatile("" ::: "memory"); } while (0)
typedef short v4i16_t __attribute__((ext_vector_type(4)));
__device__ __forceinline__ u32x2 tr_read(const LAS unsigned char* p) { return __builtin_bit_cast(u32x2, __builtin_amdgcn_ds_read_tr16_b64_v4i16((LAS v4i16_t*)p)); }
__device__ __forceinline__ void hgrn_unit(bf16_t* P1, const float* DECG, const float* hgrn_norm_g, int b, int hh, LAS unsigned char* lds, int tid, bf16_t* Ob, int ldo, int rowmask) {
    const int lane = tid & 63, w = __builtin_amdgcn_readfirstlane(tid >> 6);
    constexpr int NCH = SEQ / 64;
    if (w < 4) {
        const int vt = w, r = lane & 31, h = lane >> 5;
        const int trq = (lane & 15) >> 2, trg = (lane >> 4) & 1, trp = lane & 3;
        const int trlv = trq * HVROW + (16 * trg + 4 * trp) * 2;
        const int kxb = r * HKROW + (((4 * (r & 3) + ((r >> 2) & 3)) ^ h) << 4);
        const int pp = ((trp & 1) << 1) | (trp >> 1);
        int knb[2];
#pragma unroll
        for (int d = 0; d < 2; ++d) knb[d] = (8 * h + 4 * d + trq) * HKROW + (((2 * trg + (pp >> 1)) ^ (4 * trq + 2 * h + d)) << 4) + 8 * (pp & 1);
        f32x16 S[4];
#pragma unroll
        for (int kt = 0; kt < 4; ++kt)
#pragma unroll
            for (int i = 0; i < 16; ++i) S[kt][i] = 0.f;
        RAW_BAR();
#define SB() __builtin_amdgcn_sched_barrier(0)
#define LDX(ks, A0, A1, B0, B1) do { A0 = *(const LAS bf16x8*)(lds + ((pKx) ^ (32 * (ks)))); A1 = *(const LAS bf16x8*)(lds + ((pKx + 32 * HKROW) ^ (32 * (ks)))); B0 = *(const LAS bf16x8*)(pQD + 32 * (ks)); B1 = *(const LAS bf16x8*)(pQD + 32 * HROW + 32 * (ks)); } while (0)
#define MMX(A0, A1, B0, B1) do { X00 = MFMA32(A0, B0, X00); X01 = MFMA32(A0, B1, X01); X11 = MFMA32(A1, B1, X11); } while (0)
#define LDV(ss, st) cat44(tr_read(pVp + (32 * (st) + 16 * (ss)) * HVROW), tr_read(pVp + (32 * (st) + 16 * (ss) + 8) * HVROW))
#define LDQ(j, tt) (*(const LAS bf16x8*)(pQD + 32 * (tt) * HROW + 32 * (j)))
#pragma unroll 1
        for (int n = 0; n < NCH; ++n) {
            const LAS unsigned char* sb = lds + (n & 1) * HSET;
            const int sbo = (n & 1) * HSET, pKx = sbo + HKI + kxb, pKn0 = sbo + HKI + knb[0], pKn1 = sbo + HKI + knb[1];
            const LAS unsigned char* pQD = sb + HQD + r * HROW + h * 16;
            const LAS unsigned char* pVp = sb + HV + trlv + 64 * vt + 4 * h * HVROW;
            const LAS unsigned char* pVn = sb + HV + trlv + 64 * vt + 8 * h * HVROW;
            f32x16 X00, X01, X11;
#pragma unroll
            for (int i = 0; i < 16; ++i) { X00[i] = 0.f; X01[i] = 0.f; X11[i] = 0.f; }
            bf16x8 fa0, fa1, fb0, fb1, ga0, ga1, gb0, gb1;
            LDX(0, fa0, fa1, fb0, fb1); LDX(1, ga0, ga1, gb0, gb1); SB();
            MMX(fa0, fa1, fb0, fb1); SB(); LDX(2, fa0, fa1, fb0, fb1); SB();
            MMX(ga0, ga1, gb0, gb1); SB(); LDX(3, ga0, ga1, gb0, gb1); SB();
            MMX(fa0, fa1, fb0, fb1); SB(); LDX(4, fa0, fa1, fb0, fb1); SB();
            MMX(ga0, ga1, gb0, gb1); SB(); LDX(5, ga0, ga1, gb0, gb1); SB();
            MMX(fa0, fa1, fb0, fb1); SB(); LDX(6, fa0, fa1, fb0, fb1); SB();
            MMX(ga0, ga1, gb0, gb1); SB(); LDX(7, ga0, ga1, gb0, gb1); SB();
            const bf16x8 av00 = LDV(0, 0), av01 = LDV(0, 1), av10 = LDV(1, 0), av11 = LDV(1, 1); SB();
            MMX(fa0, fa1, fb0, fb1); SB();
            bf16x8 q00 = LDQ(0, 0), q01 = LDQ(0, 1), q10 = LDQ(1, 0), q11 = LDQ(1, 1); SB();
            MMX(ga0, ga1, gb0, gb1); SB();
#pragma unroll
            for (int i = 0; i < 16; ++i) { const int sl = (i & 3) + 8 * (i >> 2) + 4 * h; if (sl > r) { X00[i] = 0.f; X11[i] = 0.f; } }
            f32x16 OT0, OT1;
#pragma unroll
            for (int i = 0; i < 16; ++i) { OT0[i] = 0.f; OT1[i] = 0.f; }
            OT0 = MFMA32(av00, pack8(X00, 0), OT0); OT1 = MFMA32(av00, pack8(X01, 0), OT1); OT1 = MFMA32(av01, pack8(X11, 0), OT1);
            OT0 = MFMA32(av10, pack8(X00, 1), OT0); OT1 = MFMA32(av10, pack8(X01, 1), OT1); OT1 = MFMA32(av11, pack8(X11, 1), OT1); SB();
#define INTER(j, QA, QB) do { const bf16x8 sa = pack8(S[(j) >> 1], (j) & 1); OT0 = MFMA32(sa, QA, OT0); OT1 = MFMA32(sa, QB, OT1); } while (0)
            INTER(0, q00, q01); SB(); q00 = LDQ(2, 0); q01 = LDQ(2, 1); SB();
            INTER(1, q10, q11); SB(); q10 = LDQ(3, 0); q11 = LDQ(3, 1); SB();
            INTER(2, q00, q01); SB(); q00 = LDQ(4, 0); q01 = LDQ(4, 1); SB();
            INTER(3, q10, q11); SB(); q10 = LDQ(5, 0); q11 = LDQ(5, 1); SB();
            INTER(4, q00, q01); SB(); q00 = LDQ(6, 0); q01 = LDQ(6, 1); SB();
            INTER(5, q10, q11); SB(); q10 = LDQ(7, 0); q11 = LDQ(7, 1); SB();
            INTER(6, q00, q01); SB();
            bf16x8 bv[4];
#pragma unroll
            for (int ts = 0; ts < 4; ++ts) bv[ts] = cat44(tr_read(pVn + 16 * ts * HVROW), tr_read(pVn + (16 * ts + 4) * HVROW));
            SB(); INTER(7, q10, q11); SB();
            bf16x8 ka[4], kb[4]; f32x4 da[4], db[4];
            const LAS unsigned char* pDC = sb + HDEC + h * 32;
#define LDK(kt, KF, DF) do { _Pragma("unroll") for (int ts = 0; ts < 4; ++ts) KF[ts] = cat44(tr_read(lds + ((pKn0 ^ (64 * (kt))) + 16 * ts * HKROW)), tr_read(lds + ((pKn1 ^ (64 * (kt))) + 16 * ts * HKROW))); _Pragma("unroll") for (int g = 0; g < 4; ++g) DF[g] = *(const LAS f32x4*)(pDC + (32 * (kt) + 16 * (g >> 1) + 4 * (g & 1)) * 4); } while (0)
#define UPD(kt, KF, DF) do { _Pragma("unroll") for (int ts = 0; ts < 4; ++ts) S[kt] = MFMA32(KF[ts], bv[ts], S[kt]); \
                _Pragma("unroll") for (int g = 0; g < 4; ++g) { S[kt][4 * g] *= DF[g].x; S[kt][4 * g + 1] *= DF[g].y; S[kt][4 * g + 2] *= DF[g].z; S[kt][4 * g + 3] *= DF[g].w; } } while (0)
            LDK(0, ka, da); SB();
            { LAS unsigned char* ob = lds + HOUT + (n & 1) * HOUTB;
#pragma unroll
              for (int g = 0; g < 4; ++g) {
                u32x2 o0, o1; o0.x = pg8::cvt_pk_bf16(OT0[4 * g], OT0[4 * g + 1]); o0.y = pg8::cvt_pk_bf16(OT0[4 * g + 2], OT0[4 * g + 3]); o1.x = pg8::cvt_pk_bf16(OT1[4 * g], OT1[4 * g + 1]); o1.y = pg8::cvt_pk_bf16(OT1[4 * g + 2], OT1[4 * g + 3]);
                *(LAS u32x2*)(ob + r * HOROW + (32 * vt + 8 * g + 4 * h) * 2) = o0; *(LAS u32x2*)(ob + (32 + r) * HOROW + (32 * vt + 8 * g + 4 * h) * 2) = o1; } }
            SB();
            LDK(1, kb, db); SB(); UPD(0, ka, da); SB();
            LDK(2, ka, da); SB(); UPD(1, kb, db); SB();
            LDK(3, kb, db); SB(); UPD(2, ka, da); SB();
            UPD(3, kb, db); SB();
            RAW_BAR();
        }
#undef LDX
#undef MMX
#undef LDV
#undef LDQ
#undef INTER
#undef LDK
#undef UPD
#undef SB
    } else {
        const int pw = w - 4;
        const int nt = pw * 64 + lane, nrow = nt >> 2, nq = nt & 3;
        if (pw == 0) { *(LAS f32x2*)(lds + HNG + 8 * lane) = *(const f32x2*)(hgrn_norm_g + hh * 128 + 2 * lane); }
        const __amdgpu_buffer_rsrc_t rs = __builtin_amdgcn_make_buffer_rsrc((void*)P1, 0, (int)((size_t)T * LDP * 2), 0x00020000);
        const int crow = 16 * pw + (lane >> 4), cch = lane & 15;
        const int voff0 = (int)(((size_t)(b * SEQ + crow) * LDP + 256 * hh + 8 * cch) * 2);
        const int vso = (6144 + 128 * hh - 256 * hh) * 2;
        const int lq = crow * HROW + 16 * cch, lv = crow * HVROW + 16 * cch;
        const float* decg = DECG + (size_t)(b * (SEQ / 64)) * 3072 + hh * 128 + 32 * pw + 4 * (lane & 7);
        u32x4 qA[4], fA[4], vA[4], qB[4], fB[4], vB[4]; f32x4 dA, dB;
#define HG_LOAD(c_, QW, FW, VW, DW) do { const int c = ((c_) < NCH) ? (c_) : (NCH - 1); const int so_ = c * (64 * LDP * 2);       \
            DW = *(const f32x4*)(decg + (size_t)c * 3072); _Pragma("unroll") for (int j = 0; j < 4; ++j) { \
            QW[j] = __builtin_bit_cast(u32x4, __builtin_amdgcn_raw_buffer_load_b128(rs, voff0, so_ + 4 * j * (LDP * 2), 0)); FW[j] = __builtin_bit_cast(u32x4, __builtin_amdgcn_raw_buffer_load_b128(rs, voff0, so_ + 4 * j * (LDP * 2) + 256, 0)); \
            VW[j] = __builtin_bit_cast(u32x4, __builtin_amdgcn_raw_buffer_load_b128(rs, voff0, so_ + 4 * j * (LDP * 2) + vso, 0)); } } while (0)
#define HG_NORM(n_) do { u32x4 ov[4]; float ss = 0.f; const LAS unsigned char* ob = lds + HOUT + (((n_) - 1) & 1) * HOUTB; \
            _Pragma("unroll") for (int j = 0; j < 4; ++j) ov[j] = *(const LAS u32x4*)(ob + nrow * HOROW + nq * 64 + 16 * j); \
            _Pragma("unroll") for (int j = 0; j < 4; ++j) { const float x0 = pg8::bflo(ov[j].x), x1 = pg8::bfhi(ov[j].x), x2 = pg8::bflo(ov[j].y), x3 = pg8::bfhi(ov[j].y), x4 = pg8::bflo(ov[j].z), x5 = pg8::bfhi(ov[j].z), x6 = pg8::bflo(ov[j].w), x7 = pg8::bfhi(ov[j].w); \
                ss += (x0 * x0 + x1 * x1) + (x2 * x2 + x3 * x3) + (x4 * x4 + x5 * x5) + (x6 * x6 + x7 * x7); } \
            ss += DPPF(ss, 0xB1); ss += DPPF(ss, 0x4E); \
            const float rn = 1.0f / sqrtf(ss * (1.f / 128.f) + EPS); \
            bf16_t* op = Ob + (size_t)((b * SEQ + ((n_) - 1) * 64 + nrow) & rowmask) * ldo + hh * 128 + 32 * nq; \
            _Pragma("unroll") for (int j = 0; j < 4; ++j) { const f32x4 g0 = *(const LAS f32x4*)(lds + HNG + (32 * nq + 8 * j) * 4), g1 = *(const LAS f32x4*)(lds + HNG + (32 * nq + 8 * j + 4) * 4); u32x4 o; \
                o.x = pg8::cvt_pk_bf16(pg8::bflo(ov[j].x) * rn * g0.x, pg8::bfhi(ov[j].x) * rn * g0.y); o.y = pg8::cvt_pk_bf16(pg8::bflo(ov[j].y) * rn * g0.z, pg8::bfhi(ov[j].y) * rn * g0.w); \
                o.z = pg8::cvt_pk_bf16(pg8::bflo(ov[j].z) * rn * g1.x, pg8::bfhi(ov[j].z) * rn * g1.y); o.w = pg8::cvt_pk_bf16(pg8::bflo(ov[j].w) * rn * g1.z, pg8::bfhi(ov[j].w) * rn * g1.w); *(u32x4*)(op + 8 * j) = o; } } while (0)
#define HG_STEP(n_, QC, FC, VC, DC, QN, FN, VN, DN, DO_NORM) do { const int n = (n_); \
            HG_LOAD(n + 2, QN, FN, VN, DN); \
            if (DO_NORM) HG_NORM(n); \
            LAS unsigned char* sb = lds + ((n + 1) & 1) * HSET; \
            _Pragma("unroll") for (int j = 0; j < 4; ++j) { *(LAS u32x4*)(sb + HQD + lq + 4 * j * HROW) = QC[j]; *(LAS u32x4*)(sb + HKI + (crow + 4 * j) * HKROW + ((cch ^ (4 * (lane >> 4) + j)) << 4)) = FC[j]; *(LAS u32x4*)(sb + HV + lv + 4 * j * HVROW) = VC[j]; } \
            if (lane < 8) *(LAS f32x4*)(lds + ((n + 1) & 1) * HSET + HDEC + (32 * pw + 4 * lane) * 4) = DC; \
            RAW_BAR();                                                          \
        } while (0)
        HG_LOAD(0, qA, fA, vA, dA);
        HG_STEP(-1, qA, fA, vA, dA, qB, fB, vB, dB, false);
        HG_STEP(0, qB, fB, vB, dB, qA, fA, vA, dA, false);
#pragma unroll 1
        for (int n2 = 1; n2 < NCH - 1; n2 += 2) {
            HG_STEP(n2, qA, fA, vA, dA, qB, fB, vB, dB, true);
            HG_STEP(n2 + 1, qB, fB, vB, dB, qA, fA, vA, dA, true);
        }
        HG_STEP(NCH - 1, qA, fA, vA, dA, qB, fB, vB, dB, true);
        HG_NORM(NCH);
#undef HG_LOAD
#undef HG_NORM
#undef HG_STEP
    }
    __syncthreads();
}

template <int W, int RWS> __device__ __forceinline__ void pool_task(const bf16_t* up, bf16_t* op, const float* scp, int tl0) {
    constexpr int NH = W - 1;
    u32x4 R[NH + RWS];
    const f32x4 sc0 = *(const f32x4*)scp, sc1 = *(const f32x4*)(scp + 4);
#pragma unroll
    for (int i = 0; i < NH; ++i) { const int d = NH - i; const bool ok = (tl0 - d >= 0); const u32x4 v = *(const u32x4*)(up - (long)(ok ? d : 0) * LDU); R[i] = ok ? v : (u32x4){0u, 0u, 0u, 0u}; }
#pragma unroll
    for (int r = 0; r < RWS; ++r) R[NH + r] = *(const u32x4*)(up + (size_t)r * LDU);
    float s[8];
#pragma unroll
    for (int e = 0; e < 8; ++e) s[e] = 0.f;
#pragma unroll
    for (int i = 0; i < NH; ++i) { s[0] += pg8::bflo(R[i].x); s[1] += pg8::bfhi(R[i].x); s[2] += pg8::bflo(R[i].y); s[3] += pg8::bfhi(R[i].y); s[4] += pg8::bflo(R[i].z); s[5] += pg8::bfhi(R[i].z); s[6] += pg8::bflo(R[i].w); s[7] += pg8::bfhi(R[i].w); }
#pragma unroll
    for (int r = 0; r < RWS; ++r) {
        const u32x4 v = R[NH + r];
        const float c[8] = {pg8::bflo(v.x), pg8::bfhi(v.x), pg8::bflo(v.y), pg8::bfhi(v.y), pg8::bflo(v.z), pg8::bfhi(v.z), pg8::bflo(v.w), pg8::bfhi(v.w)};
#pragma unroll
        for (int e = 0; e < 8; ++e) s[e] += c[e];
        if (r >= 1) { const u32x4 o = R[r - 1]; s[0] -= pg8::bflo(o.x); s[1] -= pg8::bfhi(o.x); s[2] -= pg8::bflo(o.y); s[3] -= pg8::bfhi(o.y); s[4] -= pg8::bflo(o.z); s[5] -= pg8::bfhi(o.z); s[6] -= pg8::bflo(o.w); s[7] -= pg8::bfhi(o.w); }
        const int tl = tl0 + r; const float inv = 1.0f / (float)((tl + 1 < W) ? (tl + 1) : W);
        u32x4 o4; o4.x = pk2((s[0] * inv - c[0]) * sc0.x, (s[1] * inv - c[1]) * sc0.y); o4.y = pk2((s[2] * inv - c[2]) * sc0.z, (s[3] * inv - c[3]) * sc0.w);
        o4.z = pk2((s[4] * inv - c[4]) * sc1.x, (s[5] * inv - c[5]) * sc1.y); o4.w = pk2((s[6] * inv - c[6]) * sc1.z, (s[7] * inv - c[7]) * sc1.w);
        *(u32x4*)(op + (size_t)r * LDU) = o4;
    }
}

__global__ void __launch_bounds__(NWAVES * 64, 2) fwd_kernel(Args a) {
    extern __shared__ __attribute__((aligned(16))) unsigned char lds_raw[];
    LAS unsigned char* lds = (LAS unsigned char*)lds_raw;
    volatile LAS unsigned* MISC = (volatile LAS unsigned*)(lds + MISC_OFF);
    const int tid0 = threadIdx.x;
    const int wave_s = __builtin_amdgcn_readfirstlane(tid0 >> 6);
    const int G = gridDim.x, bx = blockIdx.x;
    const int vcu = (G % 8 == 0) ? (bx % 8) * (G / 8) + bx / 8 : bx;
    unsigned char* ws = a.ws;
    unsigned* ctl = (unsigned*)(ws + WS_CTL);
    for (int u = tid0; u < (LDS_BYTES - LDSCTL_OFF) / 4; u += NWAVES * 64) ((LAS unsigned*)(lds + LDSCTL_OFF))[u] = 0u;
    __syncthreads();
    XcdBarrier bar; bar.bar = ctl + CW_BAR; bar.x = 0; bar.st = nullptr;
    const bool multi = (a.ph_hi - a.ph_lo) > 1;
    if (multi) bar = xcd_barrier_post(ctl + CW_BAR, MISC + 8);
#ifdef PROBE_A
    unsigned long long* tsb = (unsigned long long*)(ws + WS_CTL + 65536);
    if (bx == 0 && tid0 == 0) tsb[0] = __builtin_amdgcn_s_memrealtime();
#endif

    bf16_t* Wt_in0 = (bf16_t*)(ws + WS_WIN0); bf16_t* Wt_in1 = (bf16_t*)(ws + WS_WIN1);
    bf16_t* Wt_out0 = (bf16_t*)(ws + WS_WOUT0); bf16_t* Wt_out1 = (bf16_t*)(ws + WS_WOUT1);
    bf16_t* Wt_kv = (bf16_t*)(ws + WS_WKV); bf16_t* Wt_grp = (bf16_t*)(ws + WS_WGRP);
    bf16_t* MEMN = (bf16_t*)(ws + WS_MEMN); bf16_t* KMAT = (bf16_t*)(ws + WS_KMAT); bf16_t* VT = (bf16_t*)(ws + WS_VT);
    bf16_t* H = (bf16_t*)(ws + WS_H); bf16_t* U = (bf16_t*)(ws + WS_U); bf16_t* BR0 = (bf16_t*)(ws + WS_BR0); bf16_t* WUBF = (bf16_t*)(ws + WS_WUBF); bf16_t* P1 = (bf16_t*)(ws + WS_P1);
    float* SSQ1 = (float*)(ws + WS_CTL + 262144);
    float* OMLB = (float*)(ws + WS_CTL + 393216);
    float* SSQ2 = (float*)(ws + WS_CTL + 458752);
    const int NGW = G * NWAVES;

    for (int p = a.ph_lo, sub = 0; p < a.ph_hi; ) {
        if (p == 6 || p == 11) { ++p; continue; }
#ifdef REPEAT_MASK
        const int nrep = ((REPEAT_MASK >> p) & 1) ? 2 : 1;
        for (int rep = 0; rep < nrep; ++rep) {
        const bool dummy = (rep + 1 < nrep);
#else
        constexpr bool dummy = false;
#endif
        int tid = (wave_s << 6) | lane_id_now(); asm volatile("" : "+v"(tid));
        const int lane = tid & 63, wave = __builtin_amdgcn_readfirstlane(tid >> 6), gw = vcu * NWAVES + wave;
        pg8::Job J; J.kind = -1; J.grp_tiles = 1 << 20; J.grp_stride = 0; J.bgrp_tiles = 1 << 20; J.bgrp_stride = 0; J.colscale = nullptr; J.base = nullptr; J.out = nullptr; J.O = nullptr; J.ldc = 0; J.G = G; J.c = bx;
        J.A = nullptr; J.Bt = nullptr; J.lda = 0; J.ldb = 0; J.K = 0; J.M = 0; J.N = 0; J.wgm = 8; J.lbp = OMLB; J.decp = (float*)(ws + WS_DEC); J.rowss = nullptr; J.ssq = nullptr; J.pcnt = nullptr;
        switch (p) {
            case 1: if (bx < 32) { J.kind = 0; J.A = MEMN; J.lda = LDH; J.Bt = Wt_kv; J.ldb = LDH; J.K = DM; J.M = MROWS; J.N = 2048; J.O = KMAT; J.ldc = 2048; J.G = 32; J.c = bx; }
                    else if (bx < 64) { J.kind = 0; J.A = Wt_kv + (size_t)2048 * LDH; J.lda = LDH; J.Bt = MEMN; J.ldb = LDH; J.K = DM; J.M = 2048; J.N = MROWS; J.O = VT; J.ldc = MROWS; J.G = 32; J.c = bx - 32; }
                    else if (bx < 160) { J.kind = 0; J.A = Wt_grp; J.lda = PGRP; J.Bt = WUBF; J.ldb = E_MIX; J.bgrp_tiles = 3; J.bgrp_stride = PGRP; J.K = PGRP; J.M = E_MIX; J.N = DM; J.O = Wt_in0; J.ldc = LDH; J.G = 96; J.c = bx - 64; }
                    break;
            case 2: J.kind = 0; J.A = H; J.lda = LDH; J.Bt = Wt_in0; J.ldb = LDH; J.K = DM; J.M = T; J.N = N0A; J.O = U; J.ldc = LDU; break;
            case 4: J.kind = 2; J.A = H; J.lda = LDH; J.Bt = Wt_in0 + (size_t)N0A * LDH; J.ldb = LDH; J.K = DM; J.M = T; J.N = E_BR; J.O = BR0; J.ldc = LDU; break;
            case 5: J.kind = 5; J.A = BR0; J.lda = LDU; J.Bt = Wt_out0; J.ldb = LDWO; J.K = E_BR; J.M = T; J.N = DM; J.base = a.x; J.O = H; J.ldc = LDH; J.ssq = SSQ1; J.wgm = 4; break;
            case 7: J.kind = 4; J.rowss = SSQ1; J.A = H; J.lda = LDH; J.Bt = Wt_in1; J.ldb = LDH; J.K = DM; J.M = T; J.N = N1A; J.O = P1; J.ldc = LDP; break;
            case 9: J.kind = 2; J.rowss = SSQ1; J.A = H; J.lda = LDH; J.Bt = Wt_in1 + (size_t)N1A * LDH; J.ldb = LDH; J.K = DM; J.M = T; J.N = E_MIX; J.O = P1 + 6144; J.ldc = LDP; break;
            case 10: J.kind = 7; J.A = P1 + 6144; J.lda = LDP; J.Bt = Wt_out1; J.ldb = LDWO; J.K = E_BR; J.M = T; J.N = DM; J.O = H; J.ldc = LDH; J.wgm = 4;
                     J.ssq = SSQ2; J.pcnt = (unsigned*)(ws + WS_CTL + 589824); J.colscale = a.final_g; J.out = a.out; break;
            default: break;
        }
        if (J.kind >= 0) pg8::gemm_phase(lds + RING_OFF, J, tid);

        if (p == 0 || p == 1) {
            LAS float* scr = (LAS float*)(lds + RING_OFF + wave * 16640);
            constexpr int I_IN0 = (DM / 64) * (N0 / 64), I_IN1 = (DM / 64) * (N1 / 64), I_OUT = (E_BR / 64) * (DM / 64), I_KV = (DM / 64) * (2048 / 64), I_GRP = (PGRP / 64) * (PGRP / 64);
            constexpr int NITEMS = I_IN0 + I_IN1 + 2 * I_OUT + 2 * I_KV + 4 * I_GRP;
            const bool listA = (p == 0);
            if (listA) for (int i = bx * (NWAVES * 64) + tid; i < 3072; i += G * NWAVES * 64) OMLB[i] = 1.0f - 1.0f / (1.0f + __expf(a.hgrn_lb[i] - a.hgrn_lb[3072 + i]));
            f32x4 gv[8];
            if (listA) load_gain(a.mem_norm_g, gv, lane); else load_gain(a.norm_g, gv, lane);
            const int nidx = NITEMS + (listA ? MROWS : T);
            int vfirst, vcount, vstride;
            if (listA || G != 256) { vfirst = gw; vcount = 1; vstride = NGW; }
            else { constexpr int SA = 4, SB = 10, SC = 13, TOT = NWAVES * (64 * SA + 96 * SB + 96 * SC);
                vstride = TOT;
                if (bx < 64) { vfirst = (bx * NWAVES + wave) * SA; vcount = SA; }
                else if (bx < 160) { vfirst = 64 * NWAVES * SA + ((bx - 64) * NWAVES + wave) * SB; vcount = SB; }
                else { vfirst = 64 * NWAVES * SA + 96 * NWAVES * SB + ((bx - 160) * NWAVES + wave) * SC; vcount = SC; } }
            for (int vi = 0; vi < vcount; ++vi)
            for (int it = vfirst + vi; it < nidx; it += vstride) {
                if (it >= NITEMS) { const int m = it - NITEMS;
                    if (listA) rms_row_to_bf16(a.mem + (size_t)m * DM, gv, MEMN + (size_t)m * LDH, lane); else rms_row_to_bf16(a.x + (size_t)m * DM, gv, H + (size_t)m * LDH, lane);
                    continue; }
                int r = it;
                if (r < I_IN0) { const int nb = N0 / 64, kb = r / nb, n0 = 64 * (r % nb);
                    if (n0 >= E_MIX) { if (!listA) transpose_item(a.pool_w_in, N0, 64 * kb, n0, Wt_in0, LDH, n0, scr, lane); }
                    else if (listA) {
#pragma unroll
                        for (int j = 0; j < 8; ++j) { const int k = 64 * kb + 8 * j + (lane >> 3); const float* src = a.pool_w_in + (size_t)k * N0 + n0 + 8 * (lane & 7);
                            const f32x4 v0 = *(const f32x4*)src, v1 = *(const f32x4*)(src + 4); u32x4 o; o.x = pk2(v0.x, v0.y); o.y = pk2(v0.z, v0.w); o.z = pk2(v1.x, v1.y); o.w = pk2(v1.z, v1.w);
                            *(u32x4*)(WUBF + (size_t)k * E_MIX + n0 + 8 * (lane & 7)) = o; } }
                    continue; } r -= I_IN0;
                if (r < I_IN1) { if (!listA) { const int nb = N1 / 64, kb = r / nb, n0 = 64 * (r % nb);
                    if (G == 256 && n0 >= N1A && n0 < N1A + E_MIX) continue;
                    const int orow0 = (n0 < 3072) ? (256 * (n0 >> 7) + (n0 & 127)) : (n0 < 6144) ? (256 * ((n0 - 3072) >> 7) + 128 + (n0 & 127)) : n0;
                    transpose_item<true>(a.hgrn_w_in, N1, 64 * kb, n0, Wt_in1, LDH, orow0, scr, lane, a.norm_g + DM); } continue; } r -= I_IN1;
                if (r < 2 * I_OUT) { if (!listA) { const int l = r / I_OUT; r -= l * I_OUT; const int nb = DM / 64, kb = r / nb, n0 = 64 * (r % nb);
                    if (!(l == 1 && G == 256)) transpose_item(a.w_out + (size_t)l * E_BR * DM, DM, 64 * kb, n0, l ? Wt_out1 : Wt_out0, LDWO, n0, scr, lane); } continue; } r -= 2 * I_OUT;
                if (!listA) continue;
                if (r < 2 * I_KV) { const int l = r / I_KV; r -= l * I_KV; const int nb = 2048 / 64, kb = r / nb, n0 = 64 * (r % nb);
                    const int orow0 = (n0 < 1024) ? (l * 1024 + n0) : (2048 + l * 1024 + (n0 - 1024));
                    transpose_item(a.w_kv + (size_t)l * DM * 2048, 2048, 64 * kb, n0, Wt_kv, LDH, orow0, scr, lane); continue; } r -= 2 * I_KV;
                { const int g = r / I_GRP; r -= g * I_GRP; const int nb = PGRP / 64, kb = r / nb, n0 = 64 * (r % nb);
                    transpose_item(a.pool_w_grp + (size_t)g * PGRP * PGRP, PGRP, 64 * kb, n0, Wt_grp, PGRP, g * PGRP + n0, scr, lane); }
            }
        } else if (p == 3 || p == 8) {
            if (p == 3 && sub == (bx & 1)) {
                const int NP = G * NWAVES * 64, me = bx * (NWAVES * 64) + tid;
                constexpr int NCH = PGRP / 8, NT16 = NCH * (T / 16), NT8 = NCH * (T / 8);
                for (int task = me; task < 3 * NT16 + NT8; task += NP) {
                    int grp, rem, rws; if (task < 3 * NT16) { grp = task / NT16; rem = task - grp * NT16; rws = 16; } else { grp = 3; rem = task - 3 * NT16; rws = 8; }
                    const int chl = rem % NCH, rb = rem / NCH, ch = grp * NCH + chl;
                    const int t0 = rb * rws, tl0 = t0 % SEQ;
                    const bf16_t* up = U + (size_t)t0 * LDU + ch * 8; bf16_t* op = BR0 + (size_t)t0 * LDU + ch * 8; const float* scp = a.pool_scale + ch * 8;
                    if (grp == 0) pool_task<2, 16>(up, op, scp, tl0); else if (grp == 1) pool_task<4, 16>(up, op, scp, tl0); else if (grp == 2) pool_task<8, 16>(up, op, scp, tl0); else pool_task<16, 8>(up, op, scp, tl0);
                }
            } else {
            const int layer = (p == 3) ? 0 : 1;
            bf16_t* Q = layer ? (P1 + 9216) : (U + 3072); const int ldq = layer ? LDP : LDU;
#ifndef DBG_MODE
#define DBG_MODE 0
#endif
            if (p == 8 && bx < 96) {
                if (!(dummy && (DBG_MODE & 64))) {
#if defined(REPEAT_MASK) && !(DBG_MODE & 64)
                if (dummy) hgrn_unit(P1, (const float*)(ws + WS_DEC), a.hgrn_norm_g, bx / HG_H, bx % HG_H, lds + RING_OFF, tid, (bf16_t*)(ws + WS_END), E_MIX, 4095);
                else
#endif
                hgrn_unit(P1, (const float*)(ws + WS_DEC), a.hgrn_norm_g, bx / HG_H, bx % HG_H, lds + RING_OFF, tid, P1 + 6144, LDP, -1);
                }
            } else if (!(dummy && (DBG_MODE & 32))) {
                const int u0 = (p == 8) ? (bx - 96) : bx, nu = (p == 8) ? (G - 96) : G;
                bf16_t* Oq = dummy ? (bf16_t*)(ws + WS_END) : (layer ? Q : (BR0 + 3072)); const int ldoq = dummy ? 1024 : ldq;
                for (int unit = u0; unit < (T / 256) * 4; unit += nu) {
                    const int hd = unit & 3, rb = unit >> 2, t0 = rb * 256, b = t0 / SEQ;
                    ca_unit(Q + (size_t)t0 * ldq + hd * 256, Oq + (size_t)t0 * ldoq + hd * 256, ldq, ldoq, KMAT + (size_t)(b * NMEM) * 2048 + layer * 1024 + hd * 256, VT + (size_t)(layer * 1024 + hd * 256) * MROWS + b * NMEM, lds + RING_OFF, tid);
                }
                if (p == 8 && (!dummy || (DBG_MODE & 128))) {
                    asm volatile("s_waitcnt vmcnt(0)" ::: "memory");
                    __syncthreads();
                    pg8::Job J2 = J; J2.kind = 2; J2.rowss = SSQ1; J2.A = H; J2.lda = LDH; J2.Bt = Wt_in1 + (size_t)(N1A + E_MIX) * LDH; J2.ldb = LDH; J2.K = DM; J2.M = T; J2.N = E_CA; J2.O = P1 + 6144 + E_MIX; J2.ldc = LDP; J2.G = G - 96; J2.c = bx - 96; J2.wgm = 0;
                    if (dummy) { J2.O = (bf16_t*)(ws + WS_END); J2.ldc = 1024; }
                    pg8::gemm_phase(lds + RING_OFF, J2, tid);
                    if (G == 256 && bx >= 192 && !dummy) {
                        LAS float* scr = (LAS float*)(lds + RING_OFF + wave * 16640);
                        constexpr int I_OUT1 = (E_BR / 64) * (DM / 64);
                        constexpr int I_GM = (DM / 64) * (E_MIX / 64);
                        for (int r = (bx - 192) * NWAVES + wave; r < I_GM; r += 64 * NWAVES) { const int nb = E_MIX / 64, kb = r / nb, n0 = N1A + 64 * (r % nb);
                            transpose_item<true>(a.hgrn_w_in, N1, 64 * kb, n0, Wt_in1, LDH, n0, scr, lane, a.norm_g + DM); }
                        for (int r = (bx - 192) * NWAVES + wave; r < I_OUT1; r += 64 * NWAVES) { const int nb = DM / 64, kb = r / nb, n0 = 64 * (r % nb);
                            transpose_item(a.w_out + (size_t)E_BR * DM, DM, 64 * kb, n0, Wt_out1, LDWO, n0, scr, lane); }
                    }
                }
            }
            }
        }
#ifdef REPEAT_MASK
        if (rep + 1 < nrep) xcd_barrier(bar, wave_s);
        }
#endif
        if (p == 3 && sub == 0) { sub = 1; continue; }
        sub = 0;
        if (p + 1 < a.ph_hi && p != 10) xcd_barrier(bar, wave_s);
#ifdef PROBE_A
        if (bx == 0 && tid0 == 0) tsb[p + 1] = __builtin_amdgcn_s_memrealtime();
#endif
        ++p;
    }
#ifdef PROBE_A
    if (bx == 0 && tid0 == 0) { float* pv = (float*)(ws + WS_CTL + 131072);
        pv[0] = (float)(tsb[PROBE_A + 1] - tsb[PROBE_A]) * 0.1f; pv[1] = (float)(tsb[PROBE_B + 1] - tsb[PROBE_B]) * 0.1f; }
    xcd_barrier(bar, wave_s);
    { const float* pv = (const float*)(ws + WS_CTL + 131072); const float av = pv[0], bv = pv[1];
      for (size_t i = (size_t)bx * 512 + tid0; i < (size_t)T * DM; i += (size_t)G * 512) a.out[i] = (i == 0) ? av : bv; }
#endif
}

constexpr int N_PHASES = 12;

extern "C" void kernel_launch(void* const* d_in, const int* in_sizes, int n_in, void* d_out, int out_size, void* d_ws, size_t ws_size, hipStream_t stream) {
    static int grid = 0;
    if (grid == 0) {
        if (n_in != 13 || in_sizes[0] != T * DM || out_size != T * DM || ws_size < WS_WUBF + 12 * MiB) {
            fprintf(stderr, "kernel_launch: unexpected shapes / workspace (n_in %d, in0 %d, out %d, ws %zu < %zu); nothing launched\n", n_in, n_in > 0 ? in_sizes[0] : -1, out_size, ws_size, (size_t)WS_END); grid = -1; return; }
        int dev = 0, cus = 0, per_cu = 0;
        if (hipGetDevice(&dev) != hipSuccess || hipDeviceGetAttribute(&cus, hipDeviceAttributeMultiprocessorCount, dev) != hipSuccess) { grid = -1; return; }
        if (hipFuncSetAttribute((const void*)fwd_kernel, hipFuncAttributeMaxDynamicSharedMemorySize, LDS_BYTES) != hipSuccess) { fprintf(stderr, "kernel_launch: hipFuncSetAttribute failed\n"); grid = -1; return; }
        if (hipOccupancyMaxActiveBlocksPerMultiprocessor(&per_cu, (const void*)fwd_kernel, NWAVES * 64, LDS_BYTES) != hipSuccess || per_cu < 1) {
            fprintf(stderr, "kernel_launch: occupancy query reports %d workgroups per CU; nothing launched\n", per_cu); (void)hipGetLastError(); grid = -1; return; }
        grid = cus;
        if (grid != 256) { fprintf(stderr, "kernel_launch: built for 256 CUs (tile orders / panel exchange), found %d\n", grid); grid = -1; return; }
    }
    if (grid < 0) return;
    if (hipMemsetAsync((char*)d_ws + WS_CTL, 0, CTL_ZERO_BYTES, stream) != hipSuccess) return;
    Args a{};
    a.x = (const float*)d_in[0]; a.mem = (const float*)d_in[1]; a.norm_g = (const float*)d_in[2]; a.mem_norm_g = (const float*)d_in[3]; a.w_kv = (const float*)d_in[4]; a.w_out = (const float*)d_in[5];
    a.pool_w_in = (const float*)d_in[6]; a.pool_w_grp = (const float*)d_in[7]; a.pool_scale = (const float*)d_in[8]; a.hgrn_w_in = (const float*)d_in[9]; a.hgrn_lb = (const float*)d_in[10];
    a.hgrn_norm_g = (const float*)d_in[11]; a.final_g = (const float*)d_in[12]; a.out = (float*)d_out; a.ws = (unsigned char*)d_ws;
#if MK_N_LAUNCHES == 1
    a.ph_lo = 0; a.ph_hi = N_PHASES;
    hipLaunchKernelGGL(fwd_kernel, dim3(grid), dim3(NWAVES * 64), LDS_BYTES, stream, a);
#else
    for (int p = 0; p < N_PHASES; ++p) { a.ph_lo = p; a.ph_hi = p + 1; hipLaunchKernelGGL(fwd_kernel, dim3(grid), dim3(NWAVES * 64), LDS_BYTES, stream, a); }
#endif
}
```
